# Optimizing an MI355X kernel written in HIP

```python
import math
import jax
import jax.numpy as jnp
from jax import lax
import numpy as np

D_MODEL = 1024
BATCH = 4
SEQ = 4096
DEPTH = 4

N_A_LAYERS = DEPTH // 2
N_B_LAYERS = DEPTH - N_A_LAYERS
N_DENSE = (DEPTH + 1) // 2
N_MOE = DEPTH // 2

CONV_K = 31

N_HEADS = 16
HEAD_DIM = D_MODEL // N_HEADS
MOBA_BLOCK = 256
MOBA_TOPK = 3
Q_CHUNK = 32

D_FF = ((8 * D_MODEL // 3 + 255) // 256) * 256
N_EXPERTS = 8
TOP_K_EXPERTS = 2
D_FF_EXPERT = 7 * D_MODEL // 2

ALPHA = (2.0 * DEPTH) ** 0.25
BETA = (8.0 * DEPTH) ** -0.25

LN_EPS = 1e-5
NEG_INF = -1e30
ADA_INIT = 0.5

kernel_name = "yoco_conformer_moba_deepnorm_moe"


def layer_norm(x, g, b):
    xf = x.astype(jnp.float32)
    mu = jnp.mean(xf, axis=-1, keepdims=True)
    xc = xf - mu
    var = jnp.mean(xc * xc, axis=-1, keepdims=True)
    y = xc * lax.rsqrt(var + LN_EPS)
    return (y * g.astype(jnp.float32) + b.astype(jnp.float32)).astype(x.dtype)


def alibi_slopes(n_heads):
    return jnp.exp2(-8.0 * jnp.arange(1, n_heads + 1, dtype=jnp.float32) / n_heads)


def swiglu(h, w13, w2):
    a, b = jnp.split(h @ w13, 2, axis=-1)
    return (jax.nn.silu(a) * b) @ w2


def conv_module(h, w_in, b_in, w_dw, b_dw, g_n, b_n, w_out, b_out):
    a, g = jnp.split(h @ w_in + b_in, 2, axis=-1)
    u = a * jax.nn.sigmoid(g)
    u = lax.conv_general_dilated(
        u, w_dw[:, None, :], window_strides=(1,), padding=[(CONV_K - 1, 0)],
        dimension_numbers=("NWC", "WIO", "NWC"),
        feature_group_count=u.shape[-1]) + b_dw
    u = jax.nn.silu(layer_norm(u, g_n, b_n))
    return u @ w_out + b_out


def moe_swiglu(h, router_w, router_b, w13, w2):
    logits = (h @ router_w).astype(jnp.float32) + router_b.astype(jnp.float32)
    top_val, top_idx = lax.top_k(logits, TOP_K_EXPERTS)
    top_w = jax.nn.softmax(top_val, axis=-1)
    gates = jnp.sum(jax.nn.one_hot(top_idx, N_EXPERTS, dtype=jnp.float32) * top_w[..., None], axis=-2)
    gates = gates.astype(h.dtype)
    y = jnp.zeros_like(h)
    for e in range(N_EXPERTS):
        y = y + gates[..., e:e + 1] * swiglu(h, w13[e], w2[e])
    return y


def shared_kv(h, w_kv):
    B, S, _ = h.shape
    n_blk = -(-S // MOBA_BLOCK)
    pad = n_blk * MOBA_BLOCK - S
    k, v = jnp.split(h @ w_kv, 2, axis=-1)
    k = k.reshape(B, S, N_HEADS, HEAD_DIM).transpose(0, 2, 1, 3)
    v = v.reshape(B, S, N_HEADS, HEAD_DIM).transpose(0, 2, 1, 3)
    k_pad = jnp.pad(k, ((0, 0), (0, 0), (0, pad), (0, 0)))
    v_pad = jnp.pad(v, ((0, 0), (0, 0), (0, pad), (0, 0)))
    k_mean = jnp.mean(k_pad.reshape(B, N_HEADS, n_blk, MOBA_BLOCK, HEAD_DIM).astype(jnp.float32), axis=3)
    return k_pad, v_pad, k_mean


def moba_attention(q, k_pad, v_pad, k_mean, slopes):
    B, S, H, Dh = q.shape
    n_blk = k_mean.shape[2]
    topk = min(MOBA_TOPK, n_blk)
    kb = k_pad.reshape(B, H, n_blk, MOBA_BLOCK, Dh)
    vb = v_pad.reshape(B, H, n_blk, MOBA_BLOCK, Dh)
    n_chunk = S // Q_CHUNK
    q_chunks = q.transpose(0, 2, 1, 3).reshape(B, H, n_chunk, Q_CHUNK, Dh).transpose(2, 0, 1, 3, 4)
    scale = Dh ** -0.5
    b_idx = jnp.arange(B)[:, None, None, None]
    h_idx = jnp.arange(H)[None, :, None, None]
    blk_pos = jnp.arange(MOBA_BLOCK)

    def chunk(args):
        ci, qc = args
        start = ci * Q_CHUNK
        blk = start // MOBA_BLOCK
        t = start + jnp.arange(Q_CHUNK)
        gate = jnp.einsum("bhqd,bhnd->bhqn", qc.astype(jnp.float32), k_mean)
        gate = jnp.where(jnp.arange(n_blk) < blk, gate, -jnp.inf)
        _, idx = lax.top_k(gate, topk)
        valid = idx < blk
        k_sel = kb[b_idx, h_idx, idx]
        v_sel = vb[b_idx, h_idx, idx]
        dist_sel = (t[:, None, None] - (idx[..., None] * MOBA_BLOCK + blk_pos)).astype(jnp.float32)
        s_sel = jnp.einsum("bhqd,bhqnkd->bhqnk", qc, k_sel).astype(jnp.float32) * scale
        s_sel = s_sel - slopes[:, None, None, None] * dist_sel
        s_sel = jnp.where(valid[..., None], s_sel, NEG_INF)
        k_own = lax.dynamic_slice_in_dim(k_pad, blk * MOBA_BLOCK, MOBA_BLOCK, axis=2)
        v_own = lax.dynamic_slice_in_dim(v_pad, blk * MOBA_BLOCK, MOBA_BLOCK, axis=2)
        dist_own = t[:, None] - (blk * MOBA_BLOCK + blk_pos)[None, :]
        s_own = jnp.einsum("bhqd,bhkd->bhqk", qc, k_own).astype(jnp.float32) * scale
        s_own = s_own - slopes[:, None, None] * dist_own.astype(jnp.float32)
        s_own = jnp.where(dist_own >= 0, s_own, NEG_INF)
        scores = jnp.concatenate([s_sel.reshape(B, H, Q_CHUNK, topk * MOBA_BLOCK), s_own], axis=-1)
        p = jax.nn.softmax(scores, axis=-1).astype(v_pad.dtype)
        p_sel = p[..., :topk * MOBA_BLOCK].reshape(B, H, Q_CHUNK, topk, MOBA_BLOCK)
        p_own = p[..., topk * MOBA_BLOCK:]
        return (jnp.einsum("bhqnk,bhqnkd->bhqd", p_sel, v_sel)
                + jnp.einsum("bhqk,bhkd->bhqd", p_own, v_own))

    outs = lax.map(chunk, (jnp.arange(n_chunk), q_chunks))
    return outs.transpose(1, 0, 3, 2, 4).reshape(B, S, H * Dh)


def setup_inputs(seed: int = 0) -> dict:
    key = jax.random.key(seed)
    ks = jax.random.split(key, 32)
    D = D_MODEL

    def nrm(k, shape, std):
        return jax.random.normal(k, shape, dtype=jnp.float32) * std

    return {
        "x": nrm(ks[0], (BATCH, SEQ, D), 1.0),
        "c": nrm(ks[1], (BATCH, D), 1.0),
        "ada_w": nrm(ks[2], (DEPTH, D, 6 * D), ADA_INIT * D ** -0.5),
        "ada_b": nrm(ks[3], (DEPTH, 6 * D), 0.01),
        "ln_g": 1.0 + nrm(ks[4], (DEPTH, 2, D), 0.05),
        "ln_b": nrm(ks[5], (DEPTH, 2, D), 0.01),
        "conv_in_w": nrm(ks[6], (N_A_LAYERS, D, 2 * D), D ** -0.5),
        "conv_in_b": nrm(ks[7], (N_A_LAYERS, 2 * D), 0.01),
        "conv_dw_w": nrm(ks[8], (N_A_LAYERS, CONV_K, D), CONV_K ** -0.5),
        "conv_dw_b": nrm(ks[9], (N_A_LAYERS, D), 0.01),
        "conv_norm_g": 1.0 + nrm(ks[10], (N_A_LAYERS, D), 0.05),
        "conv_norm_b": nrm(ks[11], (N_A_LAYERS, D), 0.01),
        "conv_out_w": nrm(ks[12], (N_A_LAYERS, D, D), BETA * D ** -0.5),
        "conv_out_b": nrm(ks[13], (N_A_LAYERS, D), 0.01),
        "kv_ada_w": nrm(ks[14], (D, 2 * D), ADA_INIT * D ** -0.5),
        "kv_ada_b": nrm(ks[15], (2 * D,), 0.01),
        "w_kv": nrm(ks[16], (D, 2 * D), D ** -0.5),
        "w_q": nrm(ks[17], (N_B_LAYERS, D, D), D ** -0.5),
        "w_o": nrm(ks[18], (N_B_LAYERS, D, D), BETA * D ** -0.5),
        "ffn_w13": nrm(ks[19], (N_DENSE, D, 2 * D_FF), D ** -0.5),
        "ffn_w2": nrm(ks[20], (N_DENSE, D_FF, D), BETA * D_FF ** -0.5),
        "router_w": nrm(ks[21], (N_MOE, D, N_EXPERTS), D ** -0.5),
        "router_b": nrm(ks[22], (N_MOE, N_EXPERTS), 0.01),
        "moe_w13": nrm(ks[23], (N_MOE, N_EXPERTS, D, 2 * D_FF_EXPERT), D ** -0.5),
        "moe_w2": nrm(ks[24], (N_MOE, N_EXPERTS, D_FF_EXPERT, D), BETA * D_FF_EXPERT ** -0.5),
    }


def reference(x, c, ada_w, ada_b, ln_g, ln_b, conv_in_w, conv_in_b, conv_dw_w, conv_dw_b,
              conv_norm_g, conv_norm_b, conv_out_w, conv_out_b, kv_ada_w, kv_ada_b, w_kv,
              w_q, w_o, ffn_w13, ffn_w2, router_w, router_b, moe_w13, moe_w2):
    B, S, D = x.shape
    slopes = alibi_slopes(N_HEADS)
    c_act = jax.nn.silu(c)
    k_pad = v_pad = k_mean = None
    for l in range(DEPTH):
        if l == N_A_LAYERS:
            kv_shift, kv_scale = jnp.split(c_act @ kv_ada_w + kv_ada_b, 2, axis=-1)
            h_kv = x * (1.0 + kv_scale[:, None, :]) + kv_shift[:, None, :]
            k_pad, v_pad, k_mean = shared_kv(h_kv, w_kv)
        sh1, sc1, g1, sh2, sc2, g2 = jnp.split(c_act @ ada_w[l] + ada_b[l], 6, axis=-1)
        h = x * (1.0 + sc1[:, None, :]) + sh1[:, None, :]
        if l < N_A_LAYERS:
            out = conv_module(h, conv_in_w[l], conv_in_b[l], conv_dw_w[l], conv_dw_b[l],
                              conv_norm_g[l], conv_norm_b[l], conv_out_w[l], conv_out_b[l])
        else:
            j = l - N_A_LAYERS
            q = (h @ w_q[j]).reshape(B, S, N_HEADS, HEAD_DIM)
            out = moba_attention(q, k_pad, v_pad, k_mean, slopes) @ w_o[j]
        x = layer_norm(ALPHA * x + (1.0 + g1[:, None, :]) * out, ln_g[l, 0], ln_b[l, 0])
        h = x * (1.0 + sc2[:, None, :]) + sh2[:, None, :]
        if l % 2 == 0:
            f = swiglu(h, ffn_w13[l // 2], ffn_w2[l // 2])
        else:
            f = moe_swiglu(h, router_w[l // 2], router_b[l // 2], moe_w13[l // 2], moe_w2[l // 2])
        x = layer_norm(ALPHA * x + (1.0 + g2[:, None, :]) * f, ln_g[l, 1], ln_b[l, 1])
    return x
```

```cpp
#include <hip/hip_runtime.h>
#include <cstdio>
#include <cstdint>
#ifndef HYB_SUB
#define HYB_SUB 7
#endif
#ifndef MK_PER_PHASE
#define MK_PER_PHASE 0
#endif
namespace pg8 {
#define PG8_LAS __attribute__((address_space(3)))
typedef unsigned short bf16_t;
typedef short bf16x8 __attribute__((ext_vector_type(8)));
typedef float f32x4 __attribute__((ext_vector_type(4)));
typedef unsigned u32x4 __attribute__((ext_vector_type(4)));
constexpr int BM = 256, BK = 64, HALF = 128, HTB = HALF * BK * 2  , STAGE_BYTES = 8 * HTB, NXCD = 8, WGM = 8;

__host__ __device__ __forceinline__ int lds_byte(int r, int c) { const int st = (r >> 4) * 2 + (c >> 5), rr = r & 15, cc = c & 31, ob = rr * 64 + cc * 2; return st * 1024 + (ob ^ (((ob >> 9) & 1) << 5)); }
__host__ __device__ __forceinline__ void stage_rc(int b, int& R, int& C) { const int st = b / 1024, sb = b % 1024, swz = sb ^ (((sb >> 9) & 1) << 5); R = (st >> 1) * 16 + swz / 64; C = (st & 1) * 32 + (swz % 64) / 2; }
__host__ __device__ __forceinline__ int perm32(int rho) { const int n = rho >> 4, i = rho & 15; return 8 * (i >> 2) + 4 * n + (i & 3); }

struct Unit { int pm, pn; };
struct Gemm { const bf16_t* A; const bf16_t* Bt; int M, N, K; };

struct StaticOrder {
    int nM, nN, nwg, G, c;
    __host__ __device__ void init(int M, int N, int G_, int c_) { nM = M / BM; nN = N / BM; nwg = nM * nN; G = G_; c = c_; }
    __host__ __device__ bool next(int i, Unit& u) const {
        const long L = (long)i * G + c; if (L >= nwg) return false;
        int wgid = (int)L; { const int q = nwg / NXCD, r = nwg % NXCD, xcd = wgid % NXCD, off = wgid / NXCD; wgid = (xcd < r ? xcd * (q + 1) : r * (q + 1) + (xcd - r) * q) + off; }
        const int nig = WGM * nN, gid = wgid / nig, fm = gid * WGM, gsz = (nM - fm) < WGM ? (nM - fm) : WGM;
        u.pm = fm + ((wgid % nig) % gsz); u.pn = (wgid % nig) / gsz; return true;
    }
    __device__ __forceinline__ void a_ready(const Unit&) const {}
    __device__ __forceinline__ void done(const Unit&) const {}
};

__device__ __forceinline__ unsigned cvt_pk_bf16(float lo, float hi) { unsigned r; asm volatile("v_cvt_pk_bf16_f32 %0, %1, %2" : "=v"(r) : "v"(lo), "v"(hi)); return r; }
typedef float f32x2 __attribute__((ext_vector_type(2)));
typedef int i32x4v __attribute__((ext_vector_type(4)));
typedef int i32x8v __attribute__((ext_vector_type(8)));
__device__ __forceinline__ i32x8v cat8(bf16x8 lo, bf16x8 hi) { const i32x4v a = __builtin_bit_cast(i32x4v, lo), b = __builtin_bit_cast(i32x4v, hi); return __builtin_shufflevector(a, b, 0, 1, 2, 3, 4, 5, 6, 7); }
template <class Epi, class Sched, bool ALIGN_EPI = false, bool SP2 = false, bool FP8 = false>
__device__ __forceinline__ void gemm_phase(PG8_LAS unsigned char* lds, const Gemm g, const Sched& S, const Epi& E) {
    int tid_ = threadIdx.x; asm volatile("" : "+v"(tid_));
    const int tid = tid_, wid = __builtin_amdgcn_readfirstlane(tid >> 6), lane = tid & 63, wr = wid >> 2, wc = wid & 3, fr = lane & 15, fq = lane >> 4;
    const int K = g.K, nt = K / BK;
    unsigned voffA[2], voffB[2];
#pragma unroll
    for (int i = 0; i < 2; ++i) { int R, C; stage_rc(tid * 16 + i * 8192, R, C); const int Rb = Epi::PERM ? ((R & ~31) + perm32(R & 31)) : R;
        voffA[i] = (unsigned)(R * K + C) * 2u; voffB[i] = (unsigned)(Rb * K + C) * 2u; }
    const size_t kstep = (size_t)(BK * 2);
    const size_t hstep = (size_t)HALF * K * 2;
    const size_t tstep = 2 * hstep;
    const unsigned ldsw = (unsigned)wid * 1024u;
    const int aoff = lds_byte(wr * 64 + fr, fq * 8), boff = lds_byte(wc * 32 + fr, fq * 8);
    const int aoff8 = lds_byte(wr * 64 + fr, (fq >> 1) * 32 + (fq & 1) * 16), boff8 = lds_byte(wc * 32 + fr, (fq >> 1) * 32 + (fq & 1) * 16);
#define PG8_SA(b, h) (((b) * 2 + (h)) * HTB)
#define PG8_SB(b, h) ((4 + (b) * 2 + (h)) * HTB)
#define PG8_STAGE(bufoff, gbase, voff) do { _Pragma("unroll") for (int _i = 0; _i < 2; ++_i) \
        __builtin_amdgcn_global_load_lds((const unsigned*)((const char*)(gbase) + (voff)[_i]), (PG8_LAS unsigned*)(lds + (bufoff) + ldsw + _i * 8192), 16, 0, 0); } while (0)
#define PG8_LDA(dst, b, h) do { if constexpr (FP8) { _Pragma("unroll") for (int m = 0; m < 4; ++m) dst##8[m] = *(const PG8_LAS i32x8v*)(lds + PG8_SA(b, h) + aoff8 + m * 2048); } else { \
        _Pragma("unroll") for (int m = 0; m < 4; ++m) _Pragma("unroll") for (int k = 0; k < 2; ++k) dst[m][k] = *(const PG8_LAS bf16x8*)(lds + PG8_SA(b, h) + aoff + m * 2048 + k * 1024); } } while (0)
#define PG8_LDB(dst, b, h) do { if constexpr (FP8) { _Pragma("unroll") for (int n = 0; n < 2; ++n) dst##8[n] = *(const PG8_LAS i32x8v*)(lds + PG8_SB(b, h) + boff8 + n * 2048); } else { \
        _Pragma("unroll") for (int n = 0; n < 2; ++n) _Pragma("unroll") for (int k = 0; k < 2; ++k) dst[n][k] = *(const PG8_LAS bf16x8*)(lds + PG8_SB(b, h) + boff + n * 2048 + k * 1024); } } while (0)
#define PG8_MMA(ai, bj, AF, BF) do { __builtin_amdgcn_s_setprio(1); if constexpr (FP8) { \
        _Pragma("unroll") for (int m = 0; m < 4; ++m) _Pragma("unroll") for (int n = 0; n < 2; ++n) \
            asm volatile("v_mfma_f32_16x16x128_f8f6f4 %0, %1, %2, %0" : "+v"(acc[ai][bj][m][n]) : "v"(BF##8[n]), "v"(AF##8[m])); \
        } else { _Pragma("unroll") for (int m = 0; m < 4; ++m) _Pragma("unroll") for (int n = 0; n < 2; ++n) _Pragma("unroll") for (int k = 0; k < 2; ++k) \
        acc[ai][bj][m][n] = __builtin_amdgcn_mfma_f32_16x16x32_bf16(BF[n][k], AF[m][k], acc[ai][bj][m][n], 0, 0, 0); } __builtin_amdgcn_s_setprio(0); } while (0)
#define PG8_WAIT_V(n) asm volatile("s_waitcnt vmcnt(" #n ")" ::: "memory")
#define PG8_WAIT_L(n) asm volatile("s_waitcnt lgkmcnt(" #n ")" ::: "memory")
#define PG8_BAR __builtin_amdgcn_s_barrier()
#define PG8_SCHED __builtin_amdgcn_sched_barrier(0)
    Unit cur, nxt; int ui = 0;
    if (!S.next(0, cur)) return;
    f32x4 acc[2][2][4][2];
#pragma unroll
    for (int a = 0; a < 2; ++a)
#pragma unroll
        for (int b = 0; b < 2; ++b)
#pragma unroll
            for (int m = 0; m < 4; ++m)
#pragma unroll
                for (int n = 0; n < 2; ++n) acc[a][b][m][n] = (f32x4){0.f, 0.f, 0.f, 0.f};
    bf16x8 At[4][2], B0[2][2], B1[2][2]; i32x8v At8[4], B08[2], B18[2];
    const char* cA = (const char*)g.A + (size_t)cur.pm * tstep; const char* cB = (const char*)g.Bt + (size_t)cur.pn * tstep;
    S.a_ready(cur);
    if constexpr (SP2) {
        PG8_STAGE(PG8_SB(0, 0), cB, voffB); PG8_STAGE(PG8_SB(0, 1), cB + hstep, voffB); PG8_STAGE(PG8_SA(0, 0), cA, voffA); PG8_STAGE(PG8_SA(0, 1), cA + hstep, voffA);
        if (wr == 1) PG8_BAR;
        PG8_WAIT_V(2); PG8_BAR;
        PG8_STAGE(PG8_SB(1, 0), cB + kstep, voffB); PG8_STAGE(PG8_SA(1, 0), cA + kstep, voffA); PG8_STAGE(PG8_SB(1, 1), cB + hstep + kstep, voffB);
        PG8_WAIT_V(6); PG8_BAR;
    } else {
        PG8_STAGE(PG8_SB(0, 0), cB, voffB); PG8_STAGE(PG8_SA(0, 0), cA, voffA); PG8_STAGE(PG8_SB(0, 1), cB + hstep, voffB); PG8_STAGE(PG8_SA(0, 1), cA + hstep, voffA);
        if (wr == 1) PG8_BAR;
        PG8_WAIT_V(4); PG8_BAR;
        PG8_STAGE(PG8_SB(1, 0), cB + kstep, voffB); PG8_STAGE(PG8_SA(1, 0), cA + kstep, voffA); PG8_STAGE(PG8_SB(1, 1), cB + hstep + kstep, voffB);
        PG8_WAIT_V(6); PG8_BAR;
    }
    for (;;) {
        const bool has_next = S.next(ui + 1, nxt);
        const char* nA = has_next ? (const char*)g.A + (size_t)nxt.pm * tstep : cA; const char* nB = has_next ? (const char*)g.Bt + (size_t)nxt.pn * tstep : cB;
        for (int t = 0; t < nt; t += 2) {
            const bool last = (t == nt - 2);
            const char* a1 = cA + (size_t)(t + 1) * kstep;
            const char* a2 = last ? nA : cA + (size_t)(t + 2) * kstep; const char* b2 = last ? nB : cB + (size_t)(t + 2) * kstep;
            const char* a3 = a2 + kstep; const char* b3 = b2 + kstep;
            if (last && has_next) S.a_ready(nxt);
            if constexpr (SP2) {
            PG8_LDB(B0, 0, 0); PG8_LDB(B1, 0, 1); PG8_SCHED; PG8_LDA(At, 0, 0); PG8_STAGE(PG8_SA(1, 1), a1 + hstep, voffA);
            PG8_WAIT_V(8); PG8_WAIT_L(0); PG8_BAR; PG8_MMA(0, 0, At, B0); PG8_MMA(0, 1, At, B1); PG8_BAR; PG8_SCHED;
            PG8_LDA(At, 0, 1); PG8_STAGE(PG8_SB(0, 0), b2, voffB); PG8_STAGE(PG8_SB(0, 1), b2 + hstep, voffB); PG8_STAGE(PG8_SA(0, 0), a2, voffA);
            PG8_WAIT_V(8); PG8_WAIT_L(0); PG8_BAR; PG8_MMA(1, 0, At, B0); PG8_MMA(1, 1, At, B1); PG8_BAR; PG8_SCHED;
            PG8_LDB(B0, 1, 0); PG8_LDB(B1, 1, 1); PG8_SCHED; PG8_LDA(At, 1, 0); PG8_STAGE(PG8_SA(0, 1), a2 + hstep, voffA);
            PG8_WAIT_V(8); PG8_WAIT_L(0); PG8_BAR; PG8_MMA(0, 0, At, B0); PG8_MMA(0, 1, At, B1); PG8_BAR; PG8_SCHED;
            PG8_LDA(At, 1, 1); PG8_STAGE(PG8_SB(1, 0), b3, voffB); PG8_STAGE(PG8_SB(1, 1), b3 + hstep, voffB); PG8_STAGE(PG8_SA(1, 0), a3, voffA);
            PG8_WAIT_V(8); PG8_WAIT_L(0); PG8_BAR; PG8_MMA(1, 0, At, B0); PG8_MMA(1, 1, At, B1); PG8_BAR; PG8_SCHED;
            } else {
            PG8_LDB(B0, 0, 0); PG8_SCHED; PG8_LDA(At, 0, 0); PG8_STAGE(PG8_SA(1, 1), a1 + hstep, voffA);
            PG8_WAIT_L(8); PG8_BAR; PG8_WAIT_L(0); PG8_MMA(0, 0, At, B0); PG8_BAR; PG8_SCHED;
            PG8_LDB(B1, 0, 1); PG8_STAGE(PG8_SB(0, 0), b2, voffB);
            PG8_BAR; PG8_WAIT_L(0); PG8_MMA(0, 1, At, B1); PG8_BAR;
            PG8_LDA(At, 0, 1); PG8_STAGE(PG8_SA(0, 0), a2, voffA);
            PG8_BAR; PG8_WAIT_L(0); PG8_MMA(1, 0, At, B0); PG8_BAR; PG8_SCHED;
            PG8_STAGE(PG8_SB(0, 1), b2 + hstep, voffB);
            PG8_WAIT_V(6); PG8_BAR; PG8_MMA(1, 1, At, B1); PG8_BAR;
            PG8_LDB(B0, 1, 0); PG8_SCHED; PG8_LDA(At, 1, 0); PG8_STAGE(PG8_SA(0, 1), a2 + hstep, voffA);
            PG8_WAIT_L(8); PG8_BAR; PG8_WAIT_L(0); PG8_MMA(0, 0, At, B0); PG8_BAR; PG8_SCHED;
            PG8_LDB(B1, 1, 1); PG8_STAGE(PG8_SB(1, 0), b3, voffB);
            PG8_BAR; PG8_WAIT_L(0); PG8_MMA(0, 1, At, B1); PG8_BAR;
            PG8_LDA(At, 1, 1); PG8_STAGE(PG8_SA(1, 0), a3, voffA);
            PG8_BAR; PG8_WAIT_L(0); PG8_MMA(1, 0, At, B0); PG8_BAR; PG8_SCHED;
            PG8_STAGE(PG8_SB(1, 1), b3 + hstep, voffB);
            PG8_WAIT_V(6); PG8_BAR; PG8_MMA(1, 1, At, B1); PG8_BAR;
            }
        }
        if constexpr (FP8) asm volatile("s_nop 15\n\ts_nop 15" ::: "memory");
        if constexpr (ALIGN_EPI) { if (wr == 0) PG8_BAR; }
        if constexpr (!Epi::AFTER_DRAIN) { E(acc, cur, wr, wc, fr, fq); S.done(cur); }
        if (!has_next) break;
#pragma unroll
        for (int a = 0; a < 2; ++a)
#pragma unroll
            for (int b = 0; b < 2; ++b)
#pragma unroll
                for (int m = 0; m < 4; ++m)
#pragma unroll
                    for (int n = 0; n < 2; ++n) acc[a][b][m][n] = (f32x4){0.f, 0.f, 0.f, 0.f};
        cur = nxt; cA = nA; cB = nB; ++ui;
        if constexpr (ALIGN_EPI) { if (wr == 1) PG8_BAR; }
    }
    PG8_WAIT_V(0);
    if constexpr (!ALIGN_EPI) { if (wr == 0) PG8_BAR; }
    PG8_BAR;
    if constexpr (Epi::AFTER_DRAIN) { E.fused(acc, cur, wr, wc, fr, fq, lds, wid, lane); S.done(cur); }
#undef PG8_SA
#undef PG8_SB
#undef PG8_STAGE
#undef PG8_LDA
#undef PG8_LDB
#undef PG8_MMA
#undef PG8_WAIT_V
#undef PG8_WAIT_L
#undef PG8_BAR
#undef PG8_SCHED
}
}
namespace pg8 {
typedef unsigned u32x2 __attribute__((ext_vector_type(2)));
__device__ __forceinline__ float fast_sigmoid(float v) { return __builtin_amdgcn_rcpf(1.0f + __expf(-v)); }
__device__ __forceinline__ unsigned cvt4_fp8(float a, float b, float c, float d) {
    a = __builtin_amdgcn_fmed3f(a, -448.f, 448.f); b = __builtin_amdgcn_fmed3f(b, -448.f, 448.f); c = __builtin_amdgcn_fmed3f(c, -448.f, 448.f); d = __builtin_amdgcn_fmed3f(d, -448.f, 448.f);
    int r = __builtin_amdgcn_cvt_pk_fp8_f32(a, b, 0, false); r = __builtin_amdgcn_cvt_pk_fp8_f32(c, d, r, true); return (unsigned)r; }

template <int MODE, int NCT, bool OUT8 = false> struct EpiGated {
    static constexpr bool PERM = true, AFTER_DRAIN = false;
    bf16_t* O; int ldc; const float* bias; int goff; float sin, sout;
    __device__ __forceinline__ void operator()(const f32x4 (&acc)[2][2][4][2], const Unit& u, int wr, int wc, int fr, int fq) const {
        const int ct = NCT ? (u.pn % (NCT ? NCT : 1)) : u.pn;
        const int row0 = u.pm * BM + wr * 64 + fr, col0 = ct * HALF + wc * 32 + 8 * fq;
        f32x4 ba[2], bg[2];
#pragma unroll
        for (int n = 0; n < 2; ++n) { ba[n] = MODE == 0 ? *(const f32x4*)(bias + col0 + 4 * n) : (f32x4){0.f, 0.f, 0.f, 0.f}; bg[n] = MODE == 0 ? *(const f32x4*)(bias + goff + col0 + 4 * n) : (f32x4){0.f, 0.f, 0.f, 0.f}; }
#pragma unroll
        for (int ai = 0; ai < 2; ++ai)
#pragma unroll
            for (int m = 0; m < 4; ++m) {
                f32x4 o[2];
#pragma unroll
                for (int n = 0; n < 2; ++n) { const f32x4 a = acc[ai][0][m][n] * sin + ba[n], g = acc[ai][1][m][n] * sin + bg[n];
#pragma unroll
                    for (int e = 0; e < 4; ++e) o[n][e] = MODE == 0 ? a[e] * fast_sigmoid(g[e]) : a[e] * fast_sigmoid(a[e]) * g[e]; }
                if constexpr (OUT8) { u32x2 w; w.x = cvt4_fp8(o[0][0] * sout, o[0][1] * sout, o[0][2] * sout, o[0][3] * sout); w.y = cvt4_fp8(o[1][0] * sout, o[1][1] * sout, o[1][2] * sout, o[1][3] * sout);
                    *(u32x2*)((unsigned char*)O + (size_t)(row0 + ai * HALF + m * 16) * ldc + col0) = w; }
                else { bf16_t* rowp = O + (size_t)(row0 + ai * HALF + m * 16) * ldc + col0;
                    u32x4 w; w.x = cvt_pk_bf16(o[0][0], o[0][1]); w.y = cvt_pk_bf16(o[0][2], o[0][3]); w.z = cvt_pk_bf16(o[1][0], o[1][1]); w.w = cvt_pk_bf16(o[1][2], o[1][3]);
                    *(u32x4*)rowp = w; }
            }
    }
};

struct EpiBf16S {
    static constexpr bool PERM = true, AFTER_DRAIN = false;
    bf16_t* O; int ldc; float scale;
    __device__ __forceinline__ void operator()(const f32x4 (&acc)[2][2][4][2], const Unit& u, int wr, int wc, int fr, int fq) const {
        const int row0 = u.pm * BM + wr * 64 + fr, col0 = u.pn * BM + wc * 32 + 8 * fq;
#pragma unroll
        for (int ai = 0; ai < 2; ++ai)
#pragma unroll
            for (int m = 0; m < 4; ++m) { bf16_t* rowp = O + (size_t)(row0 + ai * HALF + m * 16) * ldc + col0;
#pragma unroll
                for (int bj = 0; bj < 2; ++bj) { const f32x4 v0 = acc[ai][bj][m][0] * scale, v1 = acc[ai][bj][m][1] * scale;
                    u32x4 w; w.x = cvt_pk_bf16(v0[0], v0[1]); w.y = cvt_pk_bf16(v0[2], v0[3]); w.z = cvt_pk_bf16(v1[0], v1[1]); w.w = cvt_pk_bf16(v1[2], v1[3]);
                    *(u32x4*)(rowp + bj * HALF) = w; } }
    }
};

struct EpiK {
    static constexpr bool PERM = true, AFTER_DRAIN = false;
    bf16_t* O; int ldc; float* kmean; unsigned* kabs; float sin;
    __device__ __forceinline__ void operator()(const f32x4 (&acc)[2][2][4][2], const Unit& u, int wr, int wc, int fr, int fq) const {
        const int row0 = u.pm * BM + wr * 64 + fr, col0 = u.pn * BM + wc * 32 + 8 * fq;
        f32x4 cs[2][2];
#pragma unroll
        for (int bj = 0; bj < 2; ++bj)
#pragma unroll
            for (int n = 0; n < 2; ++n) cs[bj][n] = (f32x4){0.f, 0.f, 0.f, 0.f};
#pragma unroll
        for (int ai = 0; ai < 2; ++ai)
#pragma unroll
            for (int m = 0; m < 4; ++m) { bf16_t* rowp = O + (size_t)(row0 + ai * HALF + m * 16) * ldc + col0;
#pragma unroll
                for (int bj = 0; bj < 2; ++bj) { const f32x4 v0 = acc[ai][bj][m][0] * sin, v1 = acc[ai][bj][m][1] * sin; cs[bj][0] += v0; cs[bj][1] += v1;
                    u32x4 w; w.x = cvt_pk_bf16(v0[0], v0[1]); w.y = cvt_pk_bf16(v0[2], v0[3]); w.z = cvt_pk_bf16(v1[0], v1[1]); w.w = cvt_pk_bf16(v1[2], v1[3]);
                    *(u32x4*)(rowp + bj * HALF) = w; } }
        const int b = u.pm >> 4, nb = u.pm & 15;
#pragma unroll
        for (int bj = 0; bj < 2; ++bj) {
            float mx = 0.f;
#pragma unroll
            for (int ai = 0; ai < 2; ++ai)
#pragma unroll
                for (int m = 0; m < 4; ++m)
#pragma unroll
                    for (int n = 0; n < 2; ++n)
#pragma unroll
                        for (int e = 0; e < 4; ++e) mx = fmaxf(mx, fabsf(acc[ai][bj][m][n][e]) * sin);
#pragma unroll
            for (int o = 32; o >= 1; o >>= 1) mx = fmaxf(mx, __shfl_xor(mx, o));
            if (fr == 0 && fq == 0) atomicMax(kabs + (b * 16 + ((u.pn * BM + bj * HALF + wc * 32) >> 6)) * 16 + nb, __float_as_uint(mx));
        }
#pragma unroll
        for (int bj = 0; bj < 2; ++bj)
#pragma unroll
            for (int n = 0; n < 2; ++n)
#pragma unroll
                for (int e = 0; e < 4; ++e) { float s = cs[bj][n][e];
                    s += __shfl_xor(s, 1); s += __shfl_xor(s, 2); s += __shfl_xor(s, 4); s += __shfl_xor(s, 8);
                    if (fr == 0) { const int c = col0 + bj * HALF + 4 * n + e, h = c >> 6, d = c & 63;
                        atomicAdd(kmean + ((size_t)((b * 16 + h) * 16 + nb) * 64 + d), s * (1.0f / 256.0f)); } }
    }
};

__device__ __forceinline__ float bf_lo(unsigned w) { return __uint_as_float(w << 16); }
__device__ __forceinline__ float bf_hi(unsigned w) { return __uint_as_float(w & 0xffff0000u); }
template <bool XF32> struct EpiResid {
    static constexpr bool PERM = true, AFTER_DRAIN = false;
    const void* x; bf16_t* y; const float* gate; int gstride; const float* bias; float alpha; float sin;
    __device__ __forceinline__ void operator()(const f32x4 (&acc)[2][2][4][2], const Unit& u, int wr, int wc, int fr, int fq) const {
        const int row0 = u.pm * BM + wr * 64 + fr, col0 = u.pn * BM + wc * 32 + 8 * fq, b = u.pm >> 4;
        f32x4 gv[2][2], bv[2][2];
#pragma unroll
        for (int bj = 0; bj < 2; ++bj)
#pragma unroll
            for (int n = 0; n < 2; ++n) { const int c = col0 + bj * HALF + n * 4; gv[bj][n] = *(const f32x4*)(gate + (size_t)b * gstride + c) + 1.0f;
                bv[bj][n] = bias ? *(const f32x4*)(bias + c) : (f32x4){0.f, 0.f, 0.f, 0.f}; }
#pragma unroll
        for (int ai = 0; ai < 2; ++ai)
#pragma unroll
            for (int m = 0; m < 4; ++m) { const size_t off = (size_t)(row0 + ai * HALF + m * 16) * 1024 + col0;
#pragma unroll
                for (int bj = 0; bj < 2; ++bj) { f32x4 x0, x1;
                    if constexpr (XF32) { x0 = *(const f32x4*)((const float*)x + off + bj * HALF); x1 = *(const f32x4*)((const float*)x + off + bj * HALF + 4); }
                    else { const u32x4 xw = *(const u32x4*)((const bf16_t*)x + off + bj * HALF); x0 = (f32x4){bf_lo(xw.x), bf_hi(xw.x), bf_lo(xw.y), bf_hi(xw.y)}; x1 = (f32x4){bf_lo(xw.z), bf_hi(xw.z), bf_lo(xw.w), bf_hi(xw.w)}; }
                    const f32x4 o0 = x0 * alpha + gv[bj][0] * (acc[ai][bj][m][0] * sin + bv[bj][0]), o1 = x1 * alpha + gv[bj][1] * (acc[ai][bj][m][1] * sin + bv[bj][1]);
                    u32x4 w; w.x = cvt_pk_bf16(o0[0], o0[1]); w.y = cvt_pk_bf16(o0[2], o0[3]); w.z = cvt_pk_bf16(o1[0], o1[1]); w.w = cvt_pk_bf16(o1[2], o1[3]);
                    *(u32x4*)(y + off + bj * HALF) = w; } }
    }
};

struct EpiMoeOut {
    static constexpr bool PERM = true, AFTER_DRAIN = false;
    bf16_t* O; const int* rowinfo; const float* roww; float sin;
    __device__ __forceinline__ void operator()(const f32x4 (&acc)[2][2][4][2], const Unit& u, int wr, int wc, int fr, int fq) const {
        const int row0 = u.pm * BM + wr * 64 + fr, col0 = (u.pn & 3) * BM + wc * 32 + 8 * fq;
#pragma unroll
        for (int ai = 0; ai < 2; ++ai)
#pragma unroll
            for (int m = 0; m < 4; ++m) { const int r = row0 + ai * HALF + m * 16; const int info = rowinfo[r]; const float w = roww[r] * sin;
                if (info >= 0) { bf16_t* op = O + (size_t)info * 1024 + col0;
#pragma unroll
                    for (int bj = 0; bj < 2; ++bj) { const f32x4 v0 = acc[ai][bj][m][0] * w, v1 = acc[ai][bj][m][1] * w;
                        u32x4 o; o.x = cvt_pk_bf16(v0[0], v0[1]); o.y = cvt_pk_bf16(v0[2], v0[3]); o.z = cvt_pk_bf16(v1[0], v1[1]); o.w = cvt_pk_bf16(v1[2], v1[3]);
                        *(u32x4*)(op + bj * HALF) = o; } } }
    }
};

struct MoeOrder {
    StaticOrder so; const int* tile_e; int nct;
    __device__ void init(int NT, int nct_, int G, int c, const int* te) { so.init(NT * BM, nct_ * BM, G, c); tile_e = te; nct = nct_; }
    __device__ bool next(int i, Unit& u) const { if (!so.next(i, u)) return false; u.pn += __builtin_amdgcn_readfirstlane(tile_e[u.pm]) * nct; return true; }
    __device__ __forceinline__ void a_ready(const Unit&) const {}
    __device__ __forceinline__ void done(const Unit&) const {}
};
}
#define GAS __attribute__((address_space(1)))
#define LAS __attribute__((address_space(3)))
#define XB_TMO      128
#define XB_XCNT(j)  (256  + 64 * (j))
#define XB_XSUB(j)  (1280 + 64 * (j))
#define XB_XGEN(j)  (2304 + 64 * (j))
#define XB_TOP      3328
#define XB_TOPGEN   3392
#define XCD_BAR_WORDS 3456
#define XB_SPIN_CAP (1u << 18)

__device__ __forceinline__ unsigned xb_ld(unsigned* p)              { return __hip_atomic_load(p, __ATOMIC_RELAXED, __HIP_MEMORY_SCOPE_AGENT); }
__device__ __forceinline__ unsigned xb_add(unsigned* p, unsigned v) { return __hip_atomic_fetch_add(p, v, __ATOMIC_RELAXED, __HIP_MEMORY_SCOPE_AGENT); }
__device__ __forceinline__ unsigned xb_xcc_id() { return (unsigned)__builtin_amdgcn_s_getreg((3 << 11) | 20) & 0xFu; }
#define XB_SPIN(cond, bar) do { unsigned _sp = 0; while (cond) { __builtin_amdgcn_s_sleep(1); \
    if ((++_sp & 255u) == 0u) { if (xb_ld(&(bar)[XB_TMO])) break; if (_sp > XB_SPIN_CAP) { atomicAdd(&(bar)[XB_TMO], 1u); break; } } } } while (0)

struct XcdBarrier {
    unsigned* bar; unsigned x;
    volatile LAS unsigned* st;
};

__device__ __forceinline__ XcdBarrier xcd_barrier_post(unsigned* bar, volatile LAS unsigned* st) {
    XcdBarrier b; b.bar = bar; b.x = xb_xcc_id(); b.st = st;
    if (threadIdx.x == 0) (void)xb_add(&bar[XB_XCNT(b.x)], 1u);
    return b;
}
__device__ __forceinline__ void xcd_barrier_complete(unsigned* bar, unsigned x, unsigned& nloc, unsigned& nx) {
    const unsigned G = gridDim.x * gridDim.y * gridDim.z;
    unsigned sum, cnt, mine, sp = 0u;
    for (;;) {
        sum = 0u; cnt = 0u; mine = 0u;
#pragma unroll
        for (unsigned j = 0; j < 16; ++j) { const unsigned c = xb_ld(&bar[XB_XCNT(j)]); sum += c; cnt += (c > 0u) ? 1u : 0u; mine = (j == x) ? c : mine; }
        if (sum == G) break;
        __builtin_amdgcn_s_sleep(1);
        if ((++sp & 255u) == 0u) { if (xb_ld(&bar[XB_TMO])) break; if (sp > XB_SPIN_CAP) { atomicAdd(&bar[XB_TMO], 1u); break; } }
    }
    nloc = mine > 0u ? mine : 1u; nx = cnt > 0u ? cnt : 1u;
}

__device__ __forceinline__ void xcd_barrier(const XcdBarrier& b) {
    asm volatile("s_waitcnt vmcnt(0)" ::: "memory");
    __syncthreads();
    if (threadIdx.x == 0) {
        unsigned* bar = b.bar;
        __builtin_amdgcn_s_waitcnt(0);
        unsigned nloc = b.st[0], nx = b.st[1];
        if (nloc == 0u) { xcd_barrier_complete(bar, b.x, nloc, nx); b.st[0] = nloc; b.st[1] = nx; }
        const unsigned old = xb_add(&bar[XB_XSUB(b.x)], 1u);
        const unsigned gen = old / nloc;
        if (old + 1u == (gen + 1u) * nloc) {
            __builtin_amdgcn_fence(__ATOMIC_RELEASE, "agent");
            asm volatile("s_waitcnt vmcnt(0)" ::: "memory");
            const unsigned og = xb_add(&bar[XB_TOP], 1u);
            const unsigned tg = og / nx;
            if (og + 1u == (tg + 1u) * nx) xb_add(&bar[XB_TOPGEN], 1u);
            else XB_SPIN(xb_ld(&bar[XB_TOPGEN]) == tg, bar);
            __builtin_amdgcn_fence(__ATOMIC_ACQUIRE, "agent");
            xb_add(&bar[XB_XGEN(b.x)], 1u);
            asm volatile("s_waitcnt vmcnt(0)" ::: "memory");
        } else {
            XB_SPIN(xb_ld(&bar[XB_XGEN(b.x)]) == gen, bar);
            __builtin_amdgcn_fence(__ATOMIC_ACQUIRE, "agent");
            asm volatile("s_waitcnt vmcnt(0)" ::: "memory");
        }
    }
    __syncthreads();
}

namespace mk {
using pg8::bf16_t;
typedef unsigned v4u __attribute__((ext_vector_type(4)));
typedef unsigned v2u __attribute__((ext_vector_type(2)));
typedef float f32x4 __attribute__((ext_vector_type(4)));
typedef short bf16x8 __attribute__((ext_vector_type(8)));
typedef short s16x4 __attribute__((ext_vector_type(4)));
typedef float f32x16 __attribute__((ext_vector_type(16)));

constexpr int D = 1024, NB = 4, S = 4096, T = NB * S, DEPTH = 4, NA = 2, CONVK = 31, NH = 16, HD = 64, NBLK = 16, DFF = 2816, NE = 8, DFE = 3584;
constexpr int NWAVES = 8, NTHR = NWAVES * 64, GRID = 256;
constexpr float ALPHA = 1.681792830507429f, LN_EPS = 1e-5f;
constexpr float QSCALE = 0.125f * 1.4426950408889634f, LOG2E = 1.4426950408889634f;
#ifndef FP8_MOE
#define FP8_MOE 1
#endif
#ifndef FP8_CONV
#define FP8_CONV 0
#endif
#ifndef FP8_ATTN
#define FP8_ATTN 0
#endif
#ifndef FP8_FFN
#define FP8_FFN 0
#endif
constexpr float S8_H = 16.f, S8_W13 = 256.f, S8_HM = 8.f, S8_W2 = 1024.f, S8_WP = 256.f, S8_WO = 512.f, S8_U = 16.f;
static_assert(FP8_CONV == 0 && FP8_ATTN == 0, "the e4m3 paths of the conv / attention projections were removed");
constexpr int MAXROWS = 2 * T + NE * 256;

constexpr size_t MiB = 1u << 20;
constexpr size_t WS_CTL = 0, CTL_ZERO_BYTES = 2 * MiB;
constexpr int CW_BAR = 4096;
constexpr size_t WS_KMEAN = 1 * MiB;
constexpr size_t WS_KABS = WS_KMEAN + 512 * 1024;
constexpr size_t WS_MOD = 2 * MiB;
constexpr size_t WS_ROUTE = 3 * MiB;
constexpr size_t RT_TOKE = 0, RT_TOKW = 128 * 1024, RT_RINFO = 256 * 1024, RT_RW = 512 * 1024, RT_CNTWG = 768 * 1024, RT_META = 800 * 1024;
constexpr size_t WS_X0 = 4 * MiB;
constexpr size_t WS_W = 516 * MiB;
constexpr size_t W_CI = WS_W, W_CO = W_CI + 8 * MiB, W_KV = W_CO + 4 * MiB, W_Q = W_KV + 4 * MiB, W_O = W_Q + 4 * MiB, W_F13 = W_O + 4 * MiB, W_F2 = W_F13 + 22 * MiB,
                 W_M13 = W_F2 + 11 * MiB, W_M2 = W_M13 + 224 * MiB, W_END = W_M2 + 112 * MiB;
constexpr size_t WS_Y = W_END, WS_HBF = WS_Y + 64 * MiB, WS_HKV = WS_HBF + 32 * MiB, WS_U = WS_HKV + 32 * MiB, WS_U2 = WS_U + 32 * MiB, WS_K = WS_U2 + 32 * MiB, WS_VT = WS_K + 32 * MiB,
                 WS_HM = WS_VT + 32 * MiB, WS_HPERM = WS_HM + 240 * MiB, WS_MOEO = WS_HPERM + 68 * MiB, WS_END = WS_MOEO + 128 * MiB;
static_assert(W_END == 909 * MiB && WS_END == 1601 * MiB, "d_ws map");
static_assert((size_t)MAXROWS * DFE * 2 <= 240 * MiB && (size_t)MAXROWS * D * 2 <= 68 * MiB, "MoE buffers");
constexpr size_t NAIVE_BASE = 516 * MiB;

constexpr int RING_BYTES = 131072, LDSCTL_OFF = RING_BYTES, LDS_BYTES = 147456;

#define RLX_AGENT __ATOMIC_RELAXED, __HIP_MEMORY_SCOPE_AGENT
__device__ __forceinline__ float bf2f(unsigned short h) { return __uint_as_float((unsigned)h << 16); }
__device__ __forceinline__ float bflo(unsigned w) { return __uint_as_float(w << 16); }
__device__ __forceinline__ float bfhi(unsigned w) { return __uint_as_float(w & 0xffff0000u); }
__device__ __forceinline__ unsigned pk2(float lo, float hi) { return pg8::cvt_pk_bf16(lo, hi); }
__device__ __forceinline__ float wave_sum(float v) {
#pragma unroll
    for (int o = 1; o < 64; o <<= 1) v += __shfl_xor(v, o);
    return v;
}
__device__ __forceinline__ float silu_f(float v) { return v * __builtin_amdgcn_rcpf(1.0f + __expf(-v)); }

struct Args { const float* in[25]; float* out; unsigned char* ws; int ph_lo, ph_hi; };

__device__ __forceinline__ void mod_unit(int unit, const float* ada_w, const float* ada_b, const float* kv_ada_w, const float* kv_ada_b, float* mod, LAS float* ca, LAS float* red, int wave, int lane) {
    const int col = unit * 64 + lane, NMAIN = DEPTH * 6 * D;
    const float* w; int ldw; float bias; float* outp; int ostride;
    if (col < NMAIN) { const int l = col / (6 * D), j = col % (6 * D); w = ada_w + (size_t)l * D * 6 * D + j; ldw = 6 * D; bias = ada_b[l * 6 * D + j]; outp = mod + (size_t)l * NB * 6 * D + j; ostride = 6 * D; }
    else { const int j = col - NMAIN; w = kv_ada_w + j; ldw = 2 * D; bias = kv_ada_b[j]; outp = mod + (size_t)DEPTH * NB * 6 * D + j; ostride = 2 * D; }
    float a0 = 0.f, a1 = 0.f, a2 = 0.f, a3 = 0.f;
    const int k0 = wave * 128;
#pragma unroll 8
    for (int k = k0; k < k0 + 128; ++k) { const float wv = w[(size_t)k * ldw]; a0 += ca[k] * wv; a1 += ca[D + k] * wv; a2 += ca[2 * D + k] * wv; a3 += ca[3 * D + k] * wv; }
    red[(wave * 4 + 0) * 64 + lane] = a0; red[(wave * 4 + 1) * 64 + lane] = a1; red[(wave * 4 + 2) * 64 + lane] = a2; red[(wave * 4 + 3) * 64 + lane] = a3;
    __syncthreads();
    if (wave < 4) { float s = 0.f;
#pragma unroll
        for (int q = 0; q < 8; ++q) s += red[(q * 4 + wave) * 64 + lane];
        outp[(size_t)wave * ostride] = s + bias; }
    __syncthreads();
}

__device__ __forceinline__ void conv_item(const float* W, int K, int N, int gateF, bf16_t* WT, int item, LAS unsigned* scr, int lane) {
    const int nblk = N / 64, kb = item / nblk, nb = item % nblk, k0 = 64 * kb, n0 = 64 * nb;
    const int kr = lane >> 4, nc = (lane & 15) * 4;
#pragma unroll
    for (int p = 0; p < 8; ++p) {
        const int k = 8 * p + 2 * kr;
        const f32x4 v0 = *(const f32x4*)(W + (size_t)(k0 + k) * N + n0 + nc), v1 = *(const f32x4*)(W + (size_t)(k0 + k + 1) * N + n0 + nc);
#pragma unroll
        for (int j = 0; j < 4; ++j) scr[(nc + j) * 33 + 4 * p + kr] = pk2(v0[j], v1[j]);
    }
    asm volatile("s_waitcnt lgkmcnt(0)" ::: "memory");
    int drow0;
    if (gateF) { const int half = n0 / gateF, jj = n0 % gateF; drow0 = (jj / 128) * 256 + half * 128 + (jj % 128); } else drow0 = n0;
    const int c = lane & 7;
#pragma unroll
    for (int jj = 0; jj < 8; ++jj) { const int n = (lane >> 3) + 8 * jj; const LAS unsigned* s = scr + n * 33 + 4 * c;
        v4u o; o.x = s[0]; o.y = s[1]; o.z = s[2]; o.w = s[3];
        *(v4u*)(WT + (size_t)(drow0 + n) * K + k0 + 8 * c) = o; }
    asm volatile("s_waitcnt lgkmcnt(0)" ::: "memory");
}
__device__ __forceinline__ void conv_item8(const float* W, int K, int N, int gateF, unsigned char* WT, int item, float scale, LAS unsigned* scr, int lane) {
    const int nblk = N / 64, kb = item / nblk, nb = item % nblk, k0 = 64 * kb, n0 = 64 * nb;
    const int kr = lane >> 4, nc = (lane & 15) * 4;
#pragma unroll
    for (int p = 0; p < 4; ++p) {
        const int k = 16 * p + 4 * kr;
        const float* wp = W + (size_t)(k0 + k) * N + n0 + nc;
        const f32x4 v0 = *(const f32x4*)wp * scale, v1 = *(const f32x4*)(wp + N) * scale, v2 = *(const f32x4*)(wp + 2 * (size_t)N) * scale, v3 = *(const f32x4*)(wp + 3 * (size_t)N) * scale;
#pragma unroll
        for (int j = 0; j < 4; ++j) scr[(nc + j) * 17 + 4 * p + kr] = pg8::cvt4_fp8(v0[j], v1[j], v2[j], v3[j]);
    }
    asm volatile("s_waitcnt lgkmcnt(0)" ::: "memory");
    int drow0;
    if (gateF) { const int half = n0 / gateF, jj = n0 % gateF; drow0 = (jj / 128) * 256 + half * 128 + (jj % 128); } else drow0 = n0;
    const int c = lane & 3;
#pragma unroll
    for (int jj = 0; jj < 4; ++jj) { const int n = (lane >> 2) + 16 * jj; const LAS unsigned* sp = scr + n * 17 + 4 * c;
        v4u o; o.x = sp[0]; o.y = sp[1]; o.z = sp[2]; o.w = sp[3];
        *(v4u*)(WT + (size_t)(drow0 + n) * K + k0 + 16 * c) = o; }
    asm volatile("s_waitcnt lgkmcnt(0)" ::: "memory");
}
struct ConvGroup { int src; int count, K, N, gateF; size_t dst; float s8; };
__device__ __forceinline__ ConvGroup conv_group(int g) {
    switch (g) {
        case 0: return {6, 2, D, 2 * D, D, W_CI, FP8_CONV ? S8_WP : 0.f};      case 1: return {12, 2, D, D, 0, W_CO, FP8_CONV ? S8_WO : 0.f};   case 2: return {16, 1, D, 2 * D, 0, W_KV, FP8_ATTN ? S8_WP : 0.f};
        case 3: return {17, 2, D, D, 0, W_Q, FP8_ATTN ? S8_WP : 0.f};          case 4: return {18, 2, D, D, 0, W_O, FP8_ATTN ? S8_WO : 0.f};
        case 5: return {19, 2, D, 2 * DFF, DFF, W_F13, FP8_FFN ? S8_W13 : 0.f};   case 6: return {20, 2, DFF, D, 0, W_F2, FP8_FFN ? S8_W2 : 0.f};
        case 7: return {23, 16, D, 2 * DFE, DFE, W_M13, FP8_MOE ? S8_W13 : 0.f};  default: return {24, 16, DFE, D, 0, W_M2, FP8_MOE ? S8_W2 : 0.f};
    }
}
constexpr int CG7_PER = (D / 64) * (2 * DFE / 64), CG8_PER = (DFE / 64) * (D / 64);
__device__ __forceinline__ void conv_range(const Args& a, unsigned char* ws, int g, int i0, int i1, LAS unsigned* scr, int gw, int ngw, int lane) {
    const ConvGroup G = conv_group(g);
    const int per = (G.K / 64) * (G.N / 64), eb = G.s8 > 0.f ? 1 : 2;
    for (int i = i0 + gw; i < i1; i += ngw) { const int m = i / per, it = i % per;
        const float* W = a.in[G.src] + (size_t)m * G.K * G.N; unsigned char* WT = ws + G.dst + (size_t)m * G.K * G.N * eb;
        if (G.s8 > 0.f) conv_item8(W, G.K, G.N, G.gateF, WT, it, G.s8, scr, lane); else conv_item(W, G.K, G.N, G.gateF, (bf16_t*)WT, it, scr, lane); }
}
#ifndef MOE1_IN_P0_PCT
#define MOE1_IN_P0_PCT 100
#endif
#ifndef MOE3_IN_E2_PCT
#define MOE3_IN_E2_PCT 100
#endif
constexpr int M1A7 = (8 * CG7_PER * MOE1_IN_P0_PCT / 100) & ~63, M1A8 = (8 * CG8_PER * MOE1_IN_P0_PCT / 100) & ~63;
constexpr int M3A7 = 8 * CG7_PER + ((8 * CG7_PER * MOE3_IN_E2_PCT / 100) & ~63), M3A8 = 8 * CG8_PER + ((8 * CG8_PER * MOE3_IN_E2_PCT / 100) & ~63);
__device__ __forceinline__ void tail_convert(const Args& a, unsigned char* ws, int g7lo, int g7hi, int g8lo, int g8hi, int rem, LAS unsigned char* lds, int wg, int G, int wave, int lane) {
    const int first = (rem > 0 && rem < G) ? rem : 0;
    if (wg < first) return;
    LAS unsigned* scr = (LAS unsigned*)(lds + 32768 + wave * 8448);
    const int gw = (wg - first) * NWAVES + wave, ngw = (G - first) * NWAVES;
    conv_range(a, ws, 7, g7lo, g7hi, scr, gw, ngw, lane);
    conv_range(a, ws, 8, g8lo, g8hi, scr, gw, ngw, lane);
}

struct RowArgs {
    int mode;
    const void* x_in; const bf16_t* y; const bf16_t* moeo; const float* gate; int gstride;
    const float* lng; const float* lnb; bf16_t* x_out; float* x_out32;
    const float* sh; const float* sc; int mstride; bf16_t* h_out;
    unsigned char* h8_out;
    const float* kvsh; const float* kvsc; bf16_t* hkv_out; unsigned char* hkv8_out;
    const float* rw; const float* rb; int* tok_e; float* tok_w; int* cntwg;
};
__device__ __forceinline__ void unpack8(const v4u w, f32x4& lo, f32x4& hi) { lo = (f32x4){bflo(w.x), bfhi(w.x), bflo(w.y), bfhi(w.y)}; hi = (f32x4){bflo(w.z), bfhi(w.z), bflo(w.w), bfhi(w.w)}; }
__device__ __forceinline__ v4u pack8(const f32x4 lo, const f32x4 hi) { v4u w; w.x = pk2(lo[0], lo[1]); w.y = pk2(lo[2], lo[3]); w.z = pk2(hi[0], hi[1]); w.w = pk2(hi[2], hi[3]); return w; }
template <int RB  >
__device__ __forceinline__ void row_phase(const RowArgs& A, LAS unsigned char* lds, int wg, int tid, int wave, int lane) {
    LAS float* rwT = (LAS float*)lds;
    LAS int* lcnt = (LAS int*)(lds + 32768);
    const bool route = A.rw != nullptr;
    if (route) {
        for (int i = tid; i < D * NE; i += NTHR) { const int d = i >> 3, e = i & 7; rwT[e * D + d] = A.rw[i]; }
        if (tid < NE) lcnt[tid] = 0;
        __syncthreads();
    }
    for (int ib = 0; ib < 8 / RB; ++ib) {
      v4u ry[RB][2], rm0[RB][2], rm1[RB][2]; f32x4 rx[RB][2][2];
#pragma unroll
      for (int ii = 0; ii < RB; ++ii) { const int t = wg * 64 + (ib * RB + ii) * 8 + wave;
#pragma unroll
          for (int j = 0; j < 2; ++j) { const int c = 8 * lane + 512 * j;
              if (A.mode == 0) { const f32x4* xp = (const f32x4*)((const float*)A.x_in + (size_t)t * D + c); rx[ii][j][0] = xp[0]; rx[ii][j][1] = xp[1]; }
              else if (A.mode == 1) ry[ii][j] = *(const v4u*)(A.y + (size_t)t * D + c);
              else { ry[ii][j] = *(const v4u*)((const bf16_t*)A.x_in + (size_t)t * D + c); rm0[ii][j] = *(const v4u*)(A.moeo + (size_t)(2 * t) * D + c); rm1[ii][j] = *(const v4u*)(A.moeo + (size_t)(2 * t + 1) * D + c); } } }
#pragma unroll
      for (int ii = 0; ii < RB; ++ii) {
        const int t = wg * 64 + (ib * RB + ii) * 8 + wave, b = t >> 12;
        f32x4 v[2][2];
        if (A.mode == 0) {
#pragma unroll
            for (int j = 0; j < 2; ++j) { v[j][0] = rx[ii][j][0]; v[j][1] = rx[ii][j][1]; }
        } else {
            if (A.mode == 1) {
#pragma unroll
                for (int j = 0; j < 2; ++j) unpack8(ry[ii][j], v[j][0], v[j][1]);
            } else {
#pragma unroll
                for (int j = 0; j < 2; ++j) { const int c = 8 * lane + 512 * j; f32x4 x0, x1, a0, a1, b0, b1;
                    unpack8(ry[ii][j], x0, x1); unpack8(rm0[ii][j], a0, a1); unpack8(rm1[ii][j], b0, b1);
                    const f32x4 g0 = *(const f32x4*)(A.gate + (size_t)b * A.gstride + c), g1 = *(const f32x4*)(A.gate + (size_t)b * A.gstride + c + 4);
                    v[j][0] = x0 * ALPHA + (g0 + 1.0f) * (a0 + b0); v[j][1] = x1 * ALPHA + (g1 + 1.0f) * (a1 + b1); }
            }
            float s = 0.f;
#pragma unroll
            for (int j = 0; j < 2; ++j)
#pragma unroll
                for (int q = 0; q < 2; ++q) s += (v[j][q][0] + v[j][q][1]) + (v[j][q][2] + v[j][q][3]);
            const float mean = wave_sum(s) * (1.0f / D); float qq = 0.f;
#pragma unroll
            for (int j = 0; j < 2; ++j)
#pragma unroll
                for (int q = 0; q < 2; ++q) { v[j][q] = v[j][q] - mean; qq += (v[j][q][0] * v[j][q][0] + v[j][q][1] * v[j][q][1]) + (v[j][q][2] * v[j][q][2] + v[j][q][3] * v[j][q][3]); }
            const float rstd = rsqrtf(wave_sum(qq) * (1.0f / D) + LN_EPS);
#pragma unroll
            for (int j = 0; j < 2; ++j) { const int c = 8 * lane + 512 * j;
#pragma unroll
                for (int q = 0; q < 2; ++q) { const f32x4 g = *(const f32x4*)(A.lng + c + 4 * q), bb = *(const f32x4*)(A.lnb + c + 4 * q); v[j][q] = v[j][q] * rstd * g + bb; }
                if (A.x_out) *(v4u*)(A.x_out + (size_t)t * D + c) = pack8(v[j][0], v[j][1]);
                if (A.x_out32) { f32x4* op = (f32x4*)(A.x_out32 + (size_t)t * D + c); op[0] = v[j][0]; op[1] = v[j][1]; } }
        }
        if (A.hkv_out || A.hkv8_out) {
#pragma unroll
            for (int j = 0; j < 2; ++j) { const int c = 8 * lane + 512 * j; f32x4 h[2];
#pragma unroll
                for (int q = 0; q < 2; ++q) { const f32x4 sc = *(const f32x4*)(A.kvsc + (size_t)b * 2 * D + c + 4 * q), sh = *(const f32x4*)(A.kvsh + (size_t)b * 2 * D + c + 4 * q); h[q] = v[j][q] * (sc + 1.0f) + sh; }
                if (A.hkv_out) *(v4u*)(A.hkv_out + (size_t)t * D + c) = pack8(h[0], h[1]);
                if (A.hkv8_out) { v2u w; w.x = pg8::cvt4_fp8(h[0][0] * S8_H, h[0][1] * S8_H, h[0][2] * S8_H, h[0][3] * S8_H); w.y = pg8::cvt4_fp8(h[1][0] * S8_H, h[1][1] * S8_H, h[1][2] * S8_H, h[1][3] * S8_H);
                    *(v2u*)(A.hkv8_out + (size_t)t * D + c) = w; } }
        }
        if (A.h_out || A.h8_out) {
            float lg[NE];
#pragma unroll
            for (int e = 0; e < NE; ++e) lg[e] = 0.f;
#pragma unroll
            for (int j = 0; j < 2; ++j) { const int c = 8 * lane + 512 * j; f32x4 h[2];
#pragma unroll
                for (int q = 0; q < 2; ++q) { const f32x4 sc = *(const f32x4*)(A.sc + (size_t)b * A.mstride + c + 4 * q), sh = *(const f32x4*)(A.sh + (size_t)b * A.mstride + c + 4 * q); h[q] = v[j][q] * (sc + 1.0f) + sh; }
                if (A.h_out) *(v4u*)(A.h_out + (size_t)t * D + c) = pack8(h[0], h[1]);
                if (A.h8_out) { v2u w; w.x = pg8::cvt4_fp8(h[0][0] * S8_H, h[0][1] * S8_H, h[0][2] * S8_H, h[0][3] * S8_H); w.y = pg8::cvt4_fp8(h[1][0] * S8_H, h[1][1] * S8_H, h[1][2] * S8_H, h[1][3] * S8_H);
                    *(v2u*)(A.h8_out + (size_t)t * D + c) = w; }
                if (route) {
#pragma unroll
                    for (int e = 0; e < NE; ++e)
#pragma unroll
                        for (int q = 0; q < 2; ++q) { const f32x4 r = *(const LAS f32x4*)(rwT + e * D + c + 4 * q); lg[e] += (h[q][0] * r[0] + h[q][1] * r[1]) + (h[q][2] * r[2] + h[q][3] * r[3]); }
                } }
            if (route) {
#pragma unroll
                for (int e = 0; e < NE; ++e) lg[e] = wave_sum(lg[e]) + A.rb[e];
                int e0 = 0; float v0 = lg[0];
#pragma unroll
                for (int e = 1; e < NE; ++e) if (lg[e] > v0) { v0 = lg[e]; e0 = e; }
                int e1 = -1; float v1 = 0.f;
#pragma unroll
                for (int e = 0; e < NE; ++e) if (e != e0 && (e1 < 0 || lg[e] > v1)) { v1 = lg[e]; e1 = e; }
                if (lane == 0) { const float p1 = __expf(v1 - v0), w0 = 1.0f / (1.0f + p1);
                    A.tok_e[t * 2] = e0; A.tok_e[t * 2 + 1] = e1; A.tok_w[t * 2] = w0; A.tok_w[t * 2 + 1] = p1 * w0;
                    __hip_atomic_fetch_add(lcnt + e0, 1, __ATOMIC_RELAXED, __HIP_MEMORY_SCOPE_WORKGROUP); __hip_atomic_fetch_add(lcnt + e1, 1, __ATOMIC_RELAXED, __HIP_MEMORY_SCOPE_WORKGROUP); }
            }
        }
      }
    }
    if (route) { __syncthreads(); if (tid < NE) A.cntwg[wg * NE + tid] = lcnt[tid]; }
    __syncthreads();
}

__device__ __forceinline__ void moe_assign(const int* cntwg, const int* tok_e, const float* tok_w, int* rowinfo, float* roww, int* meta, const unsigned char* hsrc, unsigned char* hperm, const int rowbytes,
                                           LAS unsigned char* lds, int wg, int tid, int wave, int lane) {
    LAS int* arr = (LAS int*)lds;
    LAS int* tot = (LAS int*)(lds + 8192);
    LAS int* mybase = (LAS int*)(lds + 8192 + 64);
    LAS int* earr = (LAS int*)(lds + 8192 + 128);
    LAS int* posarr = (LAS int*)(lds + 8192 + 128 + 512);
    { const v4u c4 = *((const v4u*)cntwg + tid); *((LAS v4u*)arr + tid) = c4; }
    if (tid < 128) earr[tid] = tok_e[wg * 128 + tid];
    __syncthreads();
    {
        const int e = wave; int s4[4]; int s = 0;
#pragma unroll
        for (int q = 0; q < 4; ++q) { s4[q] = arr[(4 * lane + q) * 8 + e]; s += s4[q]; }
        int inc = s;
#pragma unroll
        for (int o = 1; o < 64; o <<= 1) { const int y = __shfl_up(inc, o); if (lane >= o) inc += y; }
        const int total = __shfl(inc, 63);
        int excl = inc - s;
        const int lc = wg >> 2, qc = wg & 3;
#pragma unroll
        for (int q = 0; q < 4; ++q) if (q < qc) excl += s4[q];
        const int mine = __shfl(excl, lc);
        if (lane == 0) { tot[e] = total; mybase[e] = mine; }
    }
    __syncthreads();
    int off[NE + 1]; { int s = 0;
#pragma unroll
        for (int e = 0; e < NE; ++e) { off[e] = s; s += (tot[e] + 255) & ~255; } off[NE] = s; }
    if (tid < 128) {
        const int e = earr[tid]; int rank = 0;
        for (int j = 0; j < tid; ++j) rank += (earr[j] == e) ? 1 : 0;
        int o = 0;
#pragma unroll
        for (int q = 0; q < NE; ++q) o = (q == e) ? off[q] : o;
        const int pos = o + mybase[e] + rank;
        posarr[tid] = pos; rowinfo[pos] = wg * 128 + tid; roww[pos] = tok_w[wg * 128 + tid];
    }
    __syncthreads();
    for (int it = wave; it < 128; it += NWAVES) {
        const int tok = wg * 64 + (it >> 1), pos = posarr[it];
        const v4u* src = (const v4u*)(hsrc + (size_t)tok * rowbytes); v4u* dst = (v4u*)(hperm + (size_t)pos * rowbytes);
        if (rowbytes == 2048) { const v4u a = src[lane], b = src[lane + 64]; dst[lane] = a; dst[lane + 64] = b; } else { dst[lane] = src[lane]; }
    }
    if (wg == 0) {
#pragma unroll
        for (int e = 0; e < NE; ++e) for (int r = off[e] + tot[e] + tid; r < off[e + 1]; r += NTHR) { rowinfo[r] = -1; roww[r] = 0.f; }
        const int NT = off[NE] >> 8;
        if (tid <= NE) { int o = 0;
#pragma unroll
            for (int q = 0; q <= NE; ++q) o = (q == tid) ? off[q] : o;
            meta[tid] = o; }
        if (tid == 0) meta[9] = NT;
        for (int tI = tid; tI < NT; tI += NTHR) { int e = 0;
#pragma unroll
            for (int q = 1; q < NE; ++q) if (tI * 256 >= off[q]) e = q;
            meta[16 + tI] = e; }
    }
    __syncthreads();
}

__device__ __forceinline__ void conv_phase(const bf16_t* u, const float* wdw, const float* bdw, const float* gn, const float* bn, bf16_t* u2, LAS unsigned char* lds, int wg, int tid, int wave, int lane) {
    LAS f32x4* wl = (LAS f32x4*)lds;
    for (int i = tid; i < CONVK * D / 4; i += NTHR) wl[i] = *((const f32x4*)wdw + i);
    __syncthreads();
    for (int it = 0; it < 2; ++it) {
        const int tb = wg * 64 + it * 32 + wave * 4;
        const int ts0 = (tb & (S - 1)) - (CONVK - 1);
        const bf16_t* ub = u + (ptrdiff_t)(tb - (CONVK - 1)) * D + 8 * lane;
        f32x4 acc[4][4];
#pragma unroll
        for (int o = 0; o < 4; ++o)
#pragma unroll
            for (int q = 0; q < 4; ++q) acc[o][q] = *(const f32x4*)(bdw + 8 * lane + 512 * (q >> 1) + 4 * (q & 1));
        f32x4 wwin[4][4];
#pragma unroll
        for (int r = 0; r < CONVK + 3; ++r) {
            if (r < CONVK) {
#pragma unroll
                for (int q = 0; q < 4; ++q) wwin[r & 3][q] = wl[r * 256 + 2 * lane + 128 * (q >> 1) + (q & 1)];
            }
            if (ts0 + r >= 0) {
                f32x4 uv[4];
#pragma unroll
                for (int j = 0; j < 2; ++j) unpack8(*(const v4u*)(ub + (ptrdiff_t)r * D + 512 * j), uv[2 * j], uv[2 * j + 1]);
#pragma unroll
                for (int o = 0; o < 4; ++o) { const int k = r - o; if (k >= 0 && k < CONVK) {
#pragma unroll
                        for (int q = 0; q < 4; ++q) acc[o][q] += uv[q] * wwin[k & 3][q]; } }
            }
        }
#pragma unroll
        for (int o = 0; o < 4; ++o) {
            float sm = 0.f;
#pragma unroll
            for (int q = 0; q < 4; ++q) sm += (acc[o][q][0] + acc[o][q][1]) + (acc[o][q][2] + acc[o][q][3]);
            const float mean = wave_sum(sm) * (1.0f / D); float qq = 0.f;
#pragma unroll
            for (int q = 0; q < 4; ++q) { acc[o][q] = acc[o][q] - mean; qq += (acc[o][q][0] * acc[o][q][0] + acc[o][q][1] * acc[o][q][1]) + (acc[o][q][2] * acc[o][q][2] + acc[o][q][3] * acc[o][q][3]); }
            const float rstd = rsqrtf(wave_sum(qq) * (1.0f / D) + LN_EPS);
#pragma unroll
            for (int j = 0; j < 2; ++j) { f32x4 y[2];
#pragma unroll
                for (int hh = 0; hh < 2; ++hh) { const int c = 8 * lane + 512 * j + 4 * hh; const f32x4 v = acc[o][2 * j + hh] * rstd * *(const f32x4*)(gn + c) + *(const f32x4*)(bn + c);
                    y[hh] = (f32x4){silu_f(v[0]), silu_f(v[1]), silu_f(v[2]), silu_f(v[3])}; }
                *(v4u*)(u2 + (size_t)(tb + o) * D + 8 * lane + 512 * j) = pack8(y[0], y[1]); }
        }
    }
    __syncthreads();
}

constexpr int AT_QM = 4096 + 2 * 64 * 144 + 2 * 64 * 136, AT_KM = 0, AT_K = 4096, AT_KPITCH = 144, AT_KBUF = 64 * AT_KPITCH, AT_V = AT_K + 2 * AT_KBUF, AT_VPITCH = 136, AT_VBUF = 64 * AT_VPITCH;
__device__ __forceinline__ void attn_unit(int b, int h, int qi, const bf16_t* Q, const bf16_t* K, const bf16_t* Vt, const float* kmean, const float* kabs, bf16_t* O, LAS unsigned char* lds, int tid, int wave, int lane) {
    const int r32 = lane & 31, hi = lane >> 5;
    const int q0 = qi * 256;
    if (tid < 256) *((LAS f32x4*)(lds + AT_KM) + tid) = *((const f32x4*)(kmean + (size_t)(b * NH + h) * NBLK * HD) + tid);
    const bf16_t* qrow = Q + (size_t)(b * S + q0 + wave * 32 + r32) * D + h * HD;
    bf16x8 qr[4];
#pragma unroll
    for (int d0 = 0; d0 < 4; ++d0) qr[d0] = *(const bf16x8*)(qrow + d0 * 16 + hi * 8);
    const int srow = tid >> 3, sch = tid & 7;
    const bf16_t* kg = K + (size_t)(b * S + srow) * D + h * HD + sch * 8;
    const bf16_t* vg = Vt + (size_t)(h * HD + srow) * T + b * S + sch * 8;
    const int kst = AT_K + srow * AT_KPITCH + sch * 16, vst = AT_V + srow * AT_VPITCH + sch * 16;
    { float l1 = 0.f;
#pragma unroll
      for (int d0 = 0; d0 < 4; ++d0)
#pragma unroll
          for (int e = 0; e < 8; ++e) l1 += fabsf(bf2f((unsigned short)qr[d0][e]));
      l1 += __shfl_xor(l1, 32);
#pragma unroll
      for (int o = 16; o >= 1; o >>= 1) l1 = fmaxf(l1, __shfl_xor(l1, o));
      if (lane == 0) *((LAS float*)(lds + AT_QM) + wave) = l1; }
    __syncthreads();
    const float slope2 = exp2f(-8.0f * (float)(h + 1) / (float)NH) * LOG2E;
    unsigned livemask = 1u << qi;
    { float qmax = 0.f;
#pragma unroll
      for (int w = 0; w < NWAVES; ++w) qmax = fmaxf(qmax, *((const LAS float*)(lds + AT_QM) + w));
      const float* kab = kabs + (b * NH + h) * NBLK; const float kown = kab[qi];
#pragma unroll
      for (int n = 0; n < NBLK; ++n) if (n < qi) { const float bound = qmax * (kab[n] + kown) * 1.02f + 160.0f; if (!(slope2 * (float)(256 * (qi - n) - 255) > bound)) livemask |= 1u << n; }
      livemask = (unsigned)__builtin_amdgcn_readfirstlane((int)livemask); }
    unsigned remn = livemask; int jn = __builtin_ctz(remn), ttn = 0;
    v4u kreg = *(const v4u*)(kg + (size_t)(4 * jn) * 64 * D), vreg = *(const v4u*)(vg + (size_t)(4 * jn) * 64);
    unsigned selmask = 1u << qi;
    {
        float gate[NBLK];
#pragma unroll
        for (int n = 0; n < NBLK; ++n) {
            float s = 0.f;
            if (n < qi) {
#pragma unroll
                for (int d0 = 0; d0 < 4; ++d0) { const LAS f32x4* kmp = (const LAS f32x4*)(lds + AT_KM + (n * HD + d0 * 16 + hi * 8) * 4); const f32x4 k0 = kmp[0], k1 = kmp[1];
                    s += bf2f((unsigned short)qr[d0][0]) * k0[0] + bf2f((unsigned short)qr[d0][1]) * k0[1] + bf2f((unsigned short)qr[d0][2]) * k0[2] + bf2f((unsigned short)qr[d0][3]) * k0[3]
                       + bf2f((unsigned short)qr[d0][4]) * k1[0] + bf2f((unsigned short)qr[d0][5]) * k1[1] + bf2f((unsigned short)qr[d0][6]) * k1[2] + bf2f((unsigned short)qr[d0][7]) * k1[3]; }
                s += __shfl_xor(s, 32);
            }
            gate[n] = s;
        }
#pragma unroll
        for (int r = 0; r < 3; ++r) {
            int best = -1; float bv = 0.f;
#pragma unroll
            for (int n = 0; n < NBLK; ++n) if (n < qi && !((selmask >> n) & 1u)) { if (best < 0 || gate[n] > bv) { best = n; bv = gate[n]; } }
            if (best >= 0) selmask |= 1u << best;
        }
    }
    f32x16 cb0, cb1;
#pragma unroll
    for (int r = 0; r < 16; ++r) { const int kk = (r & 3) + 8 * (r >> 2) + 4 * hi; cb0[r] = slope2 * (float)kk; cb1[r] = slope2 * (float)(kk + 32); }
    f32x16 o0 = {}, o1 = {};
    float m_run = -1.0e30f, l_run = 0.f;
    const int qrel = wave * 32 + r32;
    for (int it = 0;; ++it) {
        const int buf = it & 1;
        const int j = jn, tt = ttn, tl = 4 * jn + ttn;
        *(LAS v4u*)(lds + kst + buf * AT_KBUF) = kreg;
        *(LAS v2u*)(lds + vst + buf * AT_VBUF) = (v2u){vreg.x, vreg.y}; *(LAS v2u*)(lds + vst + buf * AT_VBUF + 8) = (v2u){vreg.z, vreg.w};
        bool more = true;
        if (++ttn == 4) { ttn = 0; remn &= remn - 1; more = remn != 0u; if (more) jn = __builtin_ctz(remn); }
        if (more) { kreg = *(const v4u*)(kg + (size_t)(4 * jn + ttn) * 64 * D); vreg = *(const v4u*)(vg + (size_t)(4 * jn + ttn) * 64); }
        __syncthreads();
        const bool own = (j == qi);
        const bool rowsel = ((selmask >> j) & 1u) != 0u;
        bool skip = own ? (64 * tt > wave * 32 + 31) : (__builtin_amdgcn_ballot_w64(rowsel) == 0ull);
        if (skip) { if (!more) break; continue; }
        const LAS unsigned char* kb = lds + AT_K + buf * AT_KBUF + r32 * AT_KPITCH + hi * 16;
        f32x16 p0 = cb0, p1 = cb1;
#pragma unroll
        for (int d0 = 0; d0 < 4; ++d0) {
            const bf16x8 a0 = *(const LAS bf16x8*)(kb + d0 * 32), a1 = *(const LAS bf16x8*)(kb + 32 * AT_KPITCH + d0 * 32);
            p0 = __builtin_amdgcn_mfma_f32_32x32x16_bf16(a0, qr[d0], p0, 0, 0, 0);
            p1 = __builtin_amdgcn_mfma_f32_32x32x16_bf16(a1, qr[d0], p1, 0, 0, 0);
        }
        if (own) {
#pragma unroll
            for (int r = 0; r < 16; ++r) { const int kk = 64 * tt + (r & 3) + 8 * (r >> 2) + 4 * hi; if (kk > qrel) p0[r] = -INFINITY; if (kk + 32 > qrel) p1[r] = -INFINITY; }
        }
        float tm = fmaxf(p0[0], p1[0]);
#pragma unroll
        for (int r = 1; r < 16; ++r) tm = fmaxf(tm, fmaxf(p0[r], p1[r]));
        tm = fmaxf(tm, __shfl_xor(tm, 32));
        const float toff = slope2 * (float)(64 * tl - q0 - 255);
        const float mnew = rowsel ? fmaxf(m_run, tm + toff) : m_run;
        const float alpha = __builtin_amdgcn_exp2f(m_run - mnew);
        const float msub = rowsel ? (mnew - toff) : INFINITY;
        m_run = mnew;
        float ls = 0.f;
#pragma unroll
        for (int r = 0; r < 16; ++r) { p0[r] = __builtin_amdgcn_exp2f(p0[r] - msub); p1[r] = __builtin_amdgcn_exp2f(p1[r] - msub); ls += p0[r] + p1[r]; }
        l_run = l_run * alpha + ls;
        if (__builtin_amdgcn_ballot_w64(alpha != 1.0f) != 0ull) { o0 = o0 * alpha; o1 = o1 * alpha; }
        bf16x8 pb[4];
#pragma unroll
        for (int s = 0; s < 4; ++s) {
            unsigned w[4];
#pragma unroll
            for (int q = 0; q < 4; ++q) w[q] = (s < 2) ? pk2(p0[8 * (s & 1) + 2 * q], p0[8 * (s & 1) + 2 * q + 1]) : pk2(p1[8 * (s & 1) + 2 * q], p1[8 * (s & 1) + 2 * q + 1]);
            pb[s] = __builtin_bit_cast(bf16x8, (v4u){w[0], w[1], w[2], w[3]});
        }
        const LAS unsigned char* vb = lds + AT_V + buf * AT_VBUF + r32 * AT_VPITCH + hi * 8;
#pragma unroll
        for (int s = 0; s < 4; ++s) {
            const int kk2 = (32 * (s >> 1) + 16 * (s & 1)) * 2;
            const v2u a0l = *(const LAS v2u*)(vb + kk2), a0h = *(const LAS v2u*)(vb + kk2 + 16);
            const v2u a1l = *(const LAS v2u*)(vb + 32 * AT_VPITCH + kk2), a1h = *(const LAS v2u*)(vb + 32 * AT_VPITCH + kk2 + 16);
            const bf16x8 va0 = __builtin_bit_cast(bf16x8, (v4u){a0l.x, a0l.y, a0h.x, a0h.y}), va1 = __builtin_bit_cast(bf16x8, (v4u){a1l.x, a1l.y, a1h.x, a1h.y});
            o0 = __builtin_amdgcn_mfma_f32_32x32x16_bf16(va0, pb[s], o0, 0, 0, 0);
            o1 = __builtin_amdgcn_mfma_f32_32x32x16_bf16(va1, pb[s], o1, 0, 0, 0);
        }
        if (!more) break;
    }
    const float ltot = l_run + __shfl_xor(l_run, 32);
    const float inv = 1.0f / ltot;
    bf16_t* orow = O + (size_t)(b * S + q0 + wave * 32 + r32) * D + h * HD;
#pragma unroll
    for (int g = 0; g < 4; ++g) {
        v2u w0, w1;
        w0.x = pk2(o0[4 * g] * inv, o0[4 * g + 1] * inv); w0.y = pk2(o0[4 * g + 2] * inv, o0[4 * g + 3] * inv);
        w1.x = pk2(o1[4 * g] * inv, o1[4 * g + 1] * inv); w1.y = pk2(o1[4 * g + 2] * inv, o1[4 * g + 3] * inv);
        *(v2u*)(orow + 8 * g + 4 * hi) = w0; *(v2u*)(orow + 32 + 8 * g + 4 * hi) = w1;
    }
    __syncthreads();
}
struct AttnOrder { unsigned char hq[256]; };
constexpr AttnOrder make_attn_order() {
    AttnOrder o{}; int cost[256] = {}; const int nb[16] = {1, 2, 2, 3, 4, 6, 8, 11, 15, 15, 15, 15, 15, 15, 15, 15};
    for (int k = 0; k < 256; ++k) { const int h = k >> 4, i = k & 15; o.hq[k] = (unsigned char)k; cost[k] = 8 * (i < nb[h] ? i : nb[h]) + 5; }
    for (int a = 1; a < 256; ++a) { const int c = cost[a]; const unsigned char v = o.hq[a]; int q = a - 1; while (q >= 0 && cost[q] < c) { cost[q + 1] = cost[q]; o.hq[q + 1] = o.hq[q]; --q; } cost[q + 1] = c; o.hq[q + 1] = v; }
    return o;
}
__device__ constexpr AttnOrder ATTN_ORDER = make_attn_order();
__device__ __forceinline__ void attn_phase(const bf16_t* Q, const bf16_t* K, const bf16_t* Vt, const float* kmean, const float* kabs, bf16_t* O, LAS unsigned char* lds, int wg, int G, int tid, int wave, int lane) {
    for (int r = 0; r < 4; ++r) {
        const int u = (r == 0) ? wg : (r == 1) ? 511 - wg : (r == 2) ? 512 + wg : 1023 - wg;
        const int hq = ATTN_ORDER.hq[u >> 2], b = u & 3;
        attn_unit(b, hq >> 4, hq & 15, Q, K, Vt, kmean, kabs, O, lds, tid, wave, lane);
    }
}

#ifndef REP_ATTN
#define REP_ATTN 1
#endif
#ifndef REP_B1
#define REP_B1 1
#endif
#ifndef REP_CI
#define REP_CI 1
#endif
#ifndef REP_CONV
#define REP_CONV 1
#endif
#ifndef REP_E0
#define REP_E0 1
#endif
#ifndef REP_E1
#define REP_E1 1
#endif
#ifndef REP_E2
#define REP_E2 1
#endif
#ifndef REP_F1
#define REP_F1 1
#endif
#ifndef REP_F2
#define REP_F2 1
#endif
#ifndef REP_P0
#define REP_P0 1
#endif
#ifndef REP_ROW
#define REP_ROW 1
#endif
#ifndef REP_X3
#define REP_X3 1
#endif
#define PH_BEGIN(REP) if (lo <= ph && ph < hi) { for (int rep_i = 0; rep_i < (REP); ++rep_i) { if (rep_i) xcd_barrier(bar); int tid = threadIdx.x; asm volatile("" : "+v"(tid)); const int lane = tid & 63, wave = __builtin_amdgcn_readfirstlane(tid >> 6); \
                 int wg = blockIdx.x; asm volatile("" : "+s"(wg)); unsigned char* ws = args.ws; asm volatile("" : "+s"(ws)); (void)lane; (void)wave; (void)wg;
#define PH_END   } if (ph + 1 < hi) xcd_barrier(bar); } ++ph;
#define WSP(Ty, off) ((Ty*)(ws + (off)))
#define MODP  WSP(float, WS_MOD)


template <int L> __device__ __forceinline__ void layer_phases(const Args& args, LAS unsigned char* lds, const XcdBarrier& bar, const int lo, const int hi, const int G) {
    constexpr int l = L;
    int ph = 2 + (L >= 1 ? 7 : 0) + (L >= 2 ? 8 : 0) + (L >= 3 ? 7 : 0);
#define MLP   (MODP + (size_t)l * NB * 6 * D)
#define XIN   ((l == 0) ? (const void*)args.in[0] : (const void*)(ws + WS_X0 + (size_t)(2 * l - 1) * 64 * MiB))
#define X1P   ((bf16_t*)(ws + WS_X0 + (size_t)(2 * l) * 64 * MiB))
#define X2P   ((bf16_t*)(ws + WS_X0 + (size_t)(2 * l + 1) * 64 * MiB))
        if (l < NA) {
            PH_BEGIN(REP_CI)
                constexpr bool F8 = FP8_CONV != 0; constexpr int EB = F8 ? 1 : 2;
                pg8::Gemm g{WSP(bf16_t, WS_HBF), (const bf16_t*)(ws + W_CI + (size_t)l * 2 * D * D * EB), T, 2 * D, D * EB / 2}; pg8::StaticOrder So; So.init(T, 2 * D, G, wg);
                pg8::EpiGated<0, 0> E{WSP(bf16_t, WS_U), D, args.in[7] + l * 2 * D, D, F8 ? 1.0f / (S8_H * S8_WP) : 1.0f, 1.0f};
                pg8::gemm_phase<pg8::EpiGated<0, 0>, pg8::StaticOrder, true, true, F8>(lds, g, So, E);
            PH_END
            PH_BEGIN(REP_CONV)
                conv_phase(WSP(bf16_t, WS_U), args.in[8] + l * CONVK * D, args.in[9] + l * D, args.in[10] + l * D, args.in[11] + l * D, WSP(bf16_t, WS_U2), lds, wg, tid, wave, lane);
            PH_END
        } else {
            PH_BEGIN(REP_B1)
                constexpr bool AF8 = FP8_ATTN != 0; constexpr int AEB = AF8 ? 1 : 2;
                if (l == NA) {
                    { pg8::Gemm g{WSP(bf16_t, WS_HKV), WSP(const bf16_t, W_KV), T, D, D * AEB / 2}; pg8::StaticOrder So; So.init(T, D, G, wg);
                      pg8::EpiK E{WSP(bf16_t, WS_K), D, WSP(float, WS_KMEAN), WSP(unsigned, WS_KABS), AF8 ? 1.0f / (S8_H * S8_WP) : 1.0f};
                      pg8::gemm_phase<pg8::EpiK, pg8::StaticOrder, true, true, AF8>(lds, g, So, E); }
                    { pg8::Gemm g{(const bf16_t*)(ws + W_KV + (size_t)D * D * AEB), WSP(bf16_t, WS_HKV), D, T, D * AEB / 2}; pg8::StaticOrder So; So.init(D, T, G, wg);
                      pg8::EpiBf16S E{WSP(bf16_t, WS_VT), T, AF8 ? 1.0f / (S8_H * S8_WP) : 1.0f};
                      pg8::gemm_phase<pg8::EpiBf16S, pg8::StaticOrder, true, true, AF8>(lds, g, So, E); }
                }
                { pg8::Gemm g{WSP(bf16_t, WS_HBF), (const bf16_t*)(ws + W_Q + (size_t)(l - NA) * D * D * AEB), T, D, D * AEB / 2}; pg8::StaticOrder So; So.init(T, D, G, wg);
                  pg8::EpiBf16S E{WSP(bf16_t, WS_U), D, AF8 ? QSCALE / (S8_H * S8_WP) : QSCALE};
                  pg8::gemm_phase<pg8::EpiBf16S, pg8::StaticOrder, true, true, AF8>(lds, g, So, E); }
            PH_END
            PH_BEGIN(REP_ATTN)
                attn_phase(WSP(bf16_t, WS_U), WSP(bf16_t, WS_K), WSP(bf16_t, WS_VT), WSP(float, WS_KMEAN), WSP(float, WS_KABS), WSP(bf16_t, WS_U2), lds, wg, G, tid, wave, lane);
            PH_END
        }
        PH_BEGIN(REP_X3)
            constexpr bool F8 = (L < NA) ? (FP8_CONV != 0) : (FP8_ATTN != 0); constexpr int EB = F8 ? 1 : 2;
            const bf16_t* Bt = (l < NA) ? (const bf16_t*)(ws + W_CO + (size_t)l * D * D * EB) : (const bf16_t*)(ws + W_O + (size_t)(l - NA) * D * D * EB);
            const float* mixbias = (l < NA) ? args.in[13] + l * D : nullptr;
            pg8::Gemm g{WSP(bf16_t, WS_U2), Bt, T, D, D * EB / 2}; pg8::StaticOrder So; So.init(T, D, G, wg);
            pg8::EpiResid<(L == 0)> E{XIN, WSP(bf16_t, WS_Y), MLP + 2 * D, 6 * D, mixbias, ALPHA, F8 ? 1.0f / (S8_U * S8_WO) : 1.0f};
            pg8::gemm_phase<pg8::EpiResid<(L == 0)>, pg8::StaticOrder, true, true, F8>(lds, g, So, E);
        PH_END
        PH_BEGIN(REP_ROW)
            RowArgs A{}; A.mode = 1; A.y = WSP(bf16_t, WS_Y); A.lng = args.in[4] + (l * 2) * D; A.lnb = args.in[5] + (l * 2) * D; A.x_out = X1P;
            A.sh = MLP + 3 * D; A.sc = MLP + 4 * D; A.mstride = 6 * D;
            if (((l & 1) && FP8_MOE) || (!(l & 1) && FP8_FFN)) A.h8_out = WSP(unsigned char, WS_HBF); else A.h_out = WSP(bf16_t, WS_HBF);
            if (l & 1) { A.rw = args.in[21] + (size_t)(l >> 1) * D * NE; A.rb = args.in[22] + (l >> 1) * NE; A.tok_e = WSP(int, WS_ROUTE + RT_TOKE); A.tok_w = WSP(float, WS_ROUTE + RT_TOKW); A.cntwg = WSP(int, WS_ROUTE + RT_CNTWG); }
            row_phase<((L & 1) ? 2 : 4)>(A, lds, wg, tid, wave, lane);
        PH_END
        if ((l & 1) == 0) {
            PH_BEGIN(REP_F1)
                constexpr bool F8 = FP8_FFN != 0; constexpr int EB = F8 ? 1 : 2;
                pg8::Gemm g{WSP(bf16_t, WS_HBF), (const bf16_t*)(ws + W_F13 + (size_t)(l >> 1) * 2 * DFF * D * EB), T, 2 * DFF, D * EB / 2}; pg8::StaticOrder So; So.init(T, 2 * DFF, G, wg);
                pg8::EpiGated<1, 0, F8> E{WSP(bf16_t, WS_HM), DFF, nullptr, 0, F8 ? 1.0f / (S8_H * S8_W13) : 1.0f, S8_HM};
                pg8::gemm_phase<pg8::EpiGated<1, 0, F8>, pg8::StaticOrder, true, true, F8>(lds, g, So, E);
                if (L == 0) tail_convert(args, ws, M1A7, 8 * CG7_PER, M1A8, 8 * CG8_PER, ((T / 256) * (2 * DFF / 256)) % GRID, lds, wg, G, wave, lane);
                else        tail_convert(args, ws, M3A7, 16 * CG7_PER, M3A8, 16 * CG8_PER, ((T / 256) * (2 * DFF / 256)) % GRID, lds, wg, G, wave, lane);
            PH_END
            PH_BEGIN(REP_F2)
                constexpr bool F8 = FP8_FFN != 0; constexpr int EB = F8 ? 1 : 2;
                pg8::Gemm g{WSP(bf16_t, WS_HM), (const bf16_t*)(ws + W_F2 + (size_t)(l >> 1) * D * DFF * EB), T, D, DFF * EB / 2}; pg8::StaticOrder So; So.init(T, D, G, wg);
                pg8::EpiResid<false> E{X1P, WSP(bf16_t, WS_Y), MLP + 5 * D, 6 * D, nullptr, ALPHA, F8 ? 1.0f / (S8_HM * S8_W2) : 1.0f};
                pg8::gemm_phase<pg8::EpiResid<false>, pg8::StaticOrder, true, true, F8>(lds, g, So, E);
            PH_END
        } else {
            PH_BEGIN(REP_E0)
                moe_assign(WSP(int, WS_ROUTE + RT_CNTWG), WSP(int, WS_ROUTE + RT_TOKE), WSP(float, WS_ROUTE + RT_TOKW), WSP(int, WS_ROUTE + RT_RINFO), WSP(float, WS_ROUTE + RT_RW), WSP(int, WS_ROUTE + RT_META),
                           WSP(unsigned char, WS_HBF), WSP(unsigned char, WS_HPERM), FP8_MOE ? 1024 : 2048, lds, wg, tid, wave, lane);
            PH_END
            PH_BEGIN(REP_E1)
                const int* meta = WSP(int, WS_ROUTE + RT_META); const int NT = __builtin_amdgcn_readfirstlane(meta[9]);
                constexpr bool F8 = FP8_MOE != 0; constexpr int EB = F8 ? 1 : 2;
                pg8::Gemm g{WSP(bf16_t, WS_HPERM), (const bf16_t*)(ws + W_M13 + (size_t)(l >> 1) * NE * 2 * DFE * D * EB), NT * 256, 2 * DFE, D * EB / 2}; pg8::MoeOrder So; So.init(NT, 2 * DFE / 256, G, wg, meta + 16);
                pg8::EpiGated<1, 28, F8> E{WSP(bf16_t, WS_HM), DFE, nullptr, 0, F8 ? 1.0f / (S8_H * S8_W13) : 1.0f, S8_HM};
                pg8::gemm_phase<pg8::EpiGated<1, 28, F8>, pg8::MoeOrder, true, true, F8>(lds, g, So, E);
            PH_END
            PH_BEGIN(REP_E2)
                const int* meta = WSP(int, WS_ROUTE + RT_META); const int NT = __builtin_amdgcn_readfirstlane(meta[9]);
                constexpr bool F8 = FP8_MOE != 0; constexpr int EB = F8 ? 1 : 2;
                pg8::Gemm g{WSP(bf16_t, WS_HM), (const bf16_t*)(ws + W_M2 + (size_t)(l >> 1) * NE * D * DFE * EB), NT * 256, D, DFE * EB / 2}; pg8::MoeOrder So; So.init(NT, D / 256, G, wg, meta + 16);
                pg8::EpiMoeOut E{WSP(bf16_t, WS_MOEO), WSP(int, WS_ROUTE + RT_RINFO), WSP(float, WS_ROUTE + RT_RW), F8 ? 1.0f / (S8_HM * S8_W2) : 1.0f};
                pg8::gemm_phase<pg8::EpiMoeOut, pg8::MoeOrder, true, true, F8>(lds, g, So, E);
                if (L == 1) tail_convert(args, ws, 8 * CG7_PER, M3A7, 8 * CG8_PER, M3A8, (NT * (D / 256)) % GRID, lds, wg, G, wave, lane);
            PH_END
        }
        PH_BEGIN(REP_ROW)
            RowArgs A{}; A.lng = args.in[4] + (l * 2 + 1) * D; A.lnb = args.in[5] + (l * 2 + 1) * D; if (l == DEPTH - 1) A.x_out32 = args.out; else A.x_out = X2P;
            if ((l & 1) == 0) { A.mode = 1; A.y = WSP(bf16_t, WS_Y); } else { A.mode = 2; A.x_in = X1P; A.moeo = WSP(bf16_t, WS_MOEO); A.gate = MLP + 5 * D; A.gstride = 6 * D; }
            if (l + 1 < DEPTH) { const float* mn = MODP + (size_t)(l + 1) * NB * 6 * D; A.sh = mn; A.sc = mn + D; A.mstride = 6 * D;
                if ((l + 1 < NA) ? (FP8_CONV != 0) : (FP8_ATTN != 0)) A.h8_out = WSP(unsigned char, WS_HBF); else A.h_out = WSP(bf16_t, WS_HBF); }
            if (l + 1 == NA) { const float* kvmod = MODP + (size_t)DEPTH * NB * 6 * D; A.kvsh = kvmod; A.kvsc = kvmod + D; if (FP8_ATTN) A.hkv8_out = WSP(unsigned char, WS_HKV); else A.hkv_out = WSP(bf16_t, WS_HKV); }
            row_phase<((L & 1) ? 2 : 4)>(A, lds, wg, tid, wave, lane);
        PH_END
}
#undef MLP
#undef XIN
#undef X1P
#undef X2P
__global__ void __launch_bounds__(NTHR, 2) mega_fwd(Args args) {
    extern __shared__ __attribute__((aligned(16))) unsigned char lds_raw[];
    LAS unsigned char* lds = (LAS unsigned char*)lds_raw;
    const int G = gridDim.x;
    for (int u = threadIdx.x; u < (LDS_BYTES - LDSCTL_OFF) / 4; u += NTHR) ((LAS unsigned*)(lds + LDSCTL_OFF))[u] = 0u;
    __syncthreads();
    XcdBarrier bar = xcd_barrier_post((unsigned*)(args.ws + WS_CTL) + CW_BAR, (volatile LAS unsigned*)(lds + LDSCTL_OFF));
    const int lo = args.ph_lo, hi = args.ph_hi;
    int ph = 0;
    PH_BEGIN(REP_P0)
        LAS float* ca = (LAS float*)lds; LAS float* red = (LAS float*)(lds + 16384);
        for (int i = tid; i < NB * D; i += NTHR) ca[i] = silu_f(args.in[1][i]);
        __syncthreads();
        for (int unit = wg; unit < (DEPTH * 6 * D + 2 * D) / 64; unit += G) mod_unit(unit, args.in[2], args.in[3], args.in[14], args.in[15], MODP, ca, red, wave, lane);
        __syncthreads();
        { LAS unsigned* scr = (LAS unsigned*)(lds + 32768 + wave * 8448); const int gw = wg * NWAVES + wave, ngw = G * NWAVES;
#pragma unroll
          for (int g = 0; g < 7; ++g) { const ConvGroup Gq = conv_group(g); conv_range(args, ws, g, 0, Gq.count * (Gq.K / 64) * (Gq.N / 64), scr, (gw + 37 * g) % ngw, ngw, lane); }
          conv_range(args, ws, 7, 0, M1A7, scr, gw, ngw, lane); conv_range(args, ws, 8, 0, M1A8, scr, (gw + 1024) % ngw, ngw, lane); }
    PH_END
    PH_BEGIN(REP_ROW)
        RowArgs A{}; A.mode = 0; A.x_in = args.in[0]; A.sh = MODP; A.sc = MODP + D; A.mstride = 6 * D; if (FP8_CONV) A.h8_out = WSP(unsigned char, WS_HBF); else A.h_out = WSP(bf16_t, WS_HBF);
        row_phase<4>(A, lds, wg, tid, wave, lane);
    PH_END
    layer_phases<0>(args, lds, bar, lo, hi, G);
    layer_phases<1>(args, lds, bar, lo, hi, G);
    layer_phases<2>(args, lds, bar, lo, hi, G);
    layer_phases<3>(args, lds, bar, lo, hi, G);
}
#undef PH_BEGIN
#undef PH_END
constexpr int N_PHASES = 2 + 7 + 8 + 7 + 8;
__host__ inline int phases_through_sublayer(int s) { const int per[4] = {7, 8, 7, 8}; const int l = s / 2; int p = 2; for (int i = 0; i < l; ++i) p += per[i]; p += (s & 1) ? per[l] : 4; return p; }
}
extern "C" void kernel_launch(void* const* d_in, const int* in_sizes, int n_in, void* d_out, int out_size, void* d_ws, size_t ws_size, hipStream_t stream) {
    using namespace mk;
    static int grid = 0;
    if (grid == 0) {
        if (n_in != 25 || in_sizes[0] != T * D || out_size != T * D || ws_size < WS_END) { fprintf(stderr, "kernel_launch: unexpected problem shape / workspace (n_in %d, ws %zu < %zu); nothing launched\n", n_in, ws_size, (size_t)WS_END); grid = -1; return; }
        int dev = 0, cus = 0, per_cu = 0;
        if (hipGetDevice(&dev) != hipSuccess || hipDeviceGetAttribute(&cus, hipDeviceAttributeMultiprocessorCount, dev) != hipSuccess) { grid = -1; return; }
        if (hipFuncSetAttribute((const void*)mega_fwd, hipFuncAttributeMaxDynamicSharedMemorySize, LDS_BYTES) != hipSuccess) { fprintf(stderr, "kernel_launch: hipFuncSetAttribute failed\n"); grid = -1; return; }
        if (hipOccupancyMaxActiveBlocksPerMultiprocessor(&per_cu, (const void*)mega_fwd, NTHR, LDS_BYTES) != hipSuccess || per_cu < 1) { fprintf(stderr, "kernel_launch: occupancy query says %d blocks per CU\n", per_cu); (void)hipGetLastError(); grid = -1; return; }
        if (cus != GRID) { fprintf(stderr, "kernel_launch: built for a 256-CU device (one workgroup per CU), found %d CUs; nothing launched\n", cus); grid = -1; return; }
        grid = GRID;
    }
    if (grid < 0) return;
    (void)hipMemsetAsync((char*)d_ws + WS_CTL, 0, CTL_ZERO_BYTES, stream);
    Args a{};
    for (int i = 0; i < 25; ++i) a.in[i] = (const float*)d_in[i];
    a.out = (float*)d_out; a.ws = (unsigned char*)d_ws;
    const int P = phases_through_sublayer(HYB_SUB);
#if MK_PER_PHASE
    for (int p = 0; p < P; ++p) { a.ph_lo = p; a.ph_hi = p + 1; hipLaunchKernelGGL(mega_fwd, dim3(grid), dim3(NTHR), LDS_BYTES, stream, a); }
#else
    a.ph_lo = 0; a.ph_hi = P;
    hipLaunchKernelGGL(mega_fwd, dim3(grid), dim3(NTHR), LDS_BYTES, stream, a);
#endif
#if HYB_SUB < 7
    nv::forward(d_in, (float*)d_out, (char*)d_ws + NAIVE_BASE, stream, HYB_SUB + 1, (const float*)((char*)d_ws + WS_X0 + (size_t)HYB_SUB * 64 * MiB), (const float*)((char*)d_ws + WS_X0 + (size_t)3 * 64 * MiB));
#endif
}
```

```cpp
#include <hip/hip_runtime.h>
#include <cstdio>
#include <cstdint>
#ifndef HYB_SUB
#define HYB_SUB 7
#endif
#ifndef MK_PER_PHASE
#define MK_PER_PHASE 0
#endif
namespace pg8 {
#define PG8_LAS __attribute__((address_space(3)))
typedef unsigned short bf16_t;
typedef short bf16x8 __attribute__((ext_vector_type(8)));
typedef float f32x4 __attribute__((ext_vector_type(4)));
typedef unsigned u32x4 __attribute__((ext_vector_type(4)));
constexpr int BM = 256, BK = 64, HALF = 128, HTB = HALF * BK * 2  , STAGE_BYTES = 8 * HTB, NXCD = 8, WGM = 8;

__host__ __device__ __forceinline__ int lds_byte(int r, int c) { const int st = (r >> 4) * 2 + (c >> 5), rr = r & 15, cc = c & 31, ob = rr * 64 + cc * 2; return st * 1024 + (ob ^ (((ob >> 9) & 1) << 5)); }
__host__ __device__ __forceinline__ void stage_rc(int b, int& R, int& C) { const int st = b / 1024, sb = b % 1024, swz = sb ^ (((sb >> 9) & 1) << 5); R = (st >> 1) * 16 + swz / 64; C = (st & 1) * 32 + (swz % 64) / 2; }
__host__ __device__ __forceinline__ int perm32(int rho) { const int n = rho >> 4, i = rho & 15; return 8 * (i >> 2) + 4 * n + (i & 3); }

struct Unit { int pm, pn, ko; };
struct Gemm { const bf16_t* A; const bf16_t* Bt; int M, N, K, ld; };

struct StaticOrder {
    int nM, nN, nwg, G, c;
    __host__ __device__ void init(int M, int N, int G_, int c_) { nM = M / BM; nN = N / BM; nwg = nM * nN; G = G_; c = c_; }
    __host__ __device__ bool next(int i, Unit& u) const {
        const long L = (long)i * G + c; if (L >= nwg) return false;
        int wgid = (int)L; { const int q = nwg / NXCD, r = nwg % NXCD, xcd = wgid % NXCD, off = wgid / NXCD; wgid = (xcd < r ? xcd * (q + 1) : r * (q + 1) + (xcd - r) * q) + off; }
        const int nig = WGM * nN, gid = wgid / nig, fm = gid * WGM, gsz = (nM - fm) < WGM ? (nM - fm) : WGM;
        u.pm = fm + ((wgid % nig) % gsz); u.pn = (wgid % nig) / gsz; u.ko = 0; return true;
    }
    __device__ __forceinline__ void a_ready(const Unit&) const {}
    __device__ __forceinline__ void done(const Unit&) const {}
};

__device__ __forceinline__ unsigned cvt_pk_bf16(float lo, float hi) { unsigned r; asm volatile("v_cvt_pk_bf16_f32 %0, %1, %2" : "=v"(r) : "v"(lo), "v"(hi)); return r; }
typedef float f32x2 __attribute__((ext_vector_type(2)));
typedef int i32x4v __attribute__((ext_vector_type(4)));
typedef int i32x8v __attribute__((ext_vector_type(8)));
__device__ __forceinline__ i32x8v cat8(bf16x8 lo, bf16x8 hi) { const i32x4v a = __builtin_bit_cast(i32x4v, lo), b = __builtin_bit_cast(i32x4v, hi); return __builtin_shufflevector(a, b, 0, 1, 2, 3, 4, 5, 6, 7); }
template <class Epi, class Sched, bool ALIGN_EPI = false, bool SP2 = false, bool FP8 = false>
__device__ __forceinline__ void gemm_phase(PG8_LAS unsigned char* lds, const Gemm g, const Sched& S, const Epi& E) {
    int tid_ = threadIdx.x; asm volatile("" : "+v"(tid_));
    const int tid = tid_, wid = __builtin_amdgcn_readfirstlane(tid >> 6), lane = tid & 63, wr = wid >> 2, wc = wid & 3, fr = lane & 15, fq = lane >> 4;
    const int K = g.K, nt = K / BK, LD = g.ld ? g.ld : g.K;
    unsigned voffA[2], voffB[2];
#pragma unroll
    for (int i = 0; i < 2; ++i) { int R, C; stage_rc(tid * 16 + i * 8192, R, C); const int Rb = Epi::PERM ? ((R & ~31) + perm32(R & 31)) : R;
        voffA[i] = (unsigned)(R * LD + C) * 2u; voffB[i] = (unsigned)(Rb * LD + C) * 2u; }
    const size_t kstep = (size_t)(BK * 2);
    const size_t hstep = (size_t)HALF * LD * 2;
    const size_t tstep = 2 * hstep;
    const unsigned ldsw = (unsigned)wid * 1024u;
    const int aoff = lds_byte(wr * 64 + fr, fq * 8), boff = lds_byte(wc * 32 + fr, fq * 8);
    const int aoff8 = lds_byte(wr * 64 + fr, (fq >> 1) * 32 + (fq & 1) * 16), boff8 = lds_byte(wc * 32 + fr, (fq >> 1) * 32 + (fq & 1) * 16);
#define PG8_SA(b, h) (((b) * 2 + (h)) * HTB)
#define PG8_SB(b, h) ((4 + (b) * 2 + (h)) * HTB)
#define PG8_STAGE(bufoff, gbase, voff) do { _Pragma("unroll") for (int _i = 0; _i < 2; ++_i) \
        __builtin_amdgcn_global_load_lds((const unsigned*)((const char*)(gbase) + (voff)[_i]), (PG8_LAS unsigned*)(lds + (bufoff) + ldsw + _i * 8192), 16, 0, 0); } while (0)
#define PG8_LDA(dst, b, h) do { if constexpr (FP8) { _Pragma("unroll") for (int m = 0; m < 4; ++m) dst##8[m] = *(const PG8_LAS i32x8v*)(lds + PG8_SA(b, h) + aoff8 + m * 2048); } else { \
        _Pragma("unroll") for (int m = 0; m < 4; ++m) _Pragma("unroll") for (int k = 0; k < 2; ++k) dst[m][k] = *(const PG8_LAS bf16x8*)(lds + PG8_SA(b, h) + aoff + m * 2048 + k * 1024); } } while (0)
#define PG8_LDB(dst, b, h) do { if constexpr (FP8) { _Pragma("unroll") for (int n = 0; n < 2; ++n) dst##8[n] = *(const PG8_LAS i32x8v*)(lds + PG8_SB(b, h) + boff8 + n * 2048); } else { \
        _Pragma("unroll") for (int n = 0; n < 2; ++n) _Pragma("unroll") for (int k = 0; k < 2; ++k) dst[n][k] = *(const PG8_LAS bf16x8*)(lds + PG8_SB(b, h) + boff + n * 2048 + k * 1024); } } while (0)
#define PG8_MMA(ai, bj, AF, BF) do { __builtin_amdgcn_s_setprio(1); if constexpr (FP8) { \
        _Pragma("unroll") for (int m = 0; m < 4; ++m) _Pragma("unroll") for (int n = 0; n < 2; ++n) \
            asm volatile("v_mfma_f32_16x16x128_f8f6f4 %0, %1, %2, %0" : "+v"(acc[ai][bj][m][n]) : "v"(BF##8[n]), "v"(AF##8[m])); \
        } else { _Pragma("unroll") for (int m = 0; m < 4; ++m) _Pragma("unroll") for (int n = 0; n < 2; ++n) _Pragma("unroll") for (int k = 0; k < 2; ++k) \
        acc[ai][bj][m][n] = __builtin_amdgcn_mfma_f32_16x16x32_bf16(BF[n][k], AF[m][k], acc[ai][bj][m][n], 0, 0, 0); } __builtin_amdgcn_s_setprio(0); } while (0)
#define PG8_WAIT_V(n) asm volatile("s_waitcnt vmcnt(" #n ")" ::: "memory")
#define PG8_WAIT_L(n) asm volatile("s_waitcnt lgkmcnt(" #n ")" ::: "memory")
#define PG8_BAR __builtin_amdgcn_s_barrier()
#define PG8_SCHED __builtin_amdgcn_sched_barrier(0)
    Unit cur, nxt; int ui = 0;
    if (!S.next(0, cur)) return;
    f32x4 acc[2][2][4][2];
#pragma unroll
    for (int a = 0; a < 2; ++a)
#pragma unroll
        for (int b = 0; b < 2; ++b)
#pragma unroll
            for (int m = 0; m < 4; ++m)
#pragma unroll
                for (int n = 0; n < 2; ++n) acc[a][b][m][n] = (f32x4){0.f, 0.f, 0.f, 0.f};
    bf16x8 At[4][2], B0[2][2], B1[2][2]; i32x8v At8[4], B08[2], B18[2];
    const char* cA = (const char*)g.A + (size_t)cur.pm * tstep + cur.ko; const char* cB = (const char*)g.Bt + (size_t)cur.pn * tstep + cur.ko;
    S.a_ready(cur);
    if constexpr (SP2) {
        PG8_STAGE(PG8_SB(0, 0), cB, voffB); PG8_STAGE(PG8_SB(0, 1), cB + hstep, voffB); PG8_STAGE(PG8_SA(0, 0), cA, voffA); PG8_STAGE(PG8_SA(0, 1), cA + hstep, voffA);
        if (wr == 1) PG8_BAR;
        PG8_WAIT_V(2); PG8_BAR;
        PG8_STAGE(PG8_SB(1, 0), cB + kstep, voffB); PG8_STAGE(PG8_SA(1, 0), cA + kstep, voffA); PG8_STAGE(PG8_SB(1, 1), cB + hstep + kstep, voffB);
        PG8_WAIT_V(6); PG8_BAR;
    } else {
        PG8_STAGE(PG8_SB(0, 0), cB, voffB); PG8_STAGE(PG8_SA(0, 0), cA, voffA); PG8_STAGE(PG8_SB(0, 1), cB + hstep, voffB); PG8_STAGE(PG8_SA(0, 1), cA + hstep, voffA);
        if (wr == 1) PG8_BAR;
        PG8_WAIT_V(4); PG8_BAR;
        PG8_STAGE(PG8_SB(1, 0), cB + kstep, voffB); PG8_STAGE(PG8_SA(1, 0), cA + kstep, voffA); PG8_STAGE(PG8_SB(1, 1), cB + hstep + kstep, voffB);
        PG8_WAIT_V(6); PG8_BAR;
    }
    for (;;) {
        const bool has_next = S.next(ui + 1, nxt);
        const char* nA = has_next ? (const char*)g.A + (size_t)nxt.pm * tstep + nxt.ko : cA; const char* nB = has_next ? (const char*)g.Bt + (size_t)nxt.pn * tstep + nxt.ko : cB;
        for (int t = 0; t < nt; t += 2) {
            const bool last = (t == nt - 2);
            const char* a1 = cA + (size_t)(t + 1) * kstep;
            const char* a2 = last ? nA : cA + (size_t)(t + 2) * kstep; const char* b2 = last ? nB : cB + (size_t)(t + 2) * kstep;
            const char* a3 = a2 + kstep; const char* b3 = b2 + kstep;
            if (last && has_next) S.a_ready(nxt);
            if constexpr (SP2) {
            PG8_LDB(B0, 0, 0); PG8_LDB(B1, 0, 1); PG8_SCHED; PG8_LDA(At, 0, 0); PG8_STAGE(PG8_SA(1, 1), a1 + hstep, voffA);
            PG8_WAIT_V(8); PG8_WAIT_L(0); PG8_BAR; PG8_MMA(0, 0, At, B0); PG8_MMA(0, 1, At, B1); PG8_BAR; PG8_SCHED;
            PG8_LDA(At, 0, 1); PG8_STAGE(PG8_SB(0, 0), b2, voffB); PG8_STAGE(PG8_SB(0, 1), b2 + hstep, voffB); PG8_STAGE(PG8_SA(0, 0), a2, voffA);
            PG8_WAIT_V(8); PG8_WAIT_L(0); PG8_BAR; PG8_MMA(1, 0, At, B0); PG8_MMA(1, 1, At, B1); PG8_BAR; PG8_SCHED;
            PG8_LDB(B0, 1, 0); PG8_LDB(B1, 1, 1); PG8_SCHED; PG8_LDA(At, 1, 0); PG8_STAGE(PG8_SA(0, 1), a2 + hstep, voffA);
            PG8_WAIT_V(8); PG8_WAIT_L(0); PG8_BAR; PG8_MMA(0, 0, At, B0); PG8_MMA(0, 1, At, B1); PG8_BAR; PG8_SCHED;
            PG8_LDA(At, 1, 1); PG8_STAGE(PG8_SB(1, 0), b3, voffB); PG8_STAGE(PG8_SB(1, 1), b3 + hstep, voffB); PG8_STAGE(PG8_SA(1, 0), a3, voffA);
            PG8_WAIT_V(8); PG8_WAIT_L(0); PG8_BAR; PG8_MMA(1, 0, At, B0); PG8_MMA(1, 1, At, B1); PG8_BAR; PG8_SCHED;
            } else {
            PG8_LDB(B0, 0, 0); PG8_SCHED; PG8_LDA(At, 0, 0); PG8_STAGE(PG8_SA(1, 1), a1 + hstep, voffA);
            PG8_WAIT_L(8); PG8_BAR; PG8_WAIT_L(0); PG8_MMA(0, 0, At, B0); PG8_BAR; PG8_SCHED;
            PG8_LDB(B1, 0, 1); PG8_STAGE(PG8_SB(0, 0), b2, voffB);
            PG8_BAR; PG8_WAIT_L(0); PG8_MMA(0, 1, At, B1); PG8_BAR;
            PG8_LDA(At, 0, 1); PG8_STAGE(PG8_SA(0, 0), a2, voffA);
            PG8_BAR; PG8_WAIT_L(0); PG8_MMA(1, 0, At, B0); PG8_BAR; PG8_SCHED;
            PG8_STAGE(PG8_SB(0, 1), b2 + hstep, voffB);
            PG8_WAIT_V(6); PG8_BAR; PG8_MMA(1, 1, At, B1); PG8_BAR;
            PG8_LDB(B0, 1, 0); PG8_SCHED; PG8_LDA(At, 1, 0); PG8_STAGE(PG8_SA(0, 1), a2 + hstep, voffA);
            PG8_WAIT_L(8); PG8_BAR; PG8_WAIT_L(0); PG8_MMA(0, 0, At, B0); PG8_BAR; PG8_SCHED;
            PG8_LDB(B1, 1, 1); PG8_STAGE(PG8_SB(1, 0), b3, voffB);
            PG8_BAR; PG8_WAIT_L(0); PG8_MMA(0, 1, At, B1); PG8_BAR;
            PG8_LDA(At, 1, 1); PG8_STAGE(PG8_SA(1, 0), a3, voffA);
            PG8_BAR; PG8_WAIT_L(0); PG8_MMA(1, 0, At, B0); PG8_BAR; PG8_SCHED;
            PG8_STAGE(PG8_SB(1, 1), b3 + hstep, voffB);
            PG8_WAIT_V(6); PG8_BAR; PG8_MMA(1, 1, At, B1); PG8_BAR;
            }
        }
        if constexpr (FP8) asm volatile("s_nop 15\n\ts_nop 15" ::: "memory");
        if constexpr (ALIGN_EPI) { if (wr == 0) PG8_BAR; }
        if constexpr (!Epi::AFTER_DRAIN) { E(acc, cur, wr, wc, fr, fq); S.done(cur); }
        if (!has_next) break;
#pragma unroll
        for (int a = 0; a < 2; ++a)
#pragma unroll
            for (int b = 0; b < 2; ++b)
#pragma unroll
                for (int m = 0; m < 4; ++m)
#pragma unroll
                    for (int n = 0; n < 2; ++n) acc[a][b][m][n] = (f32x4){0.f, 0.f, 0.f, 0.f};
        cur = nxt; cA = nA; cB = nB; ++ui;
        if constexpr (ALIGN_EPI) { if (wr == 1) PG8_BAR; }
    }
    PG8_WAIT_V(0);
    if constexpr (!ALIGN_EPI) { if (wr == 0) PG8_BAR; }
    PG8_BAR;
    if constexpr (Epi::AFTER_DRAIN) { E.fused(acc, cur, wr, wc, fr, fq, lds, wid, lane); S.done(cur); }
#undef PG8_SA
#undef PG8_SB
#undef PG8_STAGE
#undef PG8_LDA
#undef PG8_LDB
#undef PG8_MMA
#undef PG8_WAIT_V
#undef PG8_WAIT_L
#undef PG8_BAR
#undef PG8_SCHED
}
}
namespace pg8 {
typedef unsigned u32x2 __attribute__((ext_vector_type(2)));
__device__ __forceinline__ float fast_sigmoid(float v) { return __builtin_amdgcn_rcpf(1.0f + __expf(-v)); }
__device__ __forceinline__ unsigned cvt4_fp8(float a, float b, float c, float d) {
    a = __builtin_amdgcn_fmed3f(a, -448.f, 448.f); b = __builtin_amdgcn_fmed3f(b, -448.f, 448.f); c = __builtin_amdgcn_fmed3f(c, -448.f, 448.f); d = __builtin_amdgcn_fmed3f(d, -448.f, 448.f);
    int r = __builtin_amdgcn_cvt_pk_fp8_f32(a, b, 0, false); r = __builtin_amdgcn_cvt_pk_fp8_f32(c, d, r, true); return (unsigned)r; }

template <int MODE, int NCT, bool OUT8 = false> struct EpiGated {
    static constexpr bool PERM = true, AFTER_DRAIN = false;
    bf16_t* O; int ldc; const float* bias; int goff; float sin, sout;
    __device__ __forceinline__ void operator()(const f32x4 (&acc)[2][2][4][2], const Unit& u, int wr, int wc, int fr, int fq) const {
        const int ct = NCT ? (u.pn % (NCT ? NCT : 1)) : u.pn;
        const int row0 = u.pm * BM + wr * 64 + fr, col0 = ct * HALF + wc * 32 + 8 * fq;
        f32x4 ba[2], bg[2];
#pragma unroll
        for (int n = 0; n < 2; ++n) { ba[n] = MODE == 0 ? *(const f32x4*)(bias + col0 + 4 * n) : (f32x4){0.f, 0.f, 0.f, 0.f}; bg[n] = MODE == 0 ? *(const f32x4*)(bias + goff + col0 + 4 * n) : (f32x4){0.f, 0.f, 0.f, 0.f}; }
#pragma unroll
        for (int ai = 0; ai < 2; ++ai)
#pragma unroll
            for (int m = 0; m < 4; ++m) {
                f32x4 o[2];
#pragma unroll
                for (int n = 0; n < 2; ++n) { const f32x4 a = acc[ai][0][m][n] * sin + ba[n], g = acc[ai][1][m][n] * sin + bg[n];
#pragma unroll
                    for (int e = 0; e < 4; ++e) o[n][e] = MODE == 0 ? a[e] * fast_sigmoid(g[e]) : a[e] * fast_sigmoid(a[e]) * g[e]; }
                if constexpr (OUT8) { u32x2 w; w.x = cvt4_fp8(o[0][0] * sout, o[0][1] * sout, o[0][2] * sout, o[0][3] * sout); w.y = cvt4_fp8(o[1][0] * sout, o[1][1] * sout, o[1][2] * sout, o[1][3] * sout);
                    *(u32x2*)((unsigned char*)O + (size_t)(row0 + ai * HALF + m * 16) * ldc + col0) = w; }
                else { bf16_t* rowp = O + (size_t)(row0 + ai * HALF + m * 16) * ldc + col0;
                    u32x4 w; w.x = cvt_pk_bf16(o[0][0], o[0][1]); w.y = cvt_pk_bf16(o[0][2], o[0][3]); w.z = cvt_pk_bf16(o[1][0], o[1][1]); w.w = cvt_pk_bf16(o[1][2], o[1][3]);
                    *(u32x4*)rowp = w; }
            }
    }
};

struct EpiBf16S {
    static constexpr bool PERM = true, AFTER_DRAIN = false;
    bf16_t* O; int ldc; float scale;
    __device__ __forceinline__ void operator()(const f32x4 (&acc)[2][2][4][2], const Unit& u, int wr, int wc, int fr, int fq) const {
        const int row0 = u.pm * BM + wr * 64 + fr, col0 = u.pn * BM + wc * 32 + 8 * fq;
#pragma unroll
        for (int ai = 0; ai < 2; ++ai)
#pragma unroll
            for (int m = 0; m < 4; ++m) { bf16_t* rowp = O + (size_t)(row0 + ai * HALF + m * 16) * ldc + col0;
#pragma unroll
                for (int bj = 0; bj < 2; ++bj) { const f32x4 v0 = acc[ai][bj][m][0] * scale, v1 = acc[ai][bj][m][1] * scale;
                    u32x4 w; w.x = cvt_pk_bf16(v0[0], v0[1]); w.y = cvt_pk_bf16(v0[2], v0[3]); w.z = cvt_pk_bf16(v1[0], v1[1]); w.w = cvt_pk_bf16(v1[2], v1[3]);
                    *(u32x4*)(rowp + bj * HALF) = w; } }
    }
};

struct EpiK {
    static constexpr bool PERM = true, AFTER_DRAIN = false;
    bf16_t* O; int ldc; float* kmean; unsigned* kabs; float sin;
    __device__ __forceinline__ void operator()(const f32x4 (&acc)[2][2][4][2], const Unit& u, int wr, int wc, int fr, int fq) const {
        const int row0 = u.pm * BM + wr * 64 + fr, col0 = u.pn * BM + wc * 32 + 8 * fq;
        f32x4 cs[2][2];
#pragma unroll
        for (int bj = 0; bj < 2; ++bj)
#pragma unroll
            for (int n = 0; n < 2; ++n) cs[bj][n] = (f32x4){0.f, 0.f, 0.f, 0.f};
#pragma unroll
        for (int ai = 0; ai < 2; ++ai)
#pragma unroll
            for (int m = 0; m < 4; ++m) { bf16_t* rowp = O + (size_t)(row0 + ai * HALF + m * 16) * ldc + col0;
#pragma unroll
                for (int bj = 0; bj < 2; ++bj) { const f32x4 v0 = acc[ai][bj][m][0] * sin, v1 = acc[ai][bj][m][1] * sin; cs[bj][0] += v0; cs[bj][1] += v1;
                    u32x4 w; w.x = cvt_pk_bf16(v0[0], v0[1]); w.y = cvt_pk_bf16(v0[2], v0[3]); w.z = cvt_pk_bf16(v1[0], v1[1]); w.w = cvt_pk_bf16(v1[2], v1[3]);
                    *(u32x4*)(rowp + bj * HALF) = w; } }
        const int b = u.pm >> 4, nb = u.pm & 15;
#pragma unroll
        for (int bj = 0; bj < 2; ++bj) {
            float mx = 0.f;
#pragma unroll
            for (int ai = 0; ai < 2; ++ai)
#pragma unroll
                for (int m = 0; m < 4; ++m)
#pragma unroll
                    for (int n = 0; n < 2; ++n)
#pragma unroll
                        for (int e = 0; e < 4; ++e) mx = fmaxf(mx, fabsf(acc[ai][bj][m][n][e]) * sin);
#pragma unroll
            for (int o = 32; o >= 1; o >>= 1) mx = fmaxf(mx, __shfl_xor(mx, o));
            if (fr == 0 && fq == 0) atomicMax(kabs + (b * 16 + ((u.pn * BM + bj * HALF + wc * 32) >> 6)) * 16 + nb, __float_as_uint(mx));
        }
#pragma unroll
        for (int bj = 0; bj < 2; ++bj)
#pragma unroll
            for (int n = 0; n < 2; ++n)
#pragma unroll
                for (int e = 0; e < 4; ++e) { float s = cs[bj][n][e];
                    s += __shfl_xor(s, 1); s += __shfl_xor(s, 2); s += __shfl_xor(s, 4); s += __shfl_xor(s, 8);
                    if (fr == 0) { const int c = col0 + bj * HALF + 4 * n + e, h = c >> 6, d = c & 63;
                        atomicAdd(kmean + ((size_t)((b * 16 + h) * 16 + nb) * 64 + d), s * (1.0f / 256.0f)); } }
    }
};

__device__ __forceinline__ float bf_lo(unsigned w) { return __uint_as_float(w << 16); }
__device__ __forceinline__ float bf_hi(unsigned w) { return __uint_as_float(w & 0xffff0000u); }
template <bool XF32> struct EpiResid {
    static constexpr bool PERM = true, AFTER_DRAIN = false;
    const void* x; bf16_t* y; const float* gate; int gstride; const float* bias; float alpha; float sin;
    __device__ __forceinline__ void operator()(const f32x4 (&acc)[2][2][4][2], const Unit& u, int wr, int wc, int fr, int fq) const {
        const int row0 = u.pm * BM + wr * 64 + fr, col0 = u.pn * BM + wc * 32 + 8 * fq, b = u.pm >> 4;
        f32x4 gv[2][2], bv[2][2];
#pragma unroll
        for (int bj = 0; bj < 2; ++bj)
#pragma unroll
            for (int n = 0; n < 2; ++n) { const int c = col0 + bj * HALF + n * 4; gv[bj][n] = *(const f32x4*)(gate + (size_t)b * gstride + c) + 1.0f;
                bv[bj][n] = bias ? *(const f32x4*)(bias + c) : (f32x4){0.f, 0.f, 0.f, 0.f}; }
#pragma unroll
        for (int ai = 0; ai < 2; ++ai)
#pragma unroll
            for (int m = 0; m < 4; ++m) { const size_t off = (size_t)(row0 + ai * HALF + m * 16) * 1024 + col0;
#pragma unroll
                for (int bj = 0; bj < 2; ++bj) { f32x4 x0, x1;
                    if constexpr (XF32) { x0 = *(const f32x4*)((const float*)x + off + bj * HALF); x1 = *(const f32x4*)((const float*)x + off + bj * HALF + 4); }
                    else { const u32x4 xw = *(const u32x4*)((const bf16_t*)x + off + bj * HALF); x0 = (f32x4){bf_lo(xw.x), bf_hi(xw.x), bf_lo(xw.y), bf_hi(xw.y)}; x1 = (f32x4){bf_lo(xw.z), bf_hi(xw.z), bf_lo(xw.w), bf_hi(xw.w)}; }
                    const f32x4 o0 = x0 * alpha + gv[bj][0] * (acc[ai][bj][m][0] * sin + bv[bj][0]), o1 = x1 * alpha + gv[bj][1] * (acc[ai][bj][m][1] * sin + bv[bj][1]);
                    u32x4 w; w.x = cvt_pk_bf16(o0[0], o0[1]); w.y = cvt_pk_bf16(o0[2], o0[3]); w.z = cvt_pk_bf16(o1[0], o1[1]); w.w = cvt_pk_bf16(o1[2], o1[3]);
                    *(u32x4*)(y + off + bj * HALF) = w; } }
    }
};

struct EpiMoeOut {
    static constexpr bool PERM = true, AFTER_DRAIN = false;
    bf16_t* O; const int* rowinfo; const float* roww; float sin; size_t kplane;
    __device__ __forceinline__ void operator()(const f32x4 (&acc)[2][2][4][2], const Unit& u, int wr, int wc, int fr, int fq) const {
        const int row0 = u.pm * BM + wr * 64 + fr, col0 = (u.pn & 3) * BM + wc * 32 + 8 * fq;
#pragma unroll
        for (int ai = 0; ai < 2; ++ai)
#pragma unroll
            for (int m = 0; m < 4; ++m) { const int r = row0 + ai * HALF + m * 16; const int info = rowinfo[r]; const float w = roww[r] * sin;
                if (info >= 0) { bf16_t* op = O + (u.ko ? kplane : (size_t)0) + (size_t)info * 1024 + col0;
#pragma unroll
                    for (int bj = 0; bj < 2; ++bj) { const f32x4 v0 = acc[ai][bj][m][0] * w, v1 = acc[ai][bj][m][1] * w;
                        u32x4 o; o.x = cvt_pk_bf16(v0[0], v0[1]); o.y = cvt_pk_bf16(v0[2], v0[3]); o.z = cvt_pk_bf16(v1[0], v1[1]); o.w = cvt_pk_bf16(v1[2], v1[3]);
                        *(u32x4*)(op + bj * HALF) = o; } } }
    }
};

struct MoeOrder {
    StaticOrder so; const int* tile_e; int nct, kbytes;
    __device__ void init(int NT, int nct_, int G, int c, const int* te, int kbytes_ = 0) { so.init(NT * BM, nct_ * (kbytes_ ? 2 : 1) * BM, G, c); tile_e = te; nct = nct_; kbytes = kbytes_; }
    __device__ bool next(int i, Unit& u) const { if (!so.next(i, u)) return false; const int kh = u.pn / nct; u.pn = u.pn % nct + __builtin_amdgcn_readfirstlane(tile_e[u.pm]) * nct; u.ko = kh * kbytes; return true; }
    __device__ __forceinline__ void a_ready(const Unit&) const {}
    __device__ __forceinline__ void done(const Unit&) const {}
};
}
#define GAS __attribute__((address_space(1)))
#define LAS __attribute__((address_space(3)))
#define XB_TMO      128
#define XB_XCNT(j)  (256  + 64 * (j))
#define XB_XSUB(j)  (1280 + 64 * (j))
#define XB_XGEN(j)  (2304 + 64 * (j))
#define XB_TOP      3328
#define XB_TOPGEN   3392
#define XCD_BAR_WORDS 3456
#define XB_SPIN_CAP (1u << 18)

__device__ __forceinline__ unsigned xb_ld(unsigned* p)              { return __hip_atomic_load(p, __ATOMIC_RELAXED, __HIP_MEMORY_SCOPE_AGENT); }
__device__ __forceinline__ unsigned xb_add(unsigned* p, unsigned v) { return __hip_atomic_fetch_add(p, v, __ATOMIC_RELAXED, __HIP_MEMORY_SCOPE_AGENT); }
__device__ __forceinline__ unsigned xb_xcc_id() { return (unsigned)__builtin_amdgcn_s_getreg((3 << 11) | 20) & 0xFu; }
#define XB_SPIN(cond, bar) do { unsigned _sp = 0; while (cond) { __builtin_amdgcn_s_sleep(1); \
    if ((++_sp & 255u) == 0u) { if (xb_ld(&(bar)[XB_TMO])) break; if (_sp > XB_SPIN_CAP) { atomicAdd(&(bar)[XB_TMO], 1u); break; } } } } while (0)

struct XcdBarrier {
    unsigned* bar; unsigned x;
    volatile LAS unsigned* st;
};

__device__ __forceinline__ XcdBarrier xcd_barrier_post(unsigned* bar, volatile LAS unsigned* st) {
    XcdBarrier b; b.bar = bar; b.x = xb_xcc_id(); b.st = st;
    if (threadIdx.x == 0) (void)xb_add(&bar[XB_XCNT(b.x)], 1u);
    return b;
}
__device__ __forceinline__ void xcd_barrier_complete(unsigned* bar, unsigned x, unsigned& nloc, unsigned& nx) {
    const unsigned G = gridDim.x * gridDim.y * gridDim.z;
    unsigned sum, cnt, mine, sp = 0u;
    for (;;) {
        sum = 0u; cnt = 0u; mine = 0u;
#pragma unroll
        for (unsigned j = 0; j < 16; ++j) { const unsigned c = xb_ld(&bar[XB_XCNT(j)]); sum += c; cnt += (c > 0u) ? 1u : 0u; mine = (j == x) ? c : mine; }
        if (sum == G) break;
        __builtin_amdgcn_s_sleep(1);
        if ((++sp & 255u) == 0u) { if (xb_ld(&bar[XB_TMO])) break; if (sp > XB_SPIN_CAP) { atomicAdd(&bar[XB_TMO], 1u); break; } }
    }
    nloc = mine > 0u ? mine : 1u; nx = cnt > 0u ? cnt : 1u;
}

__device__ __forceinline__ void xcd_barrier(const XcdBarrier& b) {
    asm volatile("s_waitcnt vmcnt(0)" ::: "memory");
    __syncthreads();
    if (threadIdx.x == 0) {
        unsigned* bar = b.bar;
        __builtin_amdgcn_s_waitcnt(0);
        unsigned nloc = b.st[0], nx = b.st[1];
        if (nloc == 0u) { xcd_barrier_complete(bar, b.x, nloc, nx); b.st[0] = nloc; b.st[1] = nx; }
        const unsigned old = xb_add(&bar[XB_XSUB(b.x)], 1u);
        const unsigned gen = old / nloc;
        if (old + 1u == (gen + 1u) * nloc) {
            __builtin_amdgcn_fence(__ATOMIC_RELEASE, "agent");
            asm volatile("s_waitcnt vmcnt(0)" ::: "memory");
            const unsigned og = xb_add(&bar[XB_TOP], 1u);
            const unsigned tg = og / nx;
            if (og + 1u == (tg + 1u) * nx) xb_add(&bar[XB_TOPGEN], 1u);
            else XB_SPIN(xb_ld(&bar[XB_TOPGEN]) == tg, bar);
            __builtin_amdgcn_fence(__ATOMIC_ACQUIRE, "agent");
            xb_add(&bar[XB_XGEN(b.x)], 1u);
            asm volatile("s_waitcnt vmcnt(0)" ::: "memory");
        } else {
            XB_SPIN(xb_ld(&bar[XB_XGEN(b.x)]) == gen, bar);
            __builtin_amdgcn_fence(__ATOMIC_ACQUIRE, "agent");
            asm volatile("s_waitcnt vmcnt(0)" ::: "memory");
        }
    }
    __syncthreads();
}

namespace mk {
using pg8::bf16_t;
typedef unsigned v4u __attribute__((ext_vector_type(4)));
typedef unsigned v2u __attribute__((ext_vector_type(2)));
typedef float f32x4 __attribute__((ext_vector_type(4)));
typedef short bf16x8 __attribute__((ext_vector_type(8)));
typedef short s16x4 __attribute__((ext_vector_type(4)));
typedef float f32x16 __attribute__((ext_vector_type(16)));

constexpr int D = 1024, NB = 4, S = 4096, T = NB * S, DEPTH = 4, NA = 2, CONVK = 31, NH = 16, HD = 64, NBLK = 16, DFF = 2816, NE = 8, DFE = 3584;
constexpr int NWAVES = 8, NTHR = NWAVES * 64, GRID = 256;
constexpr float ALPHA = 1.681792830507429f, LN_EPS = 1e-5f;
constexpr float QSCALE = 0.125f * 1.4426950408889634f, LOG2E = 1.4426950408889634f;
#ifndef FP8_MOE
#define FP8_MOE 1
#endif
#ifndef FP8_CONV
#define FP8_CONV 0
#endif
#ifndef FP8_ATTN
#define FP8_ATTN 0
#endif
#ifndef FP8_FFN
#define FP8_FFN 0
#endif
constexpr float S8_H = 16.f, S8_W13 = 256.f, S8_HM = 8.f, S8_W2 = 1024.f, S8_WP = 256.f, S8_WO = 512.f, S8_U = 16.f;
static_assert(FP8_CONV == 0 && FP8_ATTN == 0, "the e4m3 paths of the conv / attention projections were removed");
constexpr int MAXROWS = 2 * T + NE * 256;

constexpr size_t MiB = 1u << 20;
constexpr size_t WS_CTL = 0, CTL_ZERO_BYTES = 2 * MiB;
constexpr int CW_BAR = 4096;
constexpr int CW_VWG = 1024;
#ifndef VWG_MODE
#define VWG_MODE 1
#endif
constexpr size_t WS_KMEAN = 1 * MiB;
constexpr size_t WS_KABS = WS_KMEAN + 512 * 1024;
constexpr size_t WS_MOD = 2 * MiB;
constexpr size_t WS_ROUTE = 3 * MiB;
constexpr size_t RT_TOKE = 0, RT_TOKW = 128 * 1024, RT_RINFO = 256 * 1024, RT_RW = 512 * 1024, RT_CNTWG = 768 * 1024, RT_META = 800 * 1024;
constexpr size_t WS_X0 = 4 * MiB;
constexpr size_t WS_W = 516 * MiB;
constexpr size_t W_CI = WS_W, W_CO = W_CI + 8 * MiB, W_KV = W_CO + 4 * MiB, W_Q = W_KV + 4 * MiB, W_O = W_Q + 4 * MiB, W_F13 = W_O + 4 * MiB, W_F2 = W_F13 + 22 * MiB,
                 W_M13 = W_F2 + 11 * MiB, W_M2 = W_M13 + 224 * MiB, W_END = W_M2 + 112 * MiB;
constexpr size_t WS_Y = W_END, WS_HBF = WS_Y + 64 * MiB, WS_HKV = WS_HBF + 32 * MiB, WS_U = WS_HKV + 32 * MiB, WS_U2 = WS_U + 32 * MiB, WS_K = WS_U2 + 32 * MiB, WS_VT = WS_K + 32 * MiB,
                 WS_HM = WS_VT + 32 * MiB, WS_HPERM = WS_HM + 240 * MiB, WS_MOEO = WS_HPERM + 68 * MiB, WS_END = WS_MOEO + 128 * MiB;
static_assert(W_END == 909 * MiB && WS_END == 1601 * MiB, "d_ws map");
static_assert((size_t)MAXROWS * DFE * 2 <= 240 * MiB && (size_t)MAXROWS * D * 2 <= 68 * MiB, "MoE buffers");
constexpr size_t NAIVE_BASE = 516 * MiB;

constexpr int RING_BYTES = 131072, LDSCTL_OFF = RING_BYTES, LDS_BYTES = 147456;

#define RLX_AGENT __ATOMIC_RELAXED, __HIP_MEMORY_SCOPE_AGENT
__device__ __forceinline__ float bf2f(unsigned short h) { return __uint_as_float((unsigned)h << 16); }
__device__ __forceinline__ float bflo(unsigned w) { return __uint_as_float(w << 16); }
__device__ __forceinline__ float bfhi(unsigned w) { return __uint_as_float(w & 0xffff0000u); }
__device__ __forceinline__ unsigned pk2(float lo, float hi) { return pg8::cvt_pk_bf16(lo, hi); }
__device__ __forceinline__ float wave_sum(float v) {
#pragma unroll
    for (int o = 1; o < 64; o <<= 1) v += __shfl_xor(v, o);
    return v;
}
__device__ __forceinline__ float silu_f(float v) { return v * __builtin_amdgcn_rcpf(1.0f + __expf(-v)); }

struct Args { const float* in[25]; float* out; unsigned char* ws; int ph_lo, ph_hi; };

__device__ __forceinline__ void mod_unit(int unit, const float* ada_w, const float* ada_b, const float* kv_ada_w, const float* kv_ada_b, float* mod, LAS float* ca, LAS float* red, int wave, int lane) {
    const int col = unit * 64 + lane, NMAIN = DEPTH * 6 * D;
    const float* w; int ldw; float bias; float* outp; int ostride;
    if (col < NMAIN) { const int l = col / (6 * D), j = col % (6 * D); w = ada_w + (size_t)l * D * 6 * D + j; ldw = 6 * D; bias = ada_b[l * 6 * D + j]; outp = mod + (size_t)l * NB * 6 * D + j; ostride = 6 * D; }
    else { const int j = col - NMAIN; w = kv_ada_w + j; ldw = 2 * D; bias = kv_ada_b[j]; outp = mod + (size_t)DEPTH * NB * 6 * D + j; ostride = 2 * D; }
    float a0 = 0.f, a1 = 0.f, a2 = 0.f, a3 = 0.f;
    const int k0 = wave * 128;
#pragma unroll 8
    for (int k = k0; k < k0 + 128; ++k) { const float wv = w[(size_t)k * ldw]; a0 += ca[k] * wv; a1 += ca[D + k] * wv; a2 += ca[2 * D + k] * wv; a3 += ca[3 * D + k] * wv; }
    red[(wave * 4 + 0) * 64 + lane] = a0; red[(wave * 4 + 1) * 64 + lane] = a1; red[(wave * 4 + 2) * 64 + lane] = a2; red[(wave * 4 + 3) * 64 + lane] = a3;
    __syncthreads();
    if (wave < 4) { float s = 0.f;
#pragma unroll
        for (int q = 0; q < 8; ++q) s += red[(q * 4 + wave) * 64 + lane];
        outp[(size_t)wave * ostride] = s + bias; }
    __syncthreads();
}

__device__ __forceinline__ void conv_item(const float* W, int K, int N, int gateF, bf16_t* WT, int item, LAS unsigned* scr, int lane) {
    const int nblk = N / 64, kb = item / nblk, nb = item % nblk, k0 = 64 * kb, n0 = 64 * nb;
    const int kr = lane >> 4, nc = (lane & 15) * 4;
#pragma unroll
    for (int p = 0; p < 8; ++p) {
        const int k = 8 * p + 2 * kr;
        const f32x4 v0 = *(const f32x4*)(W + (size_t)(k0 + k) * N + n0 + nc), v1 = *(const f32x4*)(W + (size_t)(k0 + k + 1) * N + n0 + nc);
#pragma unroll
        for (int j = 0; j < 4; ++j) scr[(nc + j) * 33 + 4 * p + kr] = pk2(v0[j], v1[j]);
    }
    asm volatile("s_waitcnt lgkmcnt(0)" ::: "memory");
    int drow0;
    if (gateF) { const int half = n0 / gateF, jj = n0 % gateF; drow0 = (jj / 128) * 256 + half * 128 + (jj % 128); } else drow0 = n0;
    const int c = lane & 7;
#pragma unroll
    for (int jj = 0; jj < 8; ++jj) { const int n = (lane >> 3) + 8 * jj; const LAS unsigned* s = scr + n * 33 + 4 * c;
        v4u o; o.x = s[0]; o.y = s[1]; o.z = s[2]; o.w = s[3];
        *(v4u*)(WT + (size_t)(drow0 + n) * K + k0 + 8 * c) = o; }
    asm volatile("s_waitcnt lgkmcnt(0)" ::: "memory");
}
__device__ __forceinline__ void conv_item8(const float* W, int K, int N, int gateF, unsigned char* WT, int item, float scale, LAS unsigned* scr, int lane) {
    const int nblk = N / 64, kb = item / nblk, nb = item % nblk, k0 = 64 * kb, n0 = 64 * nb;
    const int kr = lane >> 4, nc = (lane & 15) * 4;
#pragma unroll
    for (int p = 0; p < 4; ++p) {
        const int k = 16 * p + 4 * kr;
        const float* wp = W + (size_t)(k0 + k) * N + n0 + nc;
        const f32x4 v0 = *(const f32x4*)wp * scale, v1 = *(const f32x4*)(wp + N) * scale, v2 = *(const f32x4*)(wp + 2 * (size_t)N) * scale, v3 = *(const f32x4*)(wp + 3 * (size_t)N) * scale;
#pragma unroll
        for (int j = 0; j < 4; ++j) scr[(nc + j) * 17 + 4 * p + kr] = pg8::cvt4_fp8(v0[j], v1[j], v2[j], v3[j]);
    }
    asm volatile("s_waitcnt lgkmcnt(0)" ::: "memory");
    int drow0;
    if (gateF) { const int half = n0 / gateF, jj = n0 % gateF; drow0 = (jj / 128) * 256 + half * 128 + (jj % 128); } else drow0 = n0;
    const int c = lane & 3;
#pragma unroll
    for (int jj = 0; jj < 4; ++jj) { const int n = (lane >> 2) + 16 * jj; const LAS unsigned* sp = scr + n * 17 + 4 * c;
        v4u o; o.x = sp[0]; o.y = sp[1]; o.z = sp[2]; o.w = sp[3];
        *(v4u*)(WT + (size_t)(drow0 + n) * K + k0 + 16 * c) = o; }
    asm volatile("s_waitcnt lgkmcnt(0)" ::: "memory");
}
struct ConvGroup { int src; int count, K, N, gateF; size_t dst; float s8; };
__device__ __forceinline__ ConvGroup conv_group(int g) {
    switch (g) {
        case 0: return {6, 2, D, 2 * D, D, W_CI, FP8_CONV ? S8_WP : 0.f};      case 1: return {12, 2, D, D, 0, W_CO, FP8_CONV ? S8_WO : 0.f};   case 2: return {16, 1, D, 2 * D, 0, W_KV, FP8_ATTN ? S8_WP : 0.f};
        case 3: return {17, 2, D, D, 0, W_Q, FP8_ATTN ? S8_WP : 0.f};          case 4: return {18, 2, D, D, 0, W_O, FP8_ATTN ? S8_WO : 0.f};
        case 5: return {19, 2, D, 2 * DFF, DFF, W_F13, FP8_FFN ? S8_W13 : 0.f};   case 6: return {20, 2, DFF, D, 0, W_F2, FP8_FFN ? S8_W2 : 0.f};
        case 7: return {23, 16, D, 2 * DFE, DFE, W_M13, FP8_MOE ? S8_W13 : 0.f};  default: return {24, 16, DFE, D, 0, W_M2, FP8_MOE ? S8_W2 : 0.f};
    }
}
constexpr int CG7_PER = (D / 64) * (2 * DFE / 64), CG8_PER = (DFE / 64) * (D / 64);
__device__ __forceinline__ void conv_range(const Args& a, unsigned char* ws, int g, int i0, int i1, LAS unsigned* scr, int gw, int ngw, int lane) {
    const ConvGroup G = conv_group(g);
    const int per = (G.K / 64) * (G.N / 64), eb = G.s8 > 0.f ? 1 : 2;
    for (int i = i0 + gw; i < i1; i += ngw) { const int m = i / per, it = i % per;
        const float* W = a.in[G.src] + (size_t)m * G.K * G.N; unsigned char* WT = ws + G.dst + (size_t)m * G.K * G.N * eb;
        if (G.s8 > 0.f) conv_item8(W, G.K, G.N, G.gateF, WT, it, G.s8, scr, lane); else conv_item(W, G.K, G.N, G.gateF, (bf16_t*)WT, it, scr, lane); }
}
#ifndef MOE1_IN_P0_PCT
#define MOE1_IN_P0_PCT 100
#endif
#ifndef MOE3_IN_E2_PCT
#define MOE3_IN_E2_PCT 100
#endif
constexpr int M1A7 = (8 * CG7_PER * MOE1_IN_P0_PCT / 100) & ~63, M1A8 = (8 * CG8_PER * MOE1_IN_P0_PCT / 100) & ~63;
constexpr int M3A7 = 8 * CG7_PER + ((8 * CG7_PER * MOE3_IN_E2_PCT / 100) & ~63), M3A8 = 8 * CG8_PER + ((8 * CG8_PER * MOE3_IN_E2_PCT / 100) & ~63);
__device__ __forceinline__ void tail_convert(const Args& a, unsigned char* ws, int g7lo, int g7hi, int g8lo, int g8hi, int rem, LAS unsigned char* lds, int wg, int G, int wave, int lane) {
    const int first = (rem > 0 && rem < G) ? rem : 0;
    if (wg < first) return;
    LAS unsigned* scr = (LAS unsigned*)(lds + 32768 + wave * 8448);
    const int gw = (wg - first) * NWAVES + wave, ngw = (G - first) * NWAVES;
    conv_range(a, ws, 7, g7lo, g7hi, scr, gw, ngw, lane);
    conv_range(a, ws, 8, g8lo, g8hi, scr, gw, ngw, lane);
}

struct RowArgs {
    int mode;
    const void* x_in; const bf16_t* y; const bf16_t* moeo; const float* gate; int gstride;
    float oscale;
    const float* lng; const float* lnb; bf16_t* x_out; float* x_out32;
    const float* sh; const float* sc; int mstride; bf16_t* h_out;
    unsigned char* h8_out;
    const float* kvsh; const float* kvsc; bf16_t* hkv_out; unsigned char* hkv8_out;
    const float* rw; const float* rb; int* tok_e; float* tok_w; int* cntwg;
};
__device__ __forceinline__ void unpack8(const v4u w, f32x4& lo, f32x4& hi) { lo = (f32x4){bflo(w.x), bfhi(w.x), bflo(w.y), bfhi(w.y)}; hi = (f32x4){bflo(w.z), bfhi(w.z), bflo(w.w), bfhi(w.w)}; }
__device__ __forceinline__ v4u pack8(const f32x4 lo, const f32x4 hi) { v4u w; w.x = pk2(lo[0], lo[1]); w.y = pk2(lo[2], lo[3]); w.z = pk2(hi[0], hi[1]); w.w = pk2(hi[2], hi[3]); return w; }
template <int RB  >
__device__ __forceinline__ void row_phase(const RowArgs& A, LAS unsigned char* lds, int wg, int tid, int wave, int lane) {
    LAS float* rwT = (LAS float*)lds;
    LAS int* lcnt = (LAS int*)(lds + 32768);
    const bool route = A.rw != nullptr;
    if (route) {
        for (int i = tid; i < D * NE; i += NTHR) { const int d = i >> 3, e = i & 7; rwT[e * D + d] = A.rw[i]; }
        if (tid < NE) lcnt[tid] = 0;
        __syncthreads();
    }
    for (int ib = 0; ib < 8 / RB; ++ib) {
      v4u ry[RB][2], rm0[RB][2], rm1[RB][2]; f32x4 rx[RB][2][2];
#pragma unroll
      for (int ii = 0; ii < RB; ++ii) { const int t = wg * 64 + (ib * RB + ii) * 8 + wave;
#pragma unroll
          for (int j = 0; j < 2; ++j) { const int c = 8 * lane + 512 * j;
              if (A.mode == 0) { const f32x4* xp = (const f32x4*)((const float*)A.x_in + (size_t)t * D + c); rx[ii][j][0] = xp[0]; rx[ii][j][1] = xp[1]; }
              else if (A.mode == 1) ry[ii][j] = *(const v4u*)(A.y + (size_t)t * D + c);
              else { ry[ii][j] = *(const v4u*)((const bf16_t*)A.x_in + (size_t)t * D + c); rm0[ii][j] = *(const v4u*)(A.moeo + (size_t)(2 * t) * D + c); rm1[ii][j] = *(const v4u*)(A.moeo + (size_t)(2 * t + 1) * D + c); } } }
#pragma unroll
      for (int ii = 0; ii < RB; ++ii) {
        const int t = wg * 64 + (ib * RB + ii) * 8 + wave, b = t >> 12;
        f32x4 v[2][2];
        if (A.mode == 0) {
#pragma unroll
            for (int j = 0; j < 2; ++j) { v[j][0] = rx[ii][j][0]; v[j][1] = rx[ii][j][1]; }
        } else {
            if (A.mode == 1) {
#pragma unroll
                for (int j = 0; j < 2; ++j) unpack8(ry[ii][j], v[j][0], v[j][1]);
            } else {
#pragma unroll
                for (int j = 0; j < 2; ++j) { const int c = 8 * lane + 512 * j; f32x4 x0, x1, a0, a1, b0, b1;
                    unpack8(ry[ii][j], x0, x1); unpack8(rm0[ii][j], a0, a1); unpack8(rm1[ii][j], b0, b1);
                    const f32x4 g0 = *(const f32x4*)(A.gate + (size_t)b * A.gstride + c), g1 = *(const f32x4*)(A.gate + (size_t)b * A.gstride + c + 4);
                    v[j][0] = x0 * ALPHA + (g0 + 1.0f) * (a0 + b0); v[j][1] = x1 * ALPHA + (g1 + 1.0f) * (a1 + b1); }
            }
            float s = 0.f;
#pragma unroll
            for (int j = 0; j < 2; ++j)
#pragma unroll
                for (int q = 0; q < 2; ++q) s += (v[j][q][0] + v[j][q][1]) + (v[j][q][2] + v[j][q][3]);
            const float mean = wave_sum(s) * (1.0f / D); float qq = 0.f;
#pragma unroll
            for (int j = 0; j < 2; ++j)
#pragma unroll
                for (int q = 0; q < 2; ++q) { v[j][q] = v[j][q] - mean; qq += (v[j][q][0] * v[j][q][0] + v[j][q][1] * v[j][q][1]) + (v[j][q][2] * v[j][q][2] + v[j][q][3] * v[j][q][3]); }
            const float rstd = rsqrtf(wave_sum(qq) * (1.0f / D) + LN_EPS);
#pragma unroll
            for (int j = 0; j < 2; ++j) { const int c = 8 * lane + 512 * j;
#pragma unroll
                for (int q = 0; q < 2; ++q) { const f32x4 g = *(const f32x4*)(A.lng + c + 4 * q), bb = *(const f32x4*)(A.lnb + c + 4 * q); v[j][q] = v[j][q] * rstd * g + bb; }
                if (A.x_out) *(v4u*)(A.x_out + (size_t)t * D + c) = pack8(v[j][0], v[j][1]);
                if (A.x_out32) { f32x4* op = (f32x4*)(A.x_out32 + (size_t)t * D + c); op[0] = v[j][0] * A.oscale; op[1] = v[j][1] * A.oscale; } }
        }
        if (A.hkv_out || A.hkv8_out) {
#pragma unroll
            for (int j = 0; j < 2; ++j) { const int c = 8 * lane + 512 * j; f32x4 h[2];
#pragma unroll
                for (int q = 0; q < 2; ++q) { const f32x4 sc = *(const f32x4*)(A.kvsc + (size_t)b * 2 * D + c + 4 * q), sh = *(const f32x4*)(A.kvsh + (size_t)b * 2 * D + c + 4 * q); h[q] = v[j][q] * (sc + 1.0f) + sh; }
                if (A.hkv_out) *(v4u*)(A.hkv_out + (size_t)t * D + c) = pack8(h[0], h[1]);
                if (A.hkv8_out) { v2u w; w.x = pg8::cvt4_fp8(h[0][0] * S8_H, h[0][1] * S8_H, h[0][2] * S8_H, h[0][3] * S8_H); w.y = pg8::cvt4_fp8(h[1][0] * S8_H, h[1][1] * S8_H, h[1][2] * S8_H, h[1][3] * S8_H);
                    *(v2u*)(A.hkv8_out + (size_t)t * D + c) = w; } }
        }
        if (A.h_out || A.h8_out) {
            float lg[NE];
#pragma unroll
            for (int e = 0; e < NE; ++e) lg[e] = 0.f;
#pragma unroll
            for (int j = 0; j < 2; ++j) { const int c = 8 * lane + 512 * j; f32x4 h[2];
#pragma unroll
                for (int q = 0; q < 2; ++q) { const f32x4 sc = *(const f32x4*)(A.sc + (size_t)b * A.mstride + c + 4 * q), sh = *(const f32x4*)(A.sh + (size_t)b * A.mstride + c + 4 * q); h[q] = v[j][q] * (sc + 1.0f) + sh; }
                if (A.h_out) *(v4u*)(A.h_out + (size_t)t * D + c) = pack8(h[0], h[1]);
                if (A.h8_out) { v2u w; w.x = pg8::cvt4_fp8(h[0][0] * S8_H, h[0][1] * S8_H, h[0][2] * S8_H, h[0][3] * S8_H); w.y = pg8::cvt4_fp8(h[1][0] * S8_H, h[1][1] * S8_H, h[1][2] * S8_H, h[1][3] * S8_H);
                    *(v2u*)(A.h8_out + (size_t)t * D + c) = w; }
                if (route) {
#pragma unroll
                    for (int e = 0; e < NE; ++e)
#pragma unroll
                        for (int q = 0; q < 2; ++q) { const f32x4 r = *(const LAS f32x4*)(rwT + e * D + c + 4 * q); lg[e] += (h[q][0] * r[0] + h[q][1] * r[1]) + (h[q][2] * r[2] + h[q][3] * r[3]); }
                } }
            if (route) {
#pragma unroll
                for (int e = 0; e < NE; ++e) lg[e] = wave_sum(lg[e]) + A.rb[e];
                int e0 = 0; float v0 = lg[0];
#pragma unroll
                for (int e = 1; e < NE; ++e) if (lg[e] > v0) { v0 = lg[e]; e0 = e; }
                int e1 = -1; float v1 = 0.f;
#pragma unroll
                for (int e = 0; e < NE; ++e) if (e != e0 && (e1 < 0 || lg[e] > v1)) { v1 = lg[e]; e1 = e; }
                if (lane == 0) { const float p1 = __expf(v1 - v0), w0 = 1.0f / (1.0f + p1);
                    A.tok_e[t * 2] = e0; A.tok_e[t * 2 + 1] = e1; A.tok_w[t * 2] = w0; A.tok_w[t * 2 + 1] = p1 * w0;
                    __hip_atomic_fetch_add(lcnt + e0, 1, __ATOMIC_RELAXED, __HIP_MEMORY_SCOPE_WORKGROUP); __hip_atomic_fetch_add(lcnt + e1, 1, __ATOMIC_RELAXED, __HIP_MEMORY_SCOPE_WORKGROUP); }
            }
        }
      }
    }
    if (route) { __syncthreads(); if (tid < NE) A.cntwg[wg * NE + tid] = lcnt[tid]; }
    __syncthreads();
}

__device__ __forceinline__ void moe_assign(const int* cntwg, const int* tok_e, const float* tok_w, int* rowinfo, float* roww, int* meta, const unsigned char* hsrc, unsigned char* hperm, const int rowbytes,
                                           LAS unsigned char* lds, int wg, int tid, int wave, int lane) {
    LAS int* arr = (LAS int*)lds;
    LAS int* tot = (LAS int*)(lds + 8192);
    LAS int* mybase = (LAS int*)(lds + 8192 + 64);
    LAS int* earr = (LAS int*)(lds + 8192 + 128);
    LAS int* posarr = (LAS int*)(lds + 8192 + 128 + 512);
    { const v4u c4 = *((const v4u*)cntwg + tid); *((LAS v4u*)arr + tid) = c4; }
    if (tid < 128) earr[tid] = tok_e[wg * 128 + tid];
    __syncthreads();
    {
        const int e = wave; int s4[4]; int s = 0;
#pragma unroll
        for (int q = 0; q < 4; ++q) { s4[q] = arr[(4 * lane + q) * 8 + e]; s += s4[q]; }
        int inc = s;
#pragma unroll
        for (int o = 1; o < 64; o <<= 1) { const int y = __shfl_up(inc, o); if (lane >= o) inc += y; }
        const int total = __shfl(inc, 63);
        int excl = inc - s;
        const int lc = wg >> 2, qc = wg & 3;
#pragma unroll
        for (int q = 0; q < 4; ++q) if (q < qc) excl += s4[q];
        const int mine = __shfl(excl, lc);
        if (lane == 0) { tot[e] = total; mybase[e] = mine; }
    }
    __syncthreads();
    int off[NE + 1]; { int s = 0;
#pragma unroll
        for (int e = 0; e < NE; ++e) { off[e] = s; s += (tot[e] + 255) & ~255; } off[NE] = s; }
    if (tid < 128) {
        const int e = earr[tid]; int rank = 0;
        for (int j = 0; j < tid; ++j) rank += (earr[j] == e) ? 1 : 0;
        int o = 0;
#pragma unroll
        for (int q = 0; q < NE; ++q) o = (q == e) ? off[q] : o;
        const int pos = o + mybase[e] + rank;
        posarr[tid] = pos; rowinfo[pos] = wg * 128 + tid; roww[pos] = tok_w[wg * 128 + tid];
    }
    __syncthreads();
    for (int it = wave; it < 128; it += NWAVES) {
        const int tok = wg * 64 + (it >> 1), pos = posarr[it];
        const v4u* src = (const v4u*)(hsrc + (size_t)tok * rowbytes); v4u* dst = (v4u*)(hperm + (size_t)pos * rowbytes);
        if (rowbytes == 2048) { const v4u a = src[lane], b = src[lane + 64]; dst[lane] = a; dst[lane + 64] = b; } else { dst[lane] = src[lane]; }
    }
    if (wg == 0) {
#pragma unroll
        for (int e = 0; e < NE; ++e) for (int r = off[e] + tot[e] + tid; r < off[e + 1]; r += NTHR) { rowinfo[r] = -1; roww[r] = 0.f; }
        const int NT = off[NE] >> 8;
        if (tid <= NE) { int o = 0;
#pragma unroll
            for (int q = 0; q <= NE; ++q) o = (q == tid) ? off[q] : o;
            meta[tid] = o; }
        if (tid == 0) meta[9] = NT;
        for (int tI = tid; tI < NT; tI += NTHR) { int e = 0;
#pragma unroll
            for (int q = 1; q < NE; ++q) if (tI * 256 >= off[q]) e = q;
            meta[16 + tI] = e; }
    }
    __syncthreads();
}

__device__ __forceinline__ void conv_phase(const bf16_t* u, const float* wdw, const float* bdw, const float* gn, const float* bn, bf16_t* u2, LAS unsigned char* lds, int wg, int tid, int wave, int lane) {
    LAS f32x4* wl = (LAS f32x4*)lds;
    for (int i = tid; i < CONVK * D / 4; i += NTHR) wl[i] = *((const f32x4*)wdw + i);
    __syncthreads();
    for (int it = 0; it < 2; ++it) {
        const int tb = wg * 64 + it * 32 + wave * 4;
        const int ts0 = (tb & (S - 1)) - (CONVK - 1);
        const bf16_t* ub = u + (ptrdiff_t)(tb - (CONVK - 1)) * D + 8 * lane;
        f32x4 acc[4][4];
#pragma unroll
        for (int o = 0; o < 4; ++o)
#pragma unroll
            for (int q = 0; q < 4; ++q) acc[o][q] = *(const f32x4*)(bdw + 8 * lane + 512 * (q >> 1) + 4 * (q & 1));
        f32x4 wwin[4][4];
#pragma unroll
        for (int r = 0; r < CONVK + 3; ++r) {
            if (r < CONVK) {
#pragma unroll
                for (int q = 0; q < 4; ++q) wwin[r & 3][q] = wl[r * 256 + 2 * lane + 128 * (q >> 1) + (q & 1)];
            }
            if (ts0 + r >= 0) {
                f32x4 uv[4];
#pragma unroll
                for (int j = 0; j < 2; ++j) unpack8(*(const v4u*)(ub + (ptrdiff_t)r * D + 512 * j), uv[2 * j], uv[2 * j + 1]);
#pragma unroll
                for (int o = 0; o < 4; ++o) { const int k = r - o; if (k >= 0 && k < CONVK) {
#pragma unroll
                        for (int q = 0; q < 4; ++q) acc[o][q] += uv[q] * wwin[k & 3][q]; } }
            }
        }
#pragma unroll
        for (int o = 0; o < 4; ++o) {
            float sm = 0.f;
#pragma unroll
            for (int q = 0; q < 4; ++q) sm += (acc[o][q][0] + acc[o][q][1]) + (acc[o][q][2] + acc[o][q][3]);
            const float mean = wave_sum(sm) * (1.0f / D); float qq = 0.f;
#pragma unroll
            for (int q = 0; q < 4; ++q) { acc[o][q] = acc[o][q] - mean; qq += (acc[o][q][0] * acc[o][q][0] + acc[o][q][1] * acc[o][q][1]) + (acc[o][q][2] * acc[o][q][2] + acc[o][q][3] * acc[o][q][3]); }
            const float rstd = rsqrtf(wave_sum(qq) * (1.0f / D) + LN_EPS);
#pragma unroll
            for (int j = 0; j < 2; ++j) { f32x4 y[2];
#pragma unroll
                for (int hh = 0; hh < 2; ++hh) { const int c = 8 * lane + 512 * j + 4 * hh; const f32x4 v = acc[o][2 * j + hh] * rstd * *(const f32x4*)(gn + c) + *(const f32x4*)(bn + c);
                    y[hh] = (f32x4){silu_f(v[0]), silu_f(v[1]), silu_f(v[2]), silu_f(v[3])}; }
                *(v4u*)(u2 + (size_t)(tb + o) * D + 8 * lane + 512 * j) = pack8(y[0], y[1]); }
        }
    }
    __syncthreads();
}

constexpr int AT_QM = 4096 + 2 * 64 * 144 + 2 * 64 * 136, AT_KM = 0, AT_K = 4096, AT_KPITCH = 144, AT_KBUF = 64 * AT_KPITCH, AT_V = AT_K + 2 * AT_KBUF, AT_VPITCH = 136, AT_VBUF = 64 * AT_VPITCH;
__device__ __forceinline__ void attn_unit(int b, int h, int qi, const bf16_t* Q, const bf16_t* K, const bf16_t* Vt, const float* kmean, const float* kabs, bf16_t* O, LAS unsigned char* lds, int tid, int wave, int lane) {
    const int r32 = lane & 31, hi = lane >> 5;
    const int q0 = qi * 256;
    if (tid < 256) *((LAS f32x4*)(lds + AT_KM) + tid) = *((const f32x4*)(kmean + (size_t)(b * NH + h) * NBLK * HD) + tid);
    const bf16_t* qrow = Q + (size_t)(b * S + q0 + wave * 32 + r32) * D + h * HD;
    bf16x8 qr[4];
#pragma unroll
    for (int d0 = 0; d0 < 4; ++d0) qr[d0] = *(const bf16x8*)(qrow + d0 * 16 + hi * 8);
    const int srow = tid >> 3, sch = tid & 7;
    const bf16_t* kg = K + (size_t)(b * S + srow) * D + h * HD + sch * 8;
    const bf16_t* vg = Vt + (size_t)(h * HD + srow) * T + b * S + sch * 8;
    const int kst = AT_K + srow * AT_KPITCH + sch * 16, vst = AT_V + srow * AT_VPITCH + sch * 16;
    { float l1 = 0.f;
#pragma unroll
      for (int d0 = 0; d0 < 4; ++d0)
#pragma unroll
          for (int e = 0; e < 8; ++e) l1 += fabsf(bf2f((unsigned short)qr[d0][e]));
      l1 += __shfl_xor(l1, 32);
#pragma unroll
      for (int o = 16; o >= 1; o >>= 1) l1 = fmaxf(l1, __shfl_xor(l1, o));
      if (lane == 0) *((LAS float*)(lds + AT_QM) + wave) = l1; }
    __syncthreads();
    const float slope2 = exp2f(-8.0f * (float)(h + 1) / (float)NH) * LOG2E;
    unsigned livemask = 1u << qi;
    { float qmax = 0.f;
#pragma unroll
      for (int w = 0; w < NWAVES; ++w) qmax = fmaxf(qmax, *((const LAS float*)(lds + AT_QM) + w));
      const float* kab = kabs + (b * NH + h) * NBLK; const float kown = kab[qi];
#pragma unroll
      for (int n = 0; n < NBLK; ++n) if (n < qi) { const float bound = qmax * (kab[n] + kown) * 1.02f + 160.0f; if (!(slope2 * (float)(256 * (qi - n) - 255) > bound)) livemask |= 1u << n; }
      livemask = (unsigned)__builtin_amdgcn_readfirstlane((int)livemask); }
    unsigned remn = livemask; int jn = __builtin_ctz(remn), ttn = 0;
    v4u kreg = *(const v4u*)(kg + (size_t)(4 * jn) * 64 * D), vreg = *(const v4u*)(vg + (size_t)(4 * jn) * 64);
    unsigned selmask = 1u << qi;
    {
        float gate[NBLK];
#pragma unroll
        for (int n = 0; n < NBLK; ++n) {
            float s = 0.f;
            if (n < qi) {
#pragma unroll
                for (int d0 = 0; d0 < 4; ++d0) { const LAS f32x4* kmp = (const LAS f32x4*)(lds + AT_KM + (n * HD + d0 * 16 + hi * 8) * 4); const f32x4 k0 = kmp[0], k1 = kmp[1];
                    s += bf2f((unsigned short)qr[d0][0]) * k0[0] + bf2f((unsigned short)qr[d0][1]) * k0[1] + bf2f((unsigned short)qr[d0][2]) * k0[2] + bf2f((unsigned short)qr[d0][3]) * k0[3]
                       + bf2f((unsigned short)qr[d0][4]) * k1[0] + bf2f((unsigned short)qr[d0][5]) * k1[1] + bf2f((unsigned short)qr[d0][6]) * k1[2] + bf2f((unsigned short)qr[d0][7]) * k1[3]; }
                s += __shfl_xor(s, 32);
            }
            gate[n] = s;
        }
#pragma unroll
        for (int r = 0; r < 3; ++r) {
            int best = -1; float bv = 0.f;
#pragma unroll
            for (int n = 0; n < NBLK; ++n) if (n < qi && !((selmask >> n) & 1u)) { if (best < 0 || gate[n] > bv) { best = n; bv = gate[n]; } }
            if (best >= 0) selmask |= 1u << best;
        }
    }
    f32x16 cb0, cb1;
#pragma unroll
    for (int r = 0; r < 16; ++r) { const int kk = (r & 3) + 8 * (r >> 2) + 4 * hi; cb0[r] = slope2 * (float)kk; cb1[r] = slope2 * (float)(kk + 32); }
    f32x16 o0 = {}, o1 = {};
    float m_run = -1.0e30f, l_run = 0.f;
    const int qrel = wave * 32 + r32;
    for (int it = 0;; ++it) {
        const int buf = it & 1;
        const int j = jn, tt = ttn, tl = 4 * jn + ttn;
        *(LAS v4u*)(lds + kst + buf * AT_KBUF) = kreg;
        *(LAS v2u*)(lds + vst + buf * AT_VBUF) = (v2u){vreg.x, vreg.y}; *(LAS v2u*)(lds + vst + buf * AT_VBUF + 8) = (v2u){vreg.z, vreg.w};
        bool more = true;
        if (++ttn == 4) { ttn = 0; remn &= remn - 1; more = remn != 0u; if (more) jn = __builtin_ctz(remn); }
        if (more) { kreg = *(const v4u*)(kg + (size_t)(4 * jn + ttn) * 64 * D); vreg = *(const v4u*)(vg + (size_t)(4 * jn + ttn) * 64); }
        __syncthreads();
        const bool own = (j == qi);
        const bool rowsel = ((selmask >> j) & 1u) != 0u;
        bool skip = own ? (64 * tt > wave * 32 + 31) : (__builtin_amdgcn_ballot_w64(rowsel) == 0ull);
        if (skip) { if (!more) break; continue; }
        const LAS unsigned char* kb = lds + AT_K + buf * AT_KBUF + r32 * AT_KPITCH + hi * 16;
        f32x16 p0 = cb0, p1 = cb1;
#pragma unroll
        for (int d0 = 0; d0 < 4; ++d0) {
            const bf16x8 a0 = *(const LAS bf16x8*)(kb + d0 * 32), a1 = *(const LAS bf16x8*)(kb + 32 * AT_KPITCH + d0 * 32);
            p0 = __builtin_amdgcn_mfma_f32_32x32x16_bf16(a0, qr[d0], p0, 0, 0, 0);
            p1 = __builtin_amdgcn_mfma_f32_32x32x16_bf16(a1, qr[d0], p1, 0, 0, 0);
        }
        if (own) {
#pragma unroll
            for (int r = 0; r < 16; ++r) { const int kk = 64 * tt + (r & 3) + 8 * (r >> 2) + 4 * hi; if (kk > qrel) p0[r] = -INFINITY; if (kk + 32 > qrel) p1[r] = -INFINITY; }
        }
        float tm = fmaxf(p0[0], p1[0]);
#pragma unroll
        for (int r = 1; r < 16; ++r) tm = fmaxf(tm, fmaxf(p0[r], p1[r]));
        tm = fmaxf(tm, __shfl_xor(tm, 32));
        const float toff = slope2 * (float)(64 * tl - q0 - 255);
        const float mnew = rowsel ? fmaxf(m_run, tm + toff) : m_run;
        const float alpha = __builtin_amdgcn_exp2f(m_run - mnew);
        const float msub = rowsel ? (mnew - toff) : INFINITY;
        m_run = mnew;
        float ls = 0.f;
#pragma unroll
        for (int r = 0; r < 16; ++r) { p0[r] = __builtin_amdgcn_exp2f(p0[r] - msub); p1[r] = __builtin_amdgcn_exp2f(p1[r] - msub); ls += p0[r] + p1[r]; }
        l_run = l_run * alpha + ls;
        if (__builtin_amdgcn_ballot_w64(alpha != 1.0f) != 0ull) { o0 = o0 * alpha; o1 = o1 * alpha; }
        bf16x8 pb[4];
#pragma unroll
        for (int s = 0; s < 4; ++s) {
            unsigned w[4];
#pragma unroll
            for (int q = 0; q < 4; ++q) w[q] = (s < 2) ? pk2(p0[8 * (s & 1) + 2 * q], p0[8 * (s & 1) + 2 * q + 1]) : pk2(p1[8 * (s & 1) + 2 * q], p1[8 * (s & 1) + 2 * q + 1]);
            pb[s] = __builtin_bit_cast(bf16x8, (v4u){w[0], w[1], w[2], w[3]});
        }
        const LAS unsigned char* vb = lds + AT_V + buf * AT_VBUF + r32 * AT_VPITCH + hi * 8;
#pragma unroll
        for (int s = 0; s < 4; ++s) {
            const int kk2 = (32 * (s >> 1) + 16 * (s & 1)) * 2;
            const v2u a0l = *(const LAS v2u*)(vb + kk2), a0h = *(const LAS v2u*)(vb + kk2 + 16);
            const v2u a1l = *(const LAS v2u*)(vb + 32 * AT_VPITCH + kk2), a1h = *(const LAS v2u*)(vb + 32 * AT_VPITCH + kk2 + 16);
            const bf16x8 va0 = __builtin_bit_cast(bf16x8, (v4u){a0l.x, a0l.y, a0h.x, a0h.y}), va1 = __builtin_bit_cast(bf16x8, (v4u){a1l.x, a1l.y, a1h.x, a1h.y});
            o0 = __builtin_amdgcn_mfma_f32_32x32x16_bf16(va0, pb[s], o0, 0, 0, 0);
            o1 = __builtin_amdgcn_mfma_f32_32x32x16_bf16(va1, pb[s], o1, 0, 0, 0);
        }
        if (!more) break;
    }
    const float ltot = l_run + __shfl_xor(l_run, 32);
    const float inv = 1.0f / ltot;
    bf16_t* orow = O + (size_t)(b * S + q0 + wave * 32 + r32) * D + h * HD;
#pragma unroll
    for (int g = 0; g < 4; ++g) {
        v2u w0, w1;
        w0.x = pk2(o0[4 * g] * inv, o0[4 * g + 1] * inv); w0.y = pk2(o0[4 * g + 2] * inv, o0[4 * g + 3] * inv);
        w1.x = pk2(o1[4 * g] * inv, o1[4 * g + 1] * inv); w1.y = pk2(o1[4 * g + 2] * inv, o1[4 * g + 3] * inv);
        *(v2u*)(orow + 8 * g + 4 * hi) = w0; *(v2u*)(orow + 32 + 8 * g + 4 * hi) = w1;
    }
    __syncthreads();
}
struct AttnOrder { unsigned char hq[256]; };
constexpr AttnOrder make_attn_order() {
    AttnOrder o{}; int cost[256] = {}; const int nb[16] = {1, 2, 2, 3, 4, 6, 8, 11, 15, 15, 15, 15, 15, 15, 15, 15};
    for (int k = 0; k < 256; ++k) { const int h = k >> 4, i = k & 15; o.hq[k] = (unsigned char)k; cost[k] = 8 * (i < nb[h] ? i : nb[h]) + 5; }
    for (int a = 1; a < 256; ++a) { const int c = cost[a]; const unsigned char v = o.hq[a]; int q = a - 1; while (q >= 0 && cost[q] < c) { cost[q + 1] = cost[q]; o.hq[q + 1] = o.hq[q]; --q; } cost[q + 1] = c; o.hq[q + 1] = v; }
    return o;
}
__device__ constexpr AttnOrder ATTN_ORDER = make_attn_order();
__device__ __forceinline__ void attn_phase(const bf16_t* Q, const bf16_t* K, const bf16_t* Vt, const float* kmean, const float* kabs, bf16_t* O, LAS unsigned char* lds, int wg, int G, int tid, int wave, int lane) {
    for (int r = 0; r < 4; ++r) {
        const int u = (r == 0) ? wg : (r == 1) ? 511 - wg : (r == 2) ? 512 + wg : 1023 - wg;
        const int hq = ATTN_ORDER.hq[u >> 2], b = u & 3;
        attn_unit(b, hq >> 4, hq & 15, Q, K, Vt, kmean, kabs, O, lds, tid, wave, lane);
    }
}

#ifndef REP_ATTN
#define REP_ATTN 1
#endif
#ifndef REP_B1
#define REP_B1 1
#endif
#ifndef REP_CI
#define REP_CI 1
#endif
#ifndef REP_CONV
#define REP_CONV 1
#endif
#ifndef REP_E0
#define REP_E0 1
#endif
#ifndef REP_E1
#define REP_E1 1
#endif
#ifndef REP_E2
#define REP_E2 1
#endif
#ifndef REP_F1
#define REP_F1 1
#endif
#ifndef REP_F2
#define REP_F2 1
#endif
#ifndef REP_P0
#define REP_P0 1
#endif
#ifndef REP_ROW
#define REP_ROW 1
#endif
#ifndef REP_X3
#define REP_X3 1
#endif
#ifndef TPROBE
#define TPROBE -1
#endif
#ifndef TP_MULT
#define TP_MULT 2
#endif
#define PH_BEGIN(REP, CLS) if (lo <= ph && ph < hi) { if (TPROBE >= 0) { unsigned long long now_ = __builtin_amdgcn_s_memrealtime(); \
                 if (tp.cls == TPROBE) { const unsigned long long d_ = (now_ - tp.t0) * TP_MULT; while (__builtin_amdgcn_s_memrealtime() - now_ < d_) __builtin_amdgcn_s_sleep(8); now_ = __builtin_amdgcn_s_memrealtime(); } \
                 tp.t0 = now_; tp.cls = (CLS); } \
                 for (int rep_i = 0; rep_i < (REP); ++rep_i) { if (rep_i) xcd_barrier(bar); int tid = threadIdx.x; asm volatile("" : "+v"(tid)); const int lane = tid & 63, wave = __builtin_amdgcn_readfirstlane(tid >> 6); \
                 int wg = vwg; asm volatile("" : "+s"(wg)); unsigned char* ws = args.ws; asm volatile("" : "+s"(ws)); (void)lane; (void)wave; (void)wg;
#define PH_END   } if (ph + 1 < hi) xcd_barrier(bar); } ++ph;
struct TProbe { unsigned long long acc, t0; int cls; };
#define WSP(Ty, off) ((Ty*)(ws + (off)))
#define MODP  WSP(float, WS_MOD)


template <int L> __device__ __forceinline__ void layer_phases(const Args& args, LAS unsigned char* lds, const XcdBarrier& bar, const int lo, const int hi, const int G, const int vwg, TProbe& tp) {
    constexpr int l = L;
    int ph = 2 + (L >= 1 ? 7 : 0) + (L >= 2 ? 8 : 0) + (L >= 3 ? 7 : 0);
#define MLP   (MODP + (size_t)l * NB * 6 * D)
#define XIN   ((l == 0) ? (const void*)args.in[0] : (const void*)(ws + WS_X0 + (size_t)(2 * l - 1) * 64 * MiB))
#define X1P   ((bf16_t*)(ws + WS_X0 + (size_t)(2 * l) * 64 * MiB))
#define X2P   ((bf16_t*)(ws + WS_X0 + (size_t)(2 * l + 1) * 64 * MiB))
        if (l < NA) {
            PH_BEGIN(REP_CI, 2)
                constexpr bool F8 = FP8_CONV != 0; constexpr int EB = F8 ? 1 : 2;
                pg8::Gemm g{WSP(bf16_t, WS_HBF), (const bf16_t*)(ws + W_CI + (size_t)l * 2 * D * D * EB), T, 2 * D, D * EB / 2}; pg8::StaticOrder So; So.init(T, 2 * D, G, wg);
                pg8::EpiGated<0, 0> E{WSP(bf16_t, WS_U), D, args.in[7] + l * 2 * D, D, F8 ? 1.0f / (S8_H * S8_WP) : 1.0f, 1.0f};
                pg8::gemm_phase<pg8::EpiGated<0, 0>, pg8::StaticOrder, true, true, F8>(lds, g, So, E);
            PH_END
            PH_BEGIN(REP_CONV, 3)
                conv_phase(WSP(bf16_t, WS_U), args.in[8] + l * CONVK * D, args.in[9] + l * D, args.in[10] + l * D, args.in[11] + l * D, WSP(bf16_t, WS_U2), lds, wg, tid, wave, lane);
            PH_END
        } else {
            PH_BEGIN(REP_B1, 4)
                constexpr bool AF8 = FP8_ATTN != 0; constexpr int AEB = AF8 ? 1 : 2;
                if (l == NA) {
                    { pg8::Gemm g{WSP(bf16_t, WS_HKV), WSP(const bf16_t, W_KV), T, D, D * AEB / 2}; pg8::StaticOrder So; So.init(T, D, G, wg);
                      pg8::EpiK E{WSP(bf16_t, WS_K), D, WSP(float, WS_KMEAN), WSP(unsigned, WS_KABS), AF8 ? 1.0f / (S8_H * S8_WP) : 1.0f};
                      pg8::gemm_phase<pg8::EpiK, pg8::StaticOrder, true, true, AF8>(lds, g, So, E); }
                    { pg8::Gemm g{(const bf16_t*)(ws + W_KV + (size_t)D * D * AEB), WSP(bf16_t, WS_HKV), D, T, D * AEB / 2}; pg8::StaticOrder So; So.init(D, T, G, wg);
                      pg8::EpiBf16S E{WSP(bf16_t, WS_VT), T, AF8 ? 1.0f / (S8_H * S8_WP) : 1.0f};
                      pg8::gemm_phase<pg8::EpiBf16S, pg8::StaticOrder, true, true, AF8>(lds, g, So, E); }
                }
                { pg8::Gemm g{WSP(bf16_t, WS_HBF), (const bf16_t*)(ws + W_Q + (size_t)(l - NA) * D * D * AEB), T, D, D * AEB / 2}; pg8::StaticOrder So; So.init(T, D, G, wg);
                  pg8::EpiBf16S E{WSP(bf16_t, WS_U), D, AF8 ? QSCALE / (S8_H * S8_WP) : QSCALE};
                  pg8::gemm_phase<pg8::EpiBf16S, pg8::StaticOrder, true, true, AF8>(lds, g, So, E); }
            PH_END
            PH_BEGIN(REP_ATTN, 5)
                attn_phase(WSP(bf16_t, WS_U), WSP(bf16_t, WS_K), WSP(bf16_t, WS_VT), WSP(float, WS_KMEAN), WSP(float, WS_KABS), WSP(bf16_t, WS_U2), lds, wg, G, tid, wave, lane);
            PH_END
        }
        PH_BEGIN(REP_X3, 6)
            constexpr bool F8 = (L < NA) ? (FP8_CONV != 0) : (FP8_ATTN != 0); constexpr int EB = F8 ? 1 : 2;
            const bf16_t* Bt = (l < NA) ? (const bf16_t*)(ws + W_CO + (size_t)l * D * D * EB) : (const bf16_t*)(ws + W_O + (size_t)(l - NA) * D * D * EB);
            const float* mixbias = (l < NA) ? args.in[13] + l * D : nullptr;
            pg8::Gemm g{WSP(bf16_t, WS_U2), Bt, T, D, D * EB / 2}; pg8::StaticOrder So; So.init(T, D, G, wg);
            pg8::EpiResid<(L == 0)> E{XIN, WSP(bf16_t, WS_Y), MLP + 2 * D, 6 * D, mixbias, ALPHA, F8 ? 1.0f / (S8_U * S8_WO) : 1.0f};
            pg8::gemm_phase<pg8::EpiResid<(L == 0)>, pg8::StaticOrder, true, true, F8>(lds, g, So, E);
        PH_END
        PH_BEGIN(REP_ROW, 1)
            RowArgs A{}; A.oscale = 1.0f; A.mode = 1; A.y = WSP(bf16_t, WS_Y); A.lng = args.in[4] + (l * 2) * D; A.lnb = args.in[5] + (l * 2) * D; A.x_out = X1P;
            A.sh = MLP + 3 * D; A.sc = MLP + 4 * D; A.mstride = 6 * D;
            if (((l & 1) && FP8_MOE) || (!(l & 1) && FP8_FFN)) A.h8_out = WSP(unsigned char, WS_HBF); else A.h_out = WSP(bf16_t, WS_HBF);
            if (l & 1) { A.rw = args.in[21] + (size_t)(l >> 1) * D * NE; A.rb = args.in[22] + (l >> 1) * NE; A.tok_e = WSP(int, WS_ROUTE + RT_TOKE); A.tok_w = WSP(float, WS_ROUTE + RT_TOKW); A.cntwg = WSP(int, WS_ROUTE + RT_CNTWG); }
            row_phase<((L & 1) ? 2 : 4)>(A, lds, wg, tid, wave, lane);
        PH_END
        if ((l & 1) == 0) {
            PH_BEGIN(REP_F1, 7)
                constexpr bool F8 = FP8_FFN != 0; constexpr int EB = F8 ? 1 : 2;
                pg8::Gemm g{WSP(bf16_t, WS_HBF), (const bf16_t*)(ws + W_F13 + (size_t)(l >> 1) * 2 * DFF * D * EB), T, 2 * DFF, D * EB / 2}; pg8::StaticOrder So; So.init(T, 2 * DFF, G, wg);
                pg8::EpiGated<1, 0, F8> E{WSP(bf16_t, WS_HM), DFF, nullptr, 0, F8 ? 1.0f / (S8_H * S8_W13) : 1.0f, S8_HM};
                pg8::gemm_phase<pg8::EpiGated<1, 0, F8>, pg8::StaticOrder, true, true, F8>(lds, g, So, E);
                if (L == 0) tail_convert(args, ws, M1A7, 8 * CG7_PER, M1A8, 8 * CG8_PER, ((T / 256) * (2 * DFF / 256)) % GRID, lds, wg, G, wave, lane);
                else        tail_convert(args, ws, M3A7, 16 * CG7_PER, M3A8, 16 * CG8_PER, ((T / 256) * (2 * DFF / 256)) % GRID, lds, wg, G, wave, lane);
            PH_END
            PH_BEGIN(REP_F2, 8)
                constexpr bool F8 = FP8_FFN != 0; constexpr int EB = F8 ? 1 : 2;
                pg8::Gemm g{WSP(bf16_t, WS_HM), (const bf16_t*)(ws + W_F2 + (size_t)(l >> 1) * D * DFF * EB), T, D, DFF * EB / 2}; pg8::StaticOrder So; So.init(T, D, G, wg);
                pg8::EpiResid<false> E{X1P, WSP(bf16_t, WS_Y), MLP + 5 * D, 6 * D, nullptr, ALPHA, F8 ? 1.0f / (S8_HM * S8_W2) : 1.0f};
                pg8::gemm_phase<pg8::EpiResid<false>, pg8::StaticOrder, true, true, F8>(lds, g, So, E);
            PH_END
        } else {
            PH_BEGIN(REP_E0, 9)
                moe_assign(WSP(int, WS_ROUTE + RT_CNTWG), WSP(int, WS_ROUTE + RT_TOKE), WSP(float, WS_ROUTE + RT_TOKW), WSP(int, WS_ROUTE + RT_RINFO), WSP(float, WS_ROUTE + RT_RW), WSP(int, WS_ROUTE + RT_META),
                           WSP(unsigned char, WS_HBF), WSP(unsigned char, WS_HPERM), FP8_MOE ? 1024 : 2048, lds, wg, tid, wave, lane);
            PH_END
            PH_BEGIN(REP_E1, 10)
                const int* meta = WSP(int, WS_ROUTE + RT_META); const int NT = __builtin_amdgcn_readfirstlane(meta[9]);
                constexpr bool F8 = FP8_MOE != 0; constexpr int EB = F8 ? 1 : 2;
                pg8::Gemm g{WSP(bf16_t, WS_HPERM), (const bf16_t*)(ws + W_M13 + (size_t)(l >> 1) * NE * 2 * DFE * D * EB), NT * 256, 2 * DFE, D * EB / 2}; pg8::MoeOrder So; So.init(NT, 2 * DFE / 256, G, wg, meta + 16);
                pg8::EpiGated<1, 28, F8> E{WSP(bf16_t, WS_HM), DFE, nullptr, 0, F8 ? 1.0f / (S8_H * S8_W13) : 1.0f, S8_HM};
                pg8::gemm_phase<pg8::EpiGated<1, 28, F8>, pg8::MoeOrder, true, true, F8>(lds, g, So, E);
            PH_END
            PH_BEGIN(REP_E2, 11)
                const int* meta = WSP(int, WS_ROUTE + RT_META); const int NT = __builtin_amdgcn_readfirstlane(meta[9]);
                constexpr bool F8 = FP8_MOE != 0; constexpr int EB = F8 ? 1 : 2;
                pg8::Gemm g{WSP(bf16_t, WS_HM), (const bf16_t*)(ws + W_M2 + (size_t)(l >> 1) * NE * D * DFE * EB), NT * 256, D, DFE * EB / 2}; pg8::MoeOrder So; So.init(NT, D / 256, G, wg, meta + 16);
                pg8::EpiMoeOut E{WSP(bf16_t, WS_MOEO), WSP(int, WS_ROUTE + RT_RINFO), WSP(float, WS_ROUTE + RT_RW), F8 ? 1.0f / (S8_HM * S8_W2) : 1.0f, (size_t)0};
                pg8::gemm_phase<pg8::EpiMoeOut, pg8::MoeOrder, true, true, F8>(lds, g, So, E);
                if (L == 1) tail_convert(args, ws, 8 * CG7_PER, M3A7, 8 * CG8_PER, M3A8, (NT * (D / 256)) % GRID, lds, wg, G, wave, lane);
            PH_END
        }
        PH_BEGIN(REP_ROW, 1)
            RowArgs A{}; A.oscale = 1.0f;
            A.lng = args.in[4] + (l * 2 + 1) * D; A.lnb = args.in[5] + (l * 2 + 1) * D; if (l == DEPTH - 1) A.x_out32 = args.out; else A.x_out = X2P;
            if ((l & 1) == 0) { A.mode = 1; A.y = WSP(bf16_t, WS_Y); } else { A.mode = 2; A.x_in = X1P; A.moeo = WSP(bf16_t, WS_MOEO); A.gate = MLP + 5 * D; A.gstride = 6 * D; }
            if (l + 1 < DEPTH) { const float* mn = MODP + (size_t)(l + 1) * NB * 6 * D; A.sh = mn; A.sc = mn + D; A.mstride = 6 * D;
                if ((l + 1 < NA) ? (FP8_CONV != 0) : (FP8_ATTN != 0)) A.h8_out = WSP(unsigned char, WS_HBF); else A.h_out = WSP(bf16_t, WS_HBF); }
            if (l + 1 == NA) { const float* kvmod = MODP + (size_t)DEPTH * NB * 6 * D; A.kvsh = kvmod; A.kvsc = kvmod + D; if (FP8_ATTN) A.hkv8_out = WSP(unsigned char, WS_HKV); else A.hkv_out = WSP(bf16_t, WS_HKV); }
            row_phase<((L & 1) ? 2 : 4)>(A, lds, wg, tid, wave, lane);
        PH_END
}
#undef MLP
#undef XIN
#undef X1P
#undef X2P
__global__ void __launch_bounds__(NTHR, 2) mega_fwd(Args args) {
    extern __shared__ __attribute__((aligned(16))) unsigned char lds_raw[];
    LAS unsigned char* lds = (LAS unsigned char*)lds_raw;
    const int G = gridDim.x;
    for (int u = threadIdx.x; u < (LDS_BYTES - LDSCTL_OFF) / 4; u += NTHR) ((LAS unsigned*)(lds + LDSCTL_OFF))[u] = 0u;
    __syncthreads();
    XcdBarrier bar = xcd_barrier_post((unsigned*)(args.ws + WS_CTL) + CW_BAR, (volatile LAS unsigned*)(lds + LDSCTL_OFF));
    if (threadIdx.x == 0) { const unsigned xcc = xb_xcc_id() & 7u; const unsigned rank = __hip_atomic_fetch_add((unsigned*)(args.ws + WS_CTL) + CW_VWG + 64 * xcc, 1u, __ATOMIC_RELAXED, __HIP_MEMORY_SCOPE_AGENT);
        if (rank >= 32u) __hip_atomic_store((unsigned*)(args.ws + WS_CTL) + CW_VWG + 64 * 8, 1u, __ATOMIC_RELAXED, __HIP_MEMORY_SCOPE_AGENT);
        ((volatile LAS unsigned*)(lds + LDSCTL_OFF))[4] = xcc + 8u * (rank & 31u); }
    __syncthreads();
    int vwg = blockIdx.x;
    const int lo = args.ph_lo, hi = args.ph_hi;
    int ph = 0; TProbe tp{0ull, 0ull, -1};
    PH_BEGIN(REP_P0, 0)
        LAS float* ca = (LAS float*)lds; LAS float* red = (LAS float*)(lds + 16384);
        for (int i = tid; i < NB * D; i += NTHR) ca[i] = silu_f(args.in[1][i]);
        __syncthreads();
        for (int unit = wg; unit < (DEPTH * 6 * D + 2 * D) / 64; unit += G) mod_unit(unit, args.in[2], args.in[3], args.in[14], args.in[15], MODP, ca, red, wave, lane);
        __syncthreads();
        { LAS unsigned* scr = (LAS unsigned*)(lds + 32768 + wave * 8448); const int gw = wg * NWAVES + wave, ngw = G * NWAVES;
#pragma unroll
          for (int g = 0; g < 7; ++g) { const ConvGroup Gq = conv_group(g); conv_range(args, ws, g, 0, Gq.count * (Gq.K / 64) * (Gq.N / 64), scr, (gw + 37 * g) % ngw, ngw, lane); }
          conv_range(args, ws, 7, 0, M1A7, scr, gw, ngw, lane); conv_range(args, ws, 8, 0, M1A8, scr, (gw + 1024) % ngw, ngw, lane); }
    PH_END
    if (VWG_MODE && lo == 0 && hi > 1) { const unsigned bad_ = __hip_atomic_load((unsigned*)(args.ws + WS_CTL) + CW_VWG + 64 * 8, __ATOMIC_RELAXED, __HIP_MEMORY_SCOPE_AGENT);
        if (!bad_) vwg = __builtin_amdgcn_readfirstlane((int)((volatile LAS unsigned*)(lds + LDSCTL_OFF))[4]); }
    PH_BEGIN(REP_ROW, 1)
        RowArgs A{}; A.oscale = 1.0f; A.mode = 0; A.x_in = args.in[0]; A.sh = MODP; A.sc = MODP + D; A.mstride = 6 * D; if (FP8_CONV) A.h8_out = WSP(unsigned char, WS_HBF); else A.h_out = WSP(bf16_t, WS_HBF);
        row_phase<4>(A, lds, wg, tid, wave, lane);
    PH_END
    layer_phases<0>(args, lds, bar, lo, hi, G, vwg, tp);
    layer_phases<1>(args, lds, bar, lo, hi, G, vwg, tp);
    layer_phases<2>(args, lds, bar, lo, hi, G, vwg, tp);
    layer_phases<3>(args, lds, bar, lo, hi, G, vwg, tp);
}
#undef PH_BEGIN
#undef PH_END
constexpr int N_PHASES = 2 + 7 + 8 + 7 + 8;
__host__ inline int phases_through_sublayer(int s) { const int per[4] = {7, 8, 7, 8}; const int l = s / 2; int p = 2; for (int i = 0; i < l; ++i) p += per[i]; p += (s & 1) ? per[l] : 4; return p; }
}
extern "C" void kernel_launch(void* const* d_in, const int* in_sizes, int n_in, void* d_out, int out_size, void* d_ws, size_t ws_size, hipStream_t stream) {
    using namespace mk;
    static int grid = 0;
    if (grid == 0) {
        if (n_in != 25 || in_sizes[0] != T * D || out_size != T * D || ws_size < WS_END) { fprintf(stderr, "kernel_launch: unexpected problem shape / workspace (n_in %d, ws %zu < %zu); nothing launched\n", n_in, ws_size, (size_t)WS_END); grid = -1; return; }
        int dev = 0, cus = 0, per_cu = 0;
        if (hipGetDevice(&dev) != hipSuccess || hipDeviceGetAttribute(&cus, hipDeviceAttributeMultiprocessorCount, dev) != hipSuccess) { grid = -1; return; }
        if (hipFuncSetAttribute((const void*)mega_fwd, hipFuncAttributeMaxDynamicSharedMemorySize, LDS_BYTES) != hipSuccess) { fprintf(stderr, "kernel_launch: hipFuncSetAttribute failed\n"); grid = -1; return; }
        if (hipOccupancyMaxActiveBlocksPerMultiprocessor(&per_cu, (const void*)mega_fwd, NTHR, LDS_BYTES) != hipSuccess || per_cu < 1) { fprintf(stderr, "kernel_launch: occupancy query says %d blocks per CU\n", per_cu); (void)hipGetLastError(); grid = -1; return; }
        if (cus != GRID) { fprintf(stderr, "kernel_launch: built for a 256-CU device (one workgroup per CU), found %d CUs; nothing launched\n", cus); grid = -1; return; }
        grid = GRID;
    }
    if (grid < 0) return;
    (void)hipMemsetAsync((char*)d_ws + WS_CTL, 0, CTL_ZERO_BYTES, stream);
    Args a{};
    for (int i = 0; i < 25; ++i) a.in[i] = (const float*)d_in[i];
    a.out = (float*)d_out; a.ws = (unsigned char*)d_ws;
    const int P = phases_through_sublayer(HYB_SUB);
#if MK_PER_PHASE
    for (int p = 0; p < P; ++p) { a.ph_lo = p; a.ph_hi = p + 1; hipLaunchKernelGGL(mega_fwd, dim3(grid), dim3(NTHR), LDS_BYTES, stream, a); }
#else
    a.ph_lo = 0; a.ph_hi = P;
    hipLaunchKernelGGL(mega_fwd, dim3(grid), dim3(NTHR), LDS_BYTES, stream, a);
#endif
#if HYB_SUB < 7
    nv::forward(d_in, (float*)d_out, (char*)d_ws + NAIVE_BASE, stream, HYB_SUB + 1, (const float*)((char*)d_ws + WS_X0 + (size_t)HYB_SUB * 64 * MiB), (const float*)((char*)d_ws + WS_X0 + (size_t)3 * 64 * MiB));
#endif
}
```

```cpp
#include <hip/hip_runtime.h>
#include <cstdio>
#include <cstdint>
#ifndef HYB_SUB
#define HYB_SUB 7
#endif
#ifndef MK_PER_PHASE
#define MK_PER_PHASE 0
#endif
namespace pg8 {
#define PG8_LAS __attribute__((address_space(3)))
typedef unsigned short bf16_t;
typedef short bf16x8 __attribute__((ext_vector_type(8)));
typedef float f32x4 __attribute__((ext_vector_type(4)));
typedef unsigned u32x4 __attribute__((ext_vector_type(4)));
constexpr int BM = 256, BK = 64, HALF = 128, HTB = HALF * BK * 2  , STAGE_BYTES = 8 * HTB, NXCD = 8, WGM = 8;

__host__ __device__ __forceinline__ int lds_byte(int r, int c) { const int st = (r >> 4) * 2 + (c >> 5), rr = r & 15, cc = c & 31, ob = rr * 64 + cc * 2; return st * 1024 + (ob ^ (((ob >> 9) & 1) << 5)); }
__host__ __device__ __forceinline__ void stage_rc(int b, int& R, int& C) { const int st = b / 1024, sb = b % 1024, swz = sb ^ (((sb >> 9) & 1) << 5); R = (st >> 1) * 16 + swz / 64; C = (st & 1) * 32 + (swz % 64) / 2; }
__host__ __device__ __forceinline__ int perm32(int rho) { const int n = rho >> 4, i = rho & 15; return 8 * (i >> 2) + 4 * n + (i & 3); }

struct Unit { int pm, pn, ko; };
struct Gemm { const bf16_t* A; const bf16_t* Bt; int M, N, K, ld; };

struct StaticOrder {
    int nM, nN, nwg, G, c;
    __host__ __device__ void init(int M, int N, int G_, int c_) { nM = M / BM; nN = N / BM; nwg = nM * nN; G = G_; c = c_; }
    __host__ __device__ bool next(int i, Unit& u) const {
        const long L = (long)i * G + c; if (L >= nwg) return false;
        int wgid = (int)L; { const int q = nwg / NXCD, r = nwg % NXCD, xcd = wgid % NXCD, off = wgid / NXCD; wgid = (xcd < r ? xcd * (q + 1) : r * (q + 1) + (xcd - r) * q) + off; }
        const int nig = WGM * nN, gid = wgid / nig, fm = gid * WGM, gsz = (nM - fm) < WGM ? (nM - fm) : WGM;
        u.pm = fm + ((wgid % nig) % gsz); u.pn = (wgid % nig) / gsz; u.ko = 0; return true;
    }
    __device__ __forceinline__ void a_ready(const Unit&) const {}
    __device__ __forceinline__ void done(const Unit&) const {}
};

__device__ __forceinline__ unsigned cvt_pk_bf16(float lo, float hi) { unsigned r; asm volatile("v_cvt_pk_bf16_f32 %0, %1, %2" : "=v"(r) : "v"(lo), "v"(hi)); return r; }
typedef float f32x2 __attribute__((ext_vector_type(2)));
typedef int i32x4v __attribute__((ext_vector_type(4)));
typedef int i32x8v __attribute__((ext_vector_type(8)));
__device__ __forceinline__ i32x8v cat8(bf16x8 lo, bf16x8 hi) { const i32x4v a = __builtin_bit_cast(i32x4v, lo), b = __builtin_bit_cast(i32x4v, hi); return __builtin_shufflevector(a, b, 0, 1, 2, 3, 4, 5, 6, 7); }
template <class Epi, class Sched, bool ALIGN_EPI = false, bool SP2 = false, bool FP8 = false>
__device__ __forceinline__ void gemm_phase(PG8_LAS unsigned char* lds, const Gemm g, const Sched& S, const Epi& E) {
    int tid_ = threadIdx.x; asm volatile("" : "+v"(tid_));
    const int tid = tid_, wid = __builtin_amdgcn_readfirstlane(tid >> 6), lane = tid & 63, wr = wid >> 2, wc = wid & 3, fr = lane & 15, fq = lane >> 4;
    const int K = g.K, nt = K / BK, LD = g.ld ? g.ld : g.K;
    unsigned voffA[2], voffB[2];
#pragma unroll
    for (int i = 0; i < 2; ++i) { int R, C; stage_rc(tid * 16 + i * 8192, R, C); const int Rb = Epi::PERM ? ((R & ~31) + perm32(R & 31)) : R;
        voffA[i] = (unsigned)(R * LD + C) * 2u; voffB[i] = (unsigned)(Rb * LD + C) * 2u; }
    const size_t kstep = (size_t)(BK * 2);
    const size_t hstep = (size_t)HALF * LD * 2;
    const size_t tstep = 2 * hstep;
    const unsigned ldsw = (unsigned)wid * 1024u;
    const int aoff = lds_byte(wr * 64 + fr, fq * 8), boff = lds_byte(wc * 32 + fr, fq * 8);
    const int aoff8 = lds_byte(wr * 64 + fr, (fq >> 1) * 32 + (fq & 1) * 16), boff8 = lds_byte(wc * 32 + fr, (fq >> 1) * 32 + (fq & 1) * 16);
#define PG8_SA(b, h) (((b) * 2 + (h)) * HTB)
#define PG8_SB(b, h) ((4 + (b) * 2 + (h)) * HTB)
#define PG8_STAGE(bufoff, gbase, voff) do { _Pragma("unroll") for (int _i = 0; _i < 2; ++_i) \
        __builtin_amdgcn_global_load_lds((const unsigned*)((const char*)(gbase) + (voff)[_i]), (PG8_LAS unsigned*)(lds + (bufoff) + ldsw + _i * 8192), 16, 0, 0); } while (0)
#define PG8_LDA(dst, b, h) do { if constexpr (FP8) { _Pragma("unroll") for (int m = 0; m < 4; ++m) dst##8[m] = *(const PG8_LAS i32x8v*)(lds + PG8_SA(b, h) + aoff8 + m * 2048); } else { \
        _Pragma("unroll") for (int m = 0; m < 4; ++m) _Pragma("unroll") for (int k = 0; k < 2; ++k) dst[m][k] = *(const PG8_LAS bf16x8*)(lds + PG8_SA(b, h) + aoff + m * 2048 + k * 1024); } } while (0)
#define PG8_LDB(dst, b, h) do { if constexpr (FP8) { _Pragma("unroll") for (int n = 0; n < 2; ++n) dst##8[n] = *(const PG8_LAS i32x8v*)(lds + PG8_SB(b, h) + boff8 + n * 2048); } else { \
        _Pragma("unroll") for (int n = 0; n < 2; ++n) _Pragma("unroll") for (int k = 0; k < 2; ++k) dst[n][k] = *(const PG8_LAS bf16x8*)(lds + PG8_SB(b, h) + boff + n * 2048 + k * 1024); } } while (0)
#define PG8_MMA(ai, bj, AF, BF) do { __builtin_amdgcn_s_setprio(1); if constexpr (FP8) { \
        _Pragma("unroll") for (int m = 0; m < 4; ++m) _Pragma("unroll") for (int n = 0; n < 2; ++n) \
            asm volatile("v_mfma_f32_16x16x128_f8f6f4 %0, %1, %2, %0" : "+v"(acc[ai][bj][m][n]) : "v"(BF##8[n]), "v"(AF##8[m])); \
        } else { _Pragma("unroll") for (int m = 0; m < 4; ++m) _Pragma("unroll") for (int n = 0; n < 2; ++n) _Pragma("unroll") for (int k = 0; k < 2; ++k) \
        acc[ai][bj][m][n] = __builtin_amdgcn_mfma_f32_16x16x32_bf16(BF[n][k], AF[m][k], acc[ai][bj][m][n], 0, 0, 0); } __builtin_amdgcn_s_setprio(0); } while (0)
#define PG8_WAIT_V(n) asm volatile("s_waitcnt vmcnt(" #n ")" ::: "memory")
#define PG8_WAIT_L(n) asm volatile("s_waitcnt lgkmcnt(" #n ")" ::: "memory")
#define PG8_BAR __builtin_amdgcn_s_barrier()
#define PG8_SCHED __builtin_amdgcn_sched_barrier(0)
    Unit cur, nxt; int ui = 0;
    if (!S.next(0, cur)) return;
    f32x4 acc[2][2][4][2];
#pragma unroll
    for (int a = 0; a < 2; ++a)
#pragma unroll
        for (int b = 0; b < 2; ++b)
#pragma unroll
            for (int m = 0; m < 4; ++m)
#pragma unroll
                for (int n = 0; n < 2; ++n) acc[a][b][m][n] = (f32x4){0.f, 0.f, 0.f, 0.f};
    bf16x8 At[4][2], B0[2][2], B1[2][2]; i32x8v At8[4], B08[2], B18[2];
    const char* cA = (const char*)g.A + (size_t)cur.pm * tstep + cur.ko; const char* cB = (const char*)g.Bt + (size_t)cur.pn * tstep + cur.ko;
    S.a_ready(cur);
    if constexpr (SP2) {
        PG8_STAGE(PG8_SB(0, 0), cB, voffB); PG8_STAGE(PG8_SB(0, 1), cB + hstep, voffB); PG8_STAGE(PG8_SA(0, 0), cA, voffA); PG8_STAGE(PG8_SA(0, 1), cA + hstep, voffA);
        if (wr == 1) PG8_BAR;
        PG8_WAIT_V(2); PG8_BAR;
        PG8_STAGE(PG8_SB(1, 0), cB + kstep, voffB); PG8_STAGE(PG8_SA(1, 0), cA + kstep, voffA); PG8_STAGE(PG8_SB(1, 1), cB + hstep + kstep, voffB);
        PG8_WAIT_V(6); PG8_BAR;
    } else {
        PG8_STAGE(PG8_SB(0, 0), cB, voffB); PG8_STAGE(PG8_SA(0, 0), cA, voffA); PG8_STAGE(PG8_SB(0, 1), cB + hstep, voffB); PG8_STAGE(PG8_SA(0, 1), cA + hstep, voffA);
        if (wr == 1) PG8_BAR;
        PG8_WAIT_V(4); PG8_BAR;
        PG8_STAGE(PG8_SB(1, 0), cB + kstep, voffB); PG8_STAGE(PG8_SA(1, 0), cA + kstep, voffA); PG8_STAGE(PG8_SB(1, 1), cB + hstep + kstep, voffB);
        PG8_WAIT_V(6); PG8_BAR;
    }
    for (;;) {
        const bool has_next = S.next(ui + 1, nxt);
        const char* nA = has_next ? (const char*)g.A + (size_t)nxt.pm * tstep + nxt.ko : cA; const char* nB = has_next ? (const char*)g.Bt + (size_t)nxt.pn * tstep + nxt.ko : cB;
        for (int t = 0; t < nt; t += 2) {
            const bool last = (t == nt - 2);
            const char* a1 = cA + (size_t)(t + 1) * kstep;
            const char* a2 = last ? nA : cA + (size_t)(t + 2) * kstep; const char* b2 = last ? nB : cB + (size_t)(t + 2) * kstep;
            const char* a3 = a2 + kstep; const char* b3 = b2 + kstep;
            if (last && has_next) S.a_ready(nxt);
            if constexpr (SP2) {
            PG8_LDB(B0, 0, 0); PG8_LDB(B1, 0, 1); PG8_SCHED; PG8_LDA(At, 0, 0); PG8_STAGE(PG8_SA(1, 1), a1 + hstep, voffA);
            PG8_WAIT_V(8); PG8_WAIT_L(0); PG8_BAR; PG8_MMA(0, 0, At, B0); PG8_MMA(0, 1, At, B1); PG8_BAR; PG8_SCHED;
            PG8_LDA(At, 0, 1); PG8_STAGE(PG8_SB(0, 0), b2, voffB); PG8_STAGE(PG8_SB(0, 1), b2 + hstep, voffB); PG8_STAGE(PG8_SA(0, 0), a2, voffA);
            PG8_WAIT_V(8); PG8_WAIT_L(0); PG8_BAR; PG8_MMA(1, 0, At, B0); PG8_MMA(1, 1, At, B1); PG8_BAR; PG8_SCHED;
            PG8_LDB(B0, 1, 0); PG8_LDB(B1, 1, 1); PG8_SCHED; PG8_LDA(At, 1, 0); PG8_STAGE(PG8_SA(0, 1), a2 + hstep, voffA);
            PG8_WAIT_V(8); PG8_WAIT_L(0); PG8_BAR; PG8_MMA(0, 0, At, B0); PG8_MMA(0, 1, At, B1); PG8_BAR; PG8_SCHED;
            PG8_LDA(At, 1, 1); PG8_STAGE(PG8_SB(1, 0), b3, voffB); PG8_STAGE(PG8_SB(1, 1), b3 + hstep, voffB); PG8_STAGE(PG8_SA(1, 0), a3, voffA);
            PG8_WAIT_V(8); PG8_WAIT_L(0); PG8_BAR; PG8_MMA(1, 0, At, B0); PG8_MMA(1, 1, At, B1); PG8_BAR; PG8_SCHED;
            } else {
            PG8_LDB(B0, 0, 0); PG8_SCHED; PG8_LDA(At, 0, 0); PG8_STAGE(PG8_SA(1, 1), a1 + hstep, voffA);
            PG8_WAIT_L(8); PG8_BAR; PG8_WAIT_L(0); PG8_MMA(0, 0, At, B0); PG8_BAR; PG8_SCHED;
            PG8_LDB(B1, 0, 1); PG8_STAGE(PG8_SB(0, 0), b2, voffB);
            PG8_BAR; PG8_WAIT_L(0); PG8_MMA(0, 1, At, B1); PG8_BAR;
            PG8_LDA(At, 0, 1); PG8_STAGE(PG8_SA(0, 0), a2, voffA);
            PG8_BAR; PG8_WAIT_L(0); PG8_MMA(1, 0, At, B0); PG8_BAR; PG8_SCHED;
            PG8_STAGE(PG8_SB(0, 1), b2 + hstep, voffB);
            PG8_WAIT_V(6); PG8_BAR; PG8_MMA(1, 1, At, B1); PG8_BAR;
            PG8_LDB(B0, 1, 0); PG8_SCHED; PG8_LDA(At, 1, 0); PG8_STAGE(PG8_SA(0, 1), a2 + hstep, voffA);
            PG8_WAIT_L(8); PG8_BAR; PG8_WAIT_L(0); PG8_MMA(0, 0, At, B0); PG8_BAR; PG8_SCHED;
            PG8_LDB(B1, 1, 1); PG8_STAGE(PG8_SB(1, 0), b3, voffB);
            PG8_BAR; PG8_WAIT_L(0); PG8_MMA(0, 1, At, B1); PG8_BAR;
            PG8_LDA(At, 1, 1); PG8_STAGE(PG8_SA(1, 0), a3, voffA);
            PG8_BAR; PG8_WAIT_L(0); PG8_MMA(1, 0, At, B0); PG8_BAR; PG8_SCHED;
            PG8_STAGE(PG8_SB(1, 1), b3 + hstep, voffB);
            PG8_WAIT_V(6); PG8_BAR; PG8_MMA(1, 1, At, B1); PG8_BAR;
            }
        }
        if constexpr (FP8) asm volatile("s_nop 15\n\ts_nop 15" ::: "memory");
        if constexpr (ALIGN_EPI) { if (wr == 0) PG8_BAR; }
        if constexpr (!Epi::AFTER_DRAIN) { E(acc, cur, wr, wc, fr, fq); S.done(cur); }
        if (!has_next) break;
#pragma unroll
        for (int a = 0; a < 2; ++a)
#pragma unroll
            for (int b = 0; b < 2; ++b)
#pragma unroll
                for (int m = 0; m < 4; ++m)
#pragma unroll
                    for (int n = 0; n < 2; ++n) acc[a][b][m][n] = (f32x4){0.f, 0.f, 0.f, 0.f};
        cur = nxt; cA = nA; cB = nB; ++ui;
        if constexpr (ALIGN_EPI) { if (wr == 1) PG8_BAR; }
    }
    PG8_WAIT_V(0);
    if constexpr (!ALIGN_EPI) { if (wr == 0) PG8_BAR; }
    PG8_BAR;
    if constexpr (Epi::AFTER_DRAIN) { E.fused(acc, cur, wr, wc, fr, fq, lds, wid, lane); S.done(cur); }
#undef PG8_SA
#undef PG8_SB
#undef PG8_STAGE
#undef PG8_LDA
#undef PG8_LDB
#undef PG8_MMA
#undef PG8_WAIT_V
#undef PG8_WAIT_L
#undef PG8_BAR
#undef PG8_SCHED
}
}
namespace pg8 {
typedef unsigned u32x2 __attribute__((ext_vector_type(2)));
__device__ __forceinline__ float fast_sigmoid(float v) { return __builtin_amdgcn_rcpf(1.0f + __expf(-v)); }
__device__ __forceinline__ unsigned cvt4_fp8(float a, float b, float c, float d) {
    a = __builtin_amdgcn_fmed3f(a, -448.f, 448.f); b = __builtin_amdgcn_fmed3f(b, -448.f, 448.f); c = __builtin_amdgcn_fmed3f(c, -448.f, 448.f); d = __builtin_amdgcn_fmed3f(d, -448.f, 448.f);
    int r = __builtin_amdgcn_cvt_pk_fp8_f32(a, b, 0, false); r = __builtin_amdgcn_cvt_pk_fp8_f32(c, d, r, true); return (unsigned)r; }

template <int MODE, int NCT, bool OUT8 = false> struct EpiGated {
    static constexpr bool PERM = true, AFTER_DRAIN = false;
    bf16_t* O; int ldc; const float* bias; int goff; float sin, sout;
    __device__ __forceinline__ void operator()(const f32x4 (&acc)[2][2][4][2], const Unit& u, int wr, int wc, int fr, int fq) const {
        const int ct = NCT ? (u.pn % (NCT ? NCT : 1)) : u.pn;
        const int row0 = u.pm * BM + wr * 64 + fr, col0 = ct * HALF + wc * 32 + 8 * fq;
        f32x4 ba[2], bg[2];
#pragma unroll
        for (int n = 0; n < 2; ++n) { ba[n] = MODE == 0 ? *(const f32x4*)(bias + col0 + 4 * n) : (f32x4){0.f, 0.f, 0.f, 0.f}; bg[n] = MODE == 0 ? *(const f32x4*)(bias + goff + col0 + 4 * n) : (f32x4){0.f, 0.f, 0.f, 0.f}; }
#pragma unroll
        for (int ai = 0; ai < 2; ++ai)
#pragma unroll
            for (int m = 0; m < 4; ++m) {
                f32x4 o[2];
#pragma unroll
                for (int n = 0; n < 2; ++n) { const f32x4 a = acc[ai][0][m][n] * sin + ba[n], g = acc[ai][1][m][n] * sin + bg[n];
#pragma unroll
                    for (int e = 0; e < 4; ++e) o[n][e] = MODE == 0 ? a[e] * fast_sigmoid(g[e]) : a[e] * fast_sigmoid(a[e]) * g[e]; }
                if constexpr (OUT8) { u32x2 w; w.x = cvt4_fp8(o[0][0] * sout, o[0][1] * sout, o[0][2] * sout, o[0][3] * sout); w.y = cvt4_fp8(o[1][0] * sout, o[1][1] * sout, o[1][2] * sout, o[1][3] * sout);
                    *(u32x2*)((unsigned char*)O + (size_t)(row0 + ai * HALF + m * 16) * ldc + col0) = w; }
                else { bf16_t* rowp = O + (size_t)(row0 + ai * HALF + m * 16) * ldc + col0;
                    u32x4 w; w.x = cvt_pk_bf16(o[0][0], o[0][1]); w.y = cvt_pk_bf16(o[0][2], o[0][3]); w.z = cvt_pk_bf16(o[1][0], o[1][1]); w.w = cvt_pk_bf16(o[1][2], o[1][3]);
                    *(u32x4*)rowp = w; }
            }
    }
};

struct EpiBf16S {
    static constexpr bool PERM = true, AFTER_DRAIN = false;
    bf16_t* O; int ldc; float scale;
    __device__ __forceinline__ void operator()(const f32x4 (&acc)[2][2][4][2], const Unit& u, int wr, int wc, int fr, int fq) const {
        const int row0 = u.pm * BM + wr * 64 + fr, col0 = u.pn * BM + wc * 32 + 8 * fq;
#pragma unroll
        for (int ai = 0; ai < 2; ++ai)
#pragma unroll
            for (int m = 0; m < 4; ++m) { bf16_t* rowp = O + (size_t)(row0 + ai * HALF + m * 16) * ldc + col0;
#pragma unroll
                for (int bj = 0; bj < 2; ++bj) { const f32x4 v0 = acc[ai][bj][m][0] * scale, v1 = acc[ai][bj][m][1] * scale;
                    u32x4 w; w.x = cvt_pk_bf16(v0[0], v0[1]); w.y = cvt_pk_bf16(v0[2], v0[3]); w.z = cvt_pk_bf16(v1[0], v1[1]); w.w = cvt_pk_bf16(v1[2], v1[3]);
                    *(u32x4*)(rowp + bj * HALF) = w; } }
    }
};

struct EpiK {
    static constexpr bool PERM = true, AFTER_DRAIN = false;
    bf16_t* O; int ldc; float* kmean; unsigned* kabs; float sin;
    __device__ __forceinline__ void operator()(const f32x4 (&acc)[2][2][4][2], const Unit& u, int wr, int wc, int fr, int fq) const {
        const int row0 = u.pm * BM + wr * 64 + fr, col0 = u.pn * BM + wc * 32 + 8 * fq;
        f32x4 cs[2][2];
#pragma unroll
        for (int bj = 0; bj < 2; ++bj)
#pragma unroll
            for (int n = 0; n < 2; ++n) cs[bj][n] = (f32x4){0.f, 0.f, 0.f, 0.f};
#pragma unroll
        for (int ai = 0; ai < 2; ++ai)
#pragma unroll
            for (int m = 0; m < 4; ++m) { bf16_t* rowp = O + (size_t)(row0 + ai * HALF + m * 16) * ldc + col0;
#pragma unroll
                for (int bj = 0; bj < 2; ++bj) { const f32x4 v0 = acc[ai][bj][m][0] * sin, v1 = acc[ai][bj][m][1] * sin; cs[bj][0] += v0; cs[bj][1] += v1;
                    u32x4 w; w.x = cvt_pk_bf16(v0[0], v0[1]); w.y = cvt_pk_bf16(v0[2], v0[3]); w.z = cvt_pk_bf16(v1[0], v1[1]); w.w = cvt_pk_bf16(v1[2], v1[3]);
                    *(u32x4*)(rowp + bj * HALF) = w; } }
        const int b = u.pm >> 4, nb = u.pm & 15;
#pragma unroll
        for (int bj = 0; bj < 2; ++bj) {
            float mx = 0.f;
#pragma unroll
            for (int ai = 0; ai < 2; ++ai)
#pragma unroll
                for (int m = 0; m < 4; ++m)
#pragma unroll
                    for (int n = 0; n < 2; ++n)
#pragma unroll
                        for (int e = 0; e < 4; ++e) mx = fmaxf(mx, fabsf(acc[ai][bj][m][n][e]) * sin);
#pragma unroll
            for (int o = 32; o >= 1; o >>= 1) mx = fmaxf(mx, __shfl_xor(mx, o));
            if (fr == 0 && fq == 0) atomicMax(kabs + (b * 16 + ((u.pn * BM + bj * HALF + wc * 32) >> 6)) * 16 + nb, __float_as_uint(mx));
        }
#pragma unroll
        for (int bj = 0; bj < 2; ++bj)
#pragma unroll
            for (int n = 0; n < 2; ++n)
#pragma unroll
                for (int e = 0; e < 4; ++e) { float s = cs[bj][n][e];
                    s += __shfl_xor(s, 1); s += __shfl_xor(s, 2); s += __shfl_xor(s, 4); s += __shfl_xor(s, 8);
                    if (fr == 0) { const int c = col0 + bj * HALF + 4 * n + e, h = c >> 6, d = c & 63;
                        atomicAdd(kmean + ((size_t)((b * 16 + h) * 16 + nb) * 64 + d), s * (1.0f / 256.0f)); } }
    }
};

__device__ __forceinline__ float bf_lo(unsigned w) { return __uint_as_float(w << 16); }
__device__ __forceinline__ float bf_hi(unsigned w) { return __uint_as_float(w & 0xffff0000u); }
template <bool XF32> struct EpiResid {
    static constexpr bool PERM = true, AFTER_DRAIN = false;
    const void* x; bf16_t* y; const float* gate; int gstride; const float* bias; float alpha; float sin;
    __device__ __forceinline__ void operator()(const f32x4 (&acc)[2][2][4][2], const Unit& u, int wr, int wc, int fr, int fq) const {
        const int row0 = u.pm * BM + wr * 64 + fr, col0 = u.pn * BM + wc * 32 + 8 * fq, b = u.pm >> 4;
        f32x4 gv[2][2], bv[2][2];
#pragma unroll
        for (int bj = 0; bj < 2; ++bj)
#pragma unroll
            for (int n = 0; n < 2; ++n) { const int c = col0 + bj * HALF + n * 4; gv[bj][n] = *(const f32x4*)(gate + (size_t)b * gstride + c) + 1.0f;
                bv[bj][n] = bias ? *(const f32x4*)(bias + c) : (f32x4){0.f, 0.f, 0.f, 0.f}; }
#pragma unroll
        for (int ai = 0; ai < 2; ++ai)
#pragma unroll
            for (int m = 0; m < 4; ++m) { const size_t off = (size_t)(row0 + ai * HALF + m * 16) * 1024 + col0;
#pragma unroll
                for (int bj = 0; bj < 2; ++bj) { f32x4 x0, x1;
                    if constexpr (XF32) { x0 = *(const f32x4*)((const float*)x + off + bj * HALF); x1 = *(const f32x4*)((const float*)x + off + bj * HALF + 4); }
                    else { const u32x4 xw = *(const u32x4*)((const bf16_t*)x + off + bj * HALF); x0 = (f32x4){bf_lo(xw.x), bf_hi(xw.x), bf_lo(xw.y), bf_hi(xw.y)}; x1 = (f32x4){bf_lo(xw.z), bf_hi(xw.z), bf_lo(xw.w), bf_hi(xw.w)}; }
                    const f32x4 o0 = x0 * alpha + gv[bj][0] * (acc[ai][bj][m][0] * sin + bv[bj][0]), o1 = x1 * alpha + gv[bj][1] * (acc[ai][bj][m][1] * sin + bv[bj][1]);
                    u32x4 w; w.x = cvt_pk_bf16(o0[0], o0[1]); w.y = cvt_pk_bf16(o0[2], o0[3]); w.z = cvt_pk_bf16(o1[0], o1[1]); w.w = cvt_pk_bf16(o1[2], o1[3]);
                    *(u32x4*)(y + off + bj * HALF) = w; } }
    }
};

struct EpiMoeOut {
    static constexpr bool PERM = true, AFTER_DRAIN = false;
    bf16_t* O; const int* rowinfo; const float* roww; float sin; size_t kplane;
    __device__ __forceinline__ void operator()(const f32x4 (&acc)[2][2][4][2], const Unit& u, int wr, int wc, int fr, int fq) const {
        const int row0 = u.pm * BM + wr * 64 + fr, col0 = (u.pn & 3) * BM + wc * 32 + 8 * fq;
#pragma unroll
        for (int ai = 0; ai < 2; ++ai)
#pragma unroll
            for (int m = 0; m < 4; ++m) { const int r = row0 + ai * HALF + m * 16; const int info = rowinfo[r]; const float w = roww[r] * sin;
                if (info >= 0) { bf16_t* op = O + (u.ko ? kplane : (size_t)0) + (size_t)info * 1024 + col0;
#pragma unroll
                    for (int bj = 0; bj < 2; ++bj) { const f32x4 v0 = acc[ai][bj][m][0] * w, v1 = acc[ai][bj][m][1] * w;
                        u32x4 o; o.x = cvt_pk_bf16(v0[0], v0[1]); o.y = cvt_pk_bf16(v0[2], v0[3]); o.z = cvt_pk_bf16(v1[0], v1[1]); o.w = cvt_pk_bf16(v1[2], v1[3]);
                        *(u32x4*)(op + bj * HALF) = o; } } }
    }
};

struct MoeOrder {
    StaticOrder so; const int* tile_e; int nct, kbytes;
    __device__ void init(int NT, int nct_, int G, int c, const int* te, int kbytes_ = 0) { so.init(NT * BM, nct_ * (kbytes_ ? 2 : 1) * BM, G, c); tile_e = te; nct = nct_; kbytes = kbytes_; }
    __device__ bool next(int i, Unit& u) const { if (!so.next(i, u)) return false; const int kh = u.pn / nct; u.pn = u.pn % nct + __builtin_amdgcn_readfirstlane(tile_e[u.pm]) * nct; u.ko = kh * kbytes; return true; }
    __device__ __forceinline__ void a_ready(const Unit&) const {}
    __device__ __forceinline__ void done(const Unit&) const {}
};
}
#define GAS __attribute__((address_space(1)))
#define LAS __attribute__((address_space(3)))
#define XB_TMO      128
#define XB_XCNT(j)  (256  + 64 * (j))
#define XB_XSUB(j)  (1280 + 64 * (j))
#define XB_XGEN(j)  (2304 + 64 * (j))
#define XB_TOP      3328
#define XB_TOPGEN   3392
#define XCD_BAR_WORDS 3456
#define XB_SPIN_CAP (1u << 18)

__device__ __forceinline__ unsigned xb_ld(unsigned* p)              { return __hip_atomic_load(p, __ATOMIC_RELAXED, __HIP_MEMORY_SCOPE_AGENT); }
__device__ __forceinline__ unsigned xb_add(unsigned* p, unsigned v) { return __hip_atomic_fetch_add(p, v, __ATOMIC_RELAXED, __HIP_MEMORY_SCOPE_AGENT); }
__device__ __forceinline__ unsigned xb_xcc_id() { return (unsigned)__builtin_amdgcn_s_getreg((3 << 11) | 20) & 0xFu; }
#define XB_SPIN(cond, bar) do { unsigned _sp = 0; while (cond) { __builtin_amdgcn_s_sleep(1); \
    if ((++_sp & 255u) == 0u) { if (xb_ld(&(bar)[XB_TMO])) break; if (_sp > XB_SPIN_CAP) { atomicAdd(&(bar)[XB_TMO], 1u); break; } } } } while (0)

struct XcdBarrier {
    unsigned* bar; unsigned x;
    volatile LAS unsigned* st;
};

__device__ __forceinline__ XcdBarrier xcd_barrier_post(unsigned* bar, volatile LAS unsigned* st) {
    XcdBarrier b; b.bar = bar; b.x = xb_xcc_id(); b.st = st;
    if (threadIdx.x == 0) (void)xb_add(&bar[XB_XCNT(b.x)], 1u);
    return b;
}
__device__ __forceinline__ void xcd_barrier_complete(unsigned* bar, unsigned x, unsigned& nloc, unsigned& nx) {
    const unsigned G = gridDim.x * gridDim.y * gridDim.z;
    unsigned sum, cnt, mine, sp = 0u;
    for (;;) {
        sum = 0u; cnt = 0u; mine = 0u;
#pragma unroll
        for (unsigned j = 0; j < 16; ++j) { const unsigned c = xb_ld(&bar[XB_XCNT(j)]); sum += c; cnt += (c > 0u) ? 1u : 0u; mine = (j == x) ? c : mine; }
        if (sum == G) break;
        __builtin_amdgcn_s_sleep(1);
        if ((++sp & 255u) == 0u) { if (xb_ld(&bar[XB_TMO])) break; if (sp > XB_SPIN_CAP) { atomicAdd(&bar[XB_TMO], 1u); break; } }
    }
    nloc = mine > 0u ? mine : 1u; nx = cnt > 0u ? cnt : 1u;
}

__device__ __forceinline__ void xcd_barrier(const XcdBarrier& b) {
    asm volatile("s_waitcnt vmcnt(0)" ::: "memory");
    __syncthreads();
    if (threadIdx.x == 0) {
        unsigned* bar = b.bar;
        __builtin_amdgcn_s_waitcnt(0);
        unsigned nloc = b.st[0], nx = b.st[1];
        if (nloc == 0u) { xcd_barrier_complete(bar, b.x, nloc, nx); b.st[0] = nloc; b.st[1] = nx; }
        const unsigned old = xb_add(&bar[XB_XSUB(b.x)], 1u);
        const unsigned gen = old / nloc;
        if (old + 1u == (gen + 1u) * nloc) {
            __builtin_amdgcn_fence(__ATOMIC_RELEASE, "agent");
            asm volatile("s_waitcnt vmcnt(0)" ::: "memory");
            const unsigned og = xb_add(&bar[XB_TOP], 1u);
            const unsigned tg = og / nx;
            if (og + 1u == (tg + 1u) * nx) xb_add(&bar[XB_TOPGEN], 1u);
            else XB_SPIN(xb_ld(&bar[XB_TOPGEN]) == tg, bar);
            __builtin_amdgcn_fence(__ATOMIC_ACQUIRE, "agent");
            xb_add(&bar[XB_XGEN(b.x)], 1u);
            asm volatile("s_waitcnt vmcnt(0)" ::: "memory");
        } else {
            XB_SPIN(xb_ld(&bar[XB_XGEN(b.x)]) == gen, bar);
            __builtin_amdgcn_fence(__ATOMIC_ACQUIRE, "agent");
            asm volatile("s_waitcnt vmcnt(0)" ::: "memory");
        }
    }
    __syncthreads();
}

namespace mk {
using pg8::bf16_t;
typedef unsigned v4u __attribute__((ext_vector_type(4)));
typedef unsigned v2u __attribute__((ext_vector_type(2)));
typedef float f32x4 __attribute__((ext_vector_type(4)));
typedef short bf16x8 __attribute__((ext_vector_type(8)));
typedef short s16x4 __attribute__((ext_vector_type(4)));
typedef float f32x16 __attribute__((ext_vector_type(16)));

constexpr int D = 1024, NB = 4, S = 4096, T = NB * S, DEPTH = 4, NA = 2, CONVK = 31, NH = 16, HD = 64, NBLK = 16, DFF = 2816, NE = 8, DFE = 3584;
constexpr int NWAVES = 8, NTHR = NWAVES * 64, GRID = 256;
constexpr float ALPHA = 1.681792830507429f, LN_EPS = 1e-5f;
constexpr float QSCALE = 0.125f * 1.4426950408889634f, LOG2E = 1.4426950408889634f;
#ifndef FP8_MOE
#define FP8_MOE 1
#endif
#ifndef FP8_CONV
#define FP8_CONV 0
#endif
#ifndef FP8_ATTN
#define FP8_ATTN 0
#endif
#ifndef FP8_FFN
#define FP8_FFN 0
#endif
constexpr float S8_H = 16.f, S8_W13 = 256.f, S8_HM = 8.f, S8_W2 = 1024.f, S8_WP = 256.f, S8_WO = 512.f, S8_U = 16.f;
static_assert(FP8_CONV == 0 && FP8_ATTN == 0, "the e4m3 paths of the conv / attention projections were removed");
constexpr int MAXROWS = 2 * T + NE * 256;

constexpr size_t MiB = 1u << 20;
constexpr size_t WS_CTL = 0, CTL_ZERO_BYTES = 2 * MiB;
constexpr int CW_BAR = 4096;
constexpr int CW_VWG = 1024;
#ifndef VWG_MODE
#define VWG_MODE 1
#endif
constexpr size_t WS_KMEAN = 1 * MiB;
constexpr size_t WS_KABS = WS_KMEAN + 512 * 1024;
constexpr size_t WS_MOD = 2 * MiB;
constexpr size_t WS_ROUTE = 3 * MiB;
constexpr size_t RT_TOKE = 0, RT_TOKW = 128 * 1024, RT_RINFO = 256 * 1024, RT_RW = 512 * 1024, RT_CNTWG = 768 * 1024, RT_META = 800 * 1024;
constexpr size_t WS_X0 = 4 * MiB;
constexpr size_t WS_W = 516 * MiB;
constexpr size_t W_CI = WS_W, W_CO = W_CI + 8 * MiB, W_KV = W_CO + 4 * MiB, W_Q = W_KV + 4 * MiB, W_O = W_Q + 4 * MiB, W_F13 = W_O + 4 * MiB, W_F2 = W_F13 + 22 * MiB,
                 W_M13 = W_F2 + 11 * MiB, W_M2 = W_M13 + 224 * MiB, W_END = W_M2 + 112 * MiB;
constexpr size_t WS_Y = W_END, WS_HBF = WS_Y + 64 * MiB, WS_HKV = WS_HBF + 32 * MiB, WS_U = WS_HKV + 32 * MiB, WS_U2 = WS_U + 32 * MiB, WS_K = WS_U2 + 32 * MiB, WS_VT = WS_K + 32 * MiB,
                 WS_HM = WS_VT + 32 * MiB, WS_HPERM = WS_HM + 240 * MiB, WS_MOEO = WS_HPERM + 68 * MiB, WS_END = WS_MOEO + 128 * MiB;
static_assert(W_END == 909 * MiB && WS_END == 1601 * MiB, "d_ws map");
constexpr size_t WS_ALIST = WS_END, WS_APO = WS_ALIST + 16 * MiB, WS_APML = WS_APO + 96 * MiB, WS_ASEL = WS_APML + 6 * MiB, WS_END2 = WS_ASEL + 1 * MiB;
constexpr size_t WS_ACNT = WS_KMEAN + 768 * 1024;
constexpr size_t WS_ATAKE = WS_END2, WS_AGCNT = WS_ATAKE + 1 * MiB, WS_END3 = WS_AGCNT + 1 * MiB;
#ifndef DIAG_SORT_LISTS
#define DIAG_SORT_LISTS 0
#endif
#ifndef DIAG_CHECK_LISTS
#define DIAG_CHECK_LISTS 0
#endif
#ifndef DIAG_FIXED_LISTS
#define DIAG_FIXED_LISTS 0
#endif
#ifndef SPARSE_ATTN
#define SPARSE_ATTN 0
#endif
static_assert((size_t)MAXROWS * DFE * 2 <= 240 * MiB && (size_t)MAXROWS * D * 2 <= 68 * MiB, "MoE buffers");
constexpr size_t NAIVE_BASE = 516 * MiB;

constexpr int RING_BYTES = 131072, LDSCTL_OFF = RING_BYTES, LDS_BYTES = 147456;

#define RLX_AGENT __ATOMIC_RELAXED, __HIP_MEMORY_SCOPE_AGENT
#define ST_WT(p, v) __hip_atomic_store((p), (v), __ATOMIC_RELAXED, __HIP_MEMORY_SCOPE_AGENT)
__device__ __forceinline__ float bf2f(unsigned short h) { return __uint_as_float((unsigned)h << 16); }
__device__ __forceinline__ float bflo(unsigned w) { return __uint_as_float(w << 16); }
__device__ __forceinline__ float bfhi(unsigned w) { return __uint_as_float(w & 0xffff0000u); }
__device__ __forceinline__ unsigned pk2(float lo, float hi) { return pg8::cvt_pk_bf16(lo, hi); }
__device__ __forceinline__ float wave_sum(float v) {
#pragma unroll
    for (int o = 1; o < 64; o <<= 1) v += __shfl_xor(v, o);
    return v;
}
__device__ __forceinline__ float silu_f(float v) { return v * __builtin_amdgcn_rcpf(1.0f + __expf(-v)); }

struct Args { const float* in[25]; float* out; unsigned char* ws; int ph_lo, ph_hi; };

__device__ __forceinline__ void mod_unit(int unit, const float* ada_w, const float* ada_b, const float* kv_ada_w, const float* kv_ada_b, float* mod, LAS float* ca, LAS float* red, int wave, int lane) {
    const int col = unit * 64 + lane, NMAIN = DEPTH * 6 * D;
    const float* w; int ldw; float bias; float* outp; int ostride;
    if (col < NMAIN) { const int l = col / (6 * D), j = col % (6 * D); w = ada_w + (size_t)l * D * 6 * D + j; ldw = 6 * D; bias = ada_b[l * 6 * D + j]; outp = mod + (size_t)l * NB * 6 * D + j; ostride = 6 * D; }
    else { const int j = col - NMAIN; w = kv_ada_w + j; ldw = 2 * D; bias = kv_ada_b[j]; outp = mod + (size_t)DEPTH * NB * 6 * D + j; ostride = 2 * D; }
    float a0 = 0.f, a1 = 0.f, a2 = 0.f, a3 = 0.f;
    const int k0 = wave * 128;
#pragma unroll 8
    for (int k = k0; k < k0 + 128; ++k) { const float wv = w[(size_t)k * ldw]; a0 += ca[k] * wv; a1 += ca[D + k] * wv; a2 += ca[2 * D + k] * wv; a3 += ca[3 * D + k] * wv; }
    red[(wave * 4 + 0) * 64 + lane] = a0; red[(wave * 4 + 1) * 64 + lane] = a1; red[(wave * 4 + 2) * 64 + lane] = a2; red[(wave * 4 + 3) * 64 + lane] = a3;
    __syncthreads();
    if (wave < 4) { float s = 0.f;
#pragma unroll
        for (int q = 0; q < 8; ++q) s += red[(q * 4 + wave) * 64 + lane];
        outp[(size_t)wave * ostride] = s + bias; }
    __syncthreads();
}

__device__ __forceinline__ void conv_item(const float* W, int K, int N, int gateF, bf16_t* WT, int item, LAS unsigned* scr, int lane) {
    const int nblk = N / 64, kb = item / nblk, nb = item % nblk, k0 = 64 * kb, n0 = 64 * nb;
    const int kr = lane >> 4, nc = (lane & 15) * 4;
#pragma unroll
    for (int p = 0; p < 8; ++p) {
        const int k = 8 * p + 2 * kr;
        const f32x4 v0 = *(const f32x4*)(W + (size_t)(k0 + k) * N + n0 + nc), v1 = *(const f32x4*)(W + (size_t)(k0 + k + 1) * N + n0 + nc);
#pragma unroll
        for (int j = 0; j < 4; ++j) scr[(nc + j) * 33 + 4 * p + kr] = pk2(v0[j], v1[j]);
    }
    asm volatile("s_waitcnt lgkmcnt(0)" ::: "memory");
    int drow0;
    if (gateF) { const int half = n0 / gateF, jj = n0 % gateF; drow0 = (jj / 128) * 256 + half * 128 + (jj % 128); } else drow0 = n0;
    const int c = lane & 7;
#pragma unroll
    for (int jj = 0; jj < 8; ++jj) { const int n = (lane >> 3) + 8 * jj; const LAS unsigned* s = scr + n * 33 + 4 * c;
        v4u o; o.x = s[0]; o.y = s[1]; o.z = s[2]; o.w = s[3];
        *(v4u*)(WT + (size_t)(drow0 + n) * K + k0 + 8 * c) = o; }
    asm volatile("s_waitcnt lgkmcnt(0)" ::: "memory");
}
__device__ __forceinline__ void conv_item8(const float* W, int K, int N, int gateF, unsigned char* WT, int item, float scale, LAS unsigned* scr, int lane) {
    const int nblk = N / 64, kb = item / nblk, nb = item % nblk, k0 = 64 * kb, n0 = 64 * nb;
    const int kr = lane >> 4, nc = (lane & 15) * 4;
#pragma unroll
    for (int p = 0; p < 4; ++p) {
        const int k = 16 * p + 4 * kr;
        const float* wp = W + (size_t)(k0 + k) * N + n0 + nc;
        const f32x4 v0 = *(const f32x4*)wp * scale, v1 = *(const f32x4*)(wp + N) * scale, v2 = *(const f32x4*)(wp + 2 * (size_t)N) * scale, v3 = *(const f32x4*)(wp + 3 * (size_t)N) * scale;
#pragma unroll
        for (int j = 0; j < 4; ++j) scr[(nc + j) * 17 + 4 * p + kr] = pg8::cvt4_fp8(v0[j], v1[j], v2[j], v3[j]);
    }
    asm volatile("s_waitcnt lgkmcnt(0)" ::: "memory");
    int drow0;
    if (gateF) { const int half = n0 / gateF, jj = n0 % gateF; drow0 = (jj / 128) * 256 + half * 128 + (jj % 128); } else drow0 = n0;
    const int c = lane & 3;
#pragma unroll
    for (int jj = 0; jj < 4; ++jj) { const int n = (lane >> 2) + 16 * jj; const LAS unsigned* sp = scr + n * 17 + 4 * c;
        v4u o; o.x = sp[0]; o.y = sp[1]; o.z = sp[2]; o.w = sp[3];
        *(v4u*)(WT + (size_t)(drow0 + n) * K + k0 + 16 * c) = o; }
    asm volatile("s_waitcnt lgkmcnt(0)" ::: "memory");
}
struct ConvGroup { int src; int count, K, N, gateF; size_t dst; float s8; };
__device__ __forceinline__ ConvGroup conv_group(int g) {
    switch (g) {
        case 0: return {6, 2, D, 2 * D, D, W_CI, FP8_CONV ? S8_WP : 0.f};      case 1: return {12, 2, D, D, 0, W_CO, FP8_CONV ? S8_WO : 0.f};   case 2: return {16, 1, D, 2 * D, 0, W_KV, FP8_ATTN ? S8_WP : 0.f};
        case 3: return {17, 2, D, D, 0, W_Q, FP8_ATTN ? S8_WP : 0.f};          case 4: return {18, 2, D, D, 0, W_O, FP8_ATTN ? S8_WO : 0.f};
        case 5: return {19, 2, D, 2 * DFF, DFF, W_F13, FP8_FFN ? S8_W13 : 0.f};   case 6: return {20, 2, DFF, D, 0, W_F2, FP8_FFN ? S8_W2 : 0.f};
        case 7: return {23, 16, D, 2 * DFE, DFE, W_M13, FP8_MOE ? S8_W13 : 0.f};  default: return {24, 16, DFE, D, 0, W_M2, FP8_MOE ? S8_W2 : 0.f};
    }
}
constexpr int CG7_PER = (D / 64) * (2 * DFE / 64), CG8_PER = (DFE / 64) * (D / 64);
__device__ __forceinline__ void conv_range(const Args& a, unsigned char* ws, int g, int i0, int i1, LAS unsigned* scr, int gw, int ngw, int lane) {
    const ConvGroup G = conv_group(g);
    const int per = (G.K / 64) * (G.N / 64), eb = G.s8 > 0.f ? 1 : 2;
    for (int i = i0 + gw; i < i1; i += ngw) { const int m = i / per, it = i % per;
        const float* W = a.in[G.src] + (size_t)m * G.K * G.N; unsigned char* WT = ws + G.dst + (size_t)m * G.K * G.N * eb;
        if (G.s8 > 0.f) conv_item8(W, G.K, G.N, G.gateF, WT, it, G.s8, scr, lane); else conv_item(W, G.K, G.N, G.gateF, (bf16_t*)WT, it, scr, lane); }
}
#ifndef MOE1_IN_P0_PCT
#define MOE1_IN_P0_PCT 100
#endif
#ifndef MOE3_IN_E2_PCT
#define MOE3_IN_E2_PCT 100
#endif
constexpr int M1A7 = (8 * CG7_PER * MOE1_IN_P0_PCT / 100) & ~63, M1A8 = (8 * CG8_PER * MOE1_IN_P0_PCT / 100) & ~63;
constexpr int M3A7 = 8 * CG7_PER + ((8 * CG7_PER * MOE3_IN_E2_PCT / 100) & ~63), M3A8 = 8 * CG8_PER + ((8 * CG8_PER * MOE3_IN_E2_PCT / 100) & ~63);
__device__ __forceinline__ void tail_convert(const Args& a, unsigned char* ws, int g7lo, int g7hi, int g8lo, int g8hi, int rem, LAS unsigned char* lds, int wg, int G, int wave, int lane) {
    const int first = (rem > 0 && rem < G) ? rem : 0;
    if (wg < first) return;
    LAS unsigned* scr = (LAS unsigned*)(lds + 32768 + wave * 8448);
    const int gw = (wg - first) * NWAVES + wave, ngw = (G - first) * NWAVES;
    conv_range(a, ws, 7, g7lo, g7hi, scr, gw, ngw, lane);
    conv_range(a, ws, 8, g8lo, g8hi, scr, gw, ngw, lane);
}

struct RowArgs {
    int mode;
    const void* x_in; const bf16_t* y; const bf16_t* moeo; const float* gate; int gstride;
    float oscale;
    const float* lng; const float* lnb; bf16_t* x_out; float* x_out32;
    const float* sh; const float* sc; int mstride; bf16_t* h_out;
    unsigned char* h8_out;
    const float* kvsh; const float* kvsc; bf16_t* hkv_out; unsigned char* hkv8_out;
    const float* rw; const float* rb; int* tok_e; float* tok_w; int* cntwg;
};
__device__ __forceinline__ void unpack8(const v4u w, f32x4& lo, f32x4& hi) { lo = (f32x4){bflo(w.x), bfhi(w.x), bflo(w.y), bfhi(w.y)}; hi = (f32x4){bflo(w.z), bfhi(w.z), bflo(w.w), bfhi(w.w)}; }
__device__ __forceinline__ v4u pack8(const f32x4 lo, const f32x4 hi) { v4u w; w.x = pk2(lo[0], lo[1]); w.y = pk2(lo[2], lo[3]); w.z = pk2(hi[0], hi[1]); w.w = pk2(hi[2], hi[3]); return w; }
template <int RB  >
__device__ __forceinline__ void row_phase(const RowArgs& A, LAS unsigned char* lds, int wg, int tid, int wave, int lane) {
    LAS float* rwT = (LAS float*)lds;
    LAS int* lcnt = (LAS int*)(lds + 32768);
    const bool route = A.rw != nullptr;
    if (route) {
        for (int i = tid; i < D * NE; i += NTHR) { const int d = i >> 3, e = i & 7; rwT[e * D + d] = A.rw[i]; }
        if (tid < NE) lcnt[tid] = 0;
        __syncthreads();
    }
    for (int ib = 0; ib < 8 / RB; ++ib) {
      v4u ry[RB][2], rm0[RB][2], rm1[RB][2]; f32x4 rx[RB][2][2];
#pragma unroll
      for (int ii = 0; ii < RB; ++ii) { const int t = wg * 64 + (ib * RB + ii) * 8 + wave;
#pragma unroll
          for (int j = 0; j < 2; ++j) { const int c = 8 * lane + 512 * j;
              if (A.mode == 0) { const f32x4* xp = (const f32x4*)((const float*)A.x_in + (size_t)t * D + c); rx[ii][j][0] = xp[0]; rx[ii][j][1] = xp[1]; }
              else if (A.mode == 1) ry[ii][j] = *(const v4u*)(A.y + (size_t)t * D + c);
              else { ry[ii][j] = *(const v4u*)((const bf16_t*)A.x_in + (size_t)t * D + c); rm0[ii][j] = *(const v4u*)(A.moeo + (size_t)(2 * t) * D + c); rm1[ii][j] = *(const v4u*)(A.moeo + (size_t)(2 * t + 1) * D + c); } } }
#pragma unroll
      for (int ii = 0; ii < RB; ++ii) {
        const int t = wg * 64 + (ib * RB + ii) * 8 + wave, b = t >> 12;
        f32x4 v[2][2];
        if (A.mode == 0) {
#pragma unroll
            for (int j = 0; j < 2; ++j) { v[j][0] = rx[ii][j][0]; v[j][1] = rx[ii][j][1]; }
        } else {
            if (A.mode == 1) {
#pragma unroll
                for (int j = 0; j < 2; ++j) unpack8(ry[ii][j], v[j][0], v[j][1]);
            } else {
#pragma unroll
                for (int j = 0; j < 2; ++j) { const int c = 8 * lane + 512 * j; f32x4 x0, x1, a0, a1, b0, b1;
                    unpack8(ry[ii][j], x0, x1); unpack8(rm0[ii][j], a0, a1); unpack8(rm1[ii][j], b0, b1);
                    const f32x4 g0 = *(const f32x4*)(A.gate + (size_t)b * A.gstride + c), g1 = *(const f32x4*)(A.gate + (size_t)b * A.gstride + c + 4);
                    v[j][0] = x0 * ALPHA + (g0 + 1.0f) * (a0 + b0); v[j][1] = x1 * ALPHA + (g1 + 1.0f) * (a1 + b1); }
            }
            float s = 0.f;
#pragma unroll
            for (int j = 0; j < 2; ++j)
#pragma unroll
                for (int q = 0; q < 2; ++q) s += (v[j][q][0] + v[j][q][1]) + (v[j][q][2] + v[j][q][3]);
            const float mean = wave_sum(s) * (1.0f / D); float qq = 0.f;
#pragma unroll
            for (int j = 0; j < 2; ++j)
#pragma unroll
                for (int q = 0; q < 2; ++q) { v[j][q] = v[j][q] - mean; qq += (v[j][q][0] * v[j][q][0] + v[j][q][1] * v[j][q][1]) + (v[j][q][2] * v[j][q][2] + v[j][q][3] * v[j][q][3]); }
            const float rstd = rsqrtf(wave_sum(qq) * (1.0f / D) + LN_EPS);
#pragma unroll
            for (int j = 0; j < 2; ++j) { const int c = 8 * lane + 512 * j;
#pragma unroll
                for (int q = 0; q < 2; ++q) { const f32x4 g = *(const f32x4*)(A.lng + c + 4 * q), bb = *(const f32x4*)(A.lnb + c + 4 * q); v[j][q] = v[j][q] * rstd * g + bb; }
                if (A.x_out) *(v4u*)(A.x_out + (size_t)t * D + c) = pack8(v[j][0], v[j][1]);
                if (A.x_out32) { f32x4* op = (f32x4*)(A.x_out32 + (size_t)t * D + c); op[0] = v[j][0] * A.oscale; op[1] = v[j][1] * A.oscale; } }
        }
        if (A.hkv_out || A.hkv8_out) {
#pragma unroll
            for (int j = 0; j < 2; ++j) { const int c = 8 * lane + 512 * j; f32x4 h[2];
#pragma unroll
                for (int q = 0; q < 2; ++q) { const f32x4 sc = *(const f32x4*)(A.kvsc + (size_t)b * 2 * D + c + 4 * q), sh = *(const f32x4*)(A.kvsh + (size_t)b * 2 * D + c + 4 * q); h[q] = v[j][q] * (sc + 1.0f) + sh; }
                if (A.hkv_out) *(v4u*)(A.hkv_out + (size_t)t * D + c) = pack8(h[0], h[1]);
                if (A.hkv8_out) { v2u w; w.x = pg8::cvt4_fp8(h[0][0] * S8_H, h[0][1] * S8_H, h[0][2] * S8_H, h[0][3] * S8_H); w.y = pg8::cvt4_fp8(h[1][0] * S8_H, h[1][1] * S8_H, h[1][2] * S8_H, h[1][3] * S8_H);
                    *(v2u*)(A.hkv8_out + (size_t)t * D + c) = w; } }
        }
        if (A.h_out || A.h8_out) {
            float lg[NE];
#pragma unroll
            for (int e = 0; e < NE; ++e) lg[e] = 0.f;
#pragma unroll
            for (int j = 0; j < 2; ++j) { const int c = 8 * lane + 512 * j; f32x4 h[2];
#pragma unroll
                for (int q = 0; q < 2; ++q) { const f32x4 sc = *(const f32x4*)(A.sc + (size_t)b * A.mstride + c + 4 * q), sh = *(const f32x4*)(A.sh + (size_t)b * A.mstride + c + 4 * q); h[q] = v[j][q] * (sc + 1.0f) + sh; }
                if (A.h_out) *(v4u*)(A.h_out + (size_t)t * D + c) = pack8(h[0], h[1]);
                if (A.h8_out) { v2u w; w.x = pg8::cvt4_fp8(h[0][0] * S8_H, h[0][1] * S8_H, h[0][2] * S8_H, h[0][3] * S8_H); w.y = pg8::cvt4_fp8(h[1][0] * S8_H, h[1][1] * S8_H, h[1][2] * S8_H, h[1][3] * S8_H);
                    *(v2u*)(A.h8_out + (size_t)t * D + c) = w; }
                if (route) {
#pragma unroll
                    for (int e = 0; e < NE; ++e)
#pragma unroll
                        for (int q = 0; q < 2; ++q) { const f32x4 r = *(const LAS f32x4*)(rwT + e * D + c + 4 * q); lg[e] += (h[q][0] * r[0] + h[q][1] * r[1]) + (h[q][2] * r[2] + h[q][3] * r[3]); }
                } }
            if (route) {
#pragma unroll
                for (int e = 0; e < NE; ++e) lg[e] = wave_sum(lg[e]) + A.rb[e];
                int e0 = 0; float v0 = lg[0];
#pragma unroll
                for (int e = 1; e < NE; ++e) if (lg[e] > v0) { v0 = lg[e]; e0 = e; }
                int e1 = -1; float v1 = 0.f;
#pragma unroll
                for (int e = 0; e < NE; ++e) if (e != e0 && (e1 < 0 || lg[e] > v1)) { v1 = lg[e]; e1 = e; }
                if (lane == 0) { const float p1 = __expf(v1 - v0), w0 = 1.0f / (1.0f + p1);
                    A.tok_e[t * 2] = e0; A.tok_e[t * 2 + 1] = e1; A.tok_w[t * 2] = w0; A.tok_w[t * 2 + 1] = p1 * w0;
                    __hip_atomic_fetch_add(lcnt + e0, 1, __ATOMIC_RELAXED, __HIP_MEMORY_SCOPE_WORKGROUP); __hip_atomic_fetch_add(lcnt + e1, 1, __ATOMIC_RELAXED, __HIP_MEMORY_SCOPE_WORKGROUP); }
            }
        }
      }
    }
    if (route) { __syncthreads(); if (tid < NE) ST_WT(A.cntwg + wg * NE + tid, (int)lcnt[tid]); }
    __syncthreads();
}

__device__ __forceinline__ void moe_assign(const int* cntwg, const int* tok_e, const float* tok_w, int* rowinfo, float* roww, int* meta, const unsigned char* hsrc, unsigned char* hperm, const int rowbytes,
                                           LAS unsigned char* lds, int wg, int tid, int wave, int lane) {
    LAS int* arr = (LAS int*)lds;
    LAS int* tot = (LAS int*)(lds + 8192);
    LAS int* mybase = (LAS int*)(lds + 8192 + 64);
    LAS int* earr = (LAS int*)(lds + 8192 + 128);
    LAS int* posarr = (LAS int*)(lds + 8192 + 128 + 512);
    { const v4u c4 = *((const v4u*)cntwg + tid); *((LAS v4u*)arr + tid) = c4; }
    if (tid < 128) earr[tid] = tok_e[wg * 128 + tid];
    __syncthreads();
    {
        const int e = wave; int s4[4]; int s = 0;
#pragma unroll
        for (int q = 0; q < 4; ++q) { s4[q] = arr[(4 * lane + q) * 8 + e]; s += s4[q]; }
        int inc = s;
#pragma unroll
        for (int o = 1; o < 64; o <<= 1) { const int y = __shfl_up(inc, o); if (lane >= o) inc += y; }
        const int total = __shfl(inc, 63);
        int excl = inc - s;
        const int lc = wg >> 2, qc = wg & 3;
#pragma unroll
        for (int q = 0; q < 4; ++q) if (q < qc) excl += s4[q];
        const int mine = __shfl(excl, lc);
        if (lane == 0) { tot[e] = total; mybase[e] = mine; }
    }
    __syncthreads();
    int off[NE + 1]; { int s = 0;
#pragma unroll
        for (int e = 0; e < NE; ++e) { off[e] = s; s += (tot[e] + 255) & ~255; } off[NE] = s; }
    if (tid < 128) {
        const int e = earr[tid]; int rank = 0;
        for (int j = 0; j < tid; ++j) rank += (earr[j] == e) ? 1 : 0;
        int o = 0;
#pragma unroll
        for (int q = 0; q < NE; ++q) o = (q == e) ? off[q] : o;
        const int pos = o + mybase[e] + rank;
        posarr[tid] = pos; ST_WT(rowinfo + pos, wg * 128 + tid); ST_WT(roww + pos, tok_w[wg * 128 + tid]);
    }
    __syncthreads();
    for (int it = wave; it < 128; it += NWAVES) {
        const int tok = wg * 64 + (it >> 1), pos = posarr[it];
        const v4u* src = (const v4u*)(hsrc + (size_t)tok * rowbytes); v4u* dst = (v4u*)(hperm + (size_t)pos * rowbytes);
        if (rowbytes == 2048) { const v4u a = src[lane], b = src[lane + 64]; dst[lane] = a; dst[lane + 64] = b; } else { dst[lane] = src[lane]; }
    }
    if (wg == 0) {
#pragma unroll
        for (int e = 0; e < NE; ++e) for (int r = off[e] + tot[e] + tid; r < off[e + 1]; r += NTHR) { ST_WT(rowinfo + r, -1); ST_WT(roww + r, 0.f); }
        const int NT = off[NE] >> 8;
        if (tid <= NE) { int o = 0;
#pragma unroll
            for (int q = 0; q <= NE; ++q) o = (q == tid) ? off[q] : o;
            meta[tid] = o; }
        if (tid == 0) meta[9] = NT;
        for (int tI = tid; tI < NT; tI += NTHR) { int e = 0;
#pragma unroll
            for (int q = 1; q < NE; ++q) if (tI * 256 >= off[q]) e = q;
            meta[16 + tI] = e; }
    }
    __syncthreads();
}

__device__ __forceinline__ void conv_phase(const bf16_t* u, const float* wdw, const float* bdw, const float* gn, const float* bn, bf16_t* u2, LAS unsigned char* lds, int wg, int tid, int wave, int lane) {
    LAS f32x4* wl = (LAS f32x4*)lds;
    for (int i = tid; i < CONVK * D / 4; i += NTHR) wl[i] = *((const f32x4*)wdw + i);
    __syncthreads();
    for (int it = 0; it < 2; ++it) {
        const int tb = wg * 64 + it * 32 + wave * 4;
        const int ts0 = (tb & (S - 1)) - (CONVK - 1);
        const bf16_t* ub = u + (ptrdiff_t)(tb - (CONVK - 1)) * D + 8 * lane;
        f32x4 acc[4][4];
#pragma unroll
        for (int o = 0; o < 4; ++o)
#pragma unroll
            for (int q = 0; q < 4; ++q) acc[o][q] = *(const f32x4*)(bdw + 8 * lane + 512 * (q >> 1) + 4 * (q & 1));
        f32x4 wwin[4][4];
#pragma unroll
        for (int r = 0; r < CONVK + 3; ++r) {
            if (r < CONVK) {
#pragma unroll
                for (int q = 0; q < 4; ++q) wwin[r & 3][q] = wl[r * 256 + 2 * lane + 128 * (q >> 1) + (q & 1)];
            }
            if (ts0 + r >= 0) {
                f32x4 uv[4];
#pragma unroll
                for (int j = 0; j < 2; ++j) unpack8(*(const v4u*)(ub + (ptrdiff_t)r * D + 512 * j), uv[2 * j], uv[2 * j + 1]);
#pragma unroll
                for (int o = 0; o < 4; ++o) { const int k = r - o; if (k >= 0 && k < CONVK) {
#pragma unroll
                        for (int q = 0; q < 4; ++q) acc[o][q] += uv[q] * wwin[k & 3][q]; } }
            }
        }
#pragma unroll
        for (int o = 0; o < 4; ++o) {
            float sm = 0.f;
#pragma unroll
            for (int q = 0; q < 4; ++q) sm += (acc[o][q][0] + acc[o][q][1]) + (acc[o][q][2] + acc[o][q][3]);
            const float mean = wave_sum(sm) * (1.0f / D); float qq = 0.f;
#pragma unroll
            for (int q = 0; q < 4; ++q) { acc[o][q] = acc[o][q] - mean; qq += (acc[o][q][0] * acc[o][q][0] + acc[o][q][1] * acc[o][q][1]) + (acc[o][q][2] * acc[o][q][2] + acc[o][q][3] * acc[o][q][3]); }
            const float rstd = rsqrtf(wave_sum(qq) * (1.0f / D) + LN_EPS);
#pragma unroll
            for (int j = 0; j < 2; ++j) { f32x4 y[2];
#pragma unroll
                for (int hh = 0; hh < 2; ++hh) { const int c = 8 * lane + 512 * j + 4 * hh; const f32x4 v = acc[o][2 * j + hh] * rstd * *(const f32x4*)(gn + c) + *(const f32x4*)(bn + c);
                    y[hh] = (f32x4){silu_f(v[0]), silu_f(v[1]), silu_f(v[2]), silu_f(v[3])}; }
                *(v4u*)(u2 + (size_t)(tb + o) * D + 8 * lane + 512 * j) = pack8(y[0], y[1]); }
        }
    }
    __syncthreads();
}

typedef float f32x2 __attribute__((ext_vector_type(2)));
__device__ __forceinline__ float max3f(float a, float b, float c) { float r; asm("v_max3_f32 %0, %1, %2, %3" : "=v"(r) : "v"(a), "v"(b), "v"(c)); return r; }
constexpr int AT_QM = 4096 + 2 * 64 * 144 + 2 * 64 * 136, AT_KM = 0, AT_K = 4096, AT_KPITCH = 144, AT_KBUF = 64 * AT_KPITCH, AT_V = AT_K + 2 * AT_KBUF, AT_VPITCH = 136, AT_VBUF = 64 * AT_VPITCH;
__device__ __forceinline__ void attn_unit(int b, int h, int qi, const bf16_t* Q, const bf16_t* K, const bf16_t* Vt, const float* kmean, const float* kabs, bf16_t* O, LAS unsigned char* lds, int tid, int wave, int lane) {
    const int r32 = lane & 31, hi = lane >> 5;
    const int q0 = qi * 256;
    if (tid < 256) *((LAS f32x4*)(lds + AT_KM) + tid) = *((const f32x4*)(kmean + (size_t)(b * NH + h) * NBLK * HD) + tid);
    const bf16_t* qrow = Q + (size_t)(b * S + q0 + wave * 32 + r32) * D + h * HD;
    bf16x8 qr[4];
#pragma unroll
    for (int d0 = 0; d0 < 4; ++d0) qr[d0] = *(const bf16x8*)(qrow + d0 * 16 + hi * 8);
    const int srow = tid >> 3, sch = tid & 7;
    const bf16_t* kg = K + (size_t)(b * S + srow) * D + h * HD + sch * 8;
    const bf16_t* vg = Vt + (size_t)(h * HD + srow) * T + b * S + sch * 8;
    const int kst = AT_K + srow * AT_KPITCH + sch * 16, vst = AT_V + srow * AT_VPITCH + sch * 16;
    { float l1 = 0.f;
#pragma unroll
      for (int d0 = 0; d0 < 4; ++d0)
#pragma unroll
          for (int e = 0; e < 8; ++e) l1 += fabsf(bf2f((unsigned short)qr[d0][e]));
      l1 += __shfl_xor(l1, 32);
#pragma unroll
      for (int o = 16; o >= 1; o >>= 1) l1 = fmaxf(l1, __shfl_xor(l1, o));
      if (lane == 0) *((LAS float*)(lds + AT_QM) + wave) = l1; }
    __syncthreads();
    const float slope2 = exp2f(-8.0f * (float)(h + 1) / (float)NH) * LOG2E;
    unsigned livemask = 1u << qi;
    { float qmax = 0.f;
#pragma unroll
      for (int w = 0; w < NWAVES; ++w) qmax = fmaxf(qmax, *((const LAS float*)(lds + AT_QM) + w));
      const float* kab = kabs + (b * NH + h) * NBLK; const float kown = kab[qi];
#pragma unroll
      for (int n = 0; n < NBLK; ++n) if (n < qi) { const float bound = qmax * (kab[n] + kown) * 1.02f + 160.0f; if (!(slope2 * (float)(256 * (qi - n) - 255) > bound)) livemask |= 1u << n; }
      livemask = (unsigned)__builtin_amdgcn_readfirstlane((int)livemask); }
    unsigned remn = livemask; int jn = __builtin_ctz(remn), ttn = 0;
    v4u kreg = *(const v4u*)(kg + (size_t)(4 * jn) * 64 * D), vreg = *(const v4u*)(vg + (size_t)(4 * jn) * 64);
    unsigned selmask = 1u << qi;
    {
        float gate[NBLK];
#pragma unroll
        for (int n = 0; n < NBLK; ++n) {
            float s = 0.f;
            if (n < qi) {
#pragma unroll
                for (int d0 = 0; d0 < 4; ++d0) { const LAS f32x4* kmp = (const LAS f32x4*)(lds + AT_KM + (n * HD + d0 * 16 + hi * 8) * 4); const f32x4 k0 = kmp[0], k1 = kmp[1];
                    s += bf2f((unsigned short)qr[d0][0]) * k0[0] + bf2f((unsigned short)qr[d0][1]) * k0[1] + bf2f((unsigned short)qr[d0][2]) * k0[2] + bf2f((unsigned short)qr[d0][3]) * k0[3]
                       + bf2f((unsigned short)qr[d0][4]) * k1[0] + bf2f((unsigned short)qr[d0][5]) * k1[1] + bf2f((unsigned short)qr[d0][6]) * k1[2] + bf2f((unsigned short)qr[d0][7]) * k1[3]; }
                s += __shfl_xor(s, 32);
            }
            gate[n] = s;
        }
#pragma unroll
        for (int r = 0; r < 3; ++r) {
            int best = -1; float bv = 0.f;
#pragma unroll
            for (int n = 0; n < NBLK; ++n) if (n < qi && !((selmask >> n) & 1u)) { if (best < 0 || gate[n] > bv) { best = n; bv = gate[n]; } }
            if (best >= 0) selmask |= 1u << best;
        }
    }
    f32x16 cb0, cb1;
#pragma unroll
    for (int r = 0; r < 16; ++r) { const int kk = (r & 3) + 8 * (r >> 2) + 4 * hi; cb0[r] = slope2 * (float)kk; cb1[r] = slope2 * (float)(kk + 32); }
    f32x16 o0 = {}, o1 = {};
    float m_run = -1.0e30f, l_run = 0.f;
    const int qrel = wave * 32 + r32;
    for (int it = 0;; ++it) {
        const int buf = it & 1;
        const int j = jn, tt = ttn, tl = 4 * jn + ttn;
        *(LAS v4u*)(lds + kst + buf * AT_KBUF) = kreg;
        *(LAS v2u*)(lds + vst + buf * AT_VBUF) = (v2u){vreg.x, vreg.y}; *(LAS v2u*)(lds + vst + buf * AT_VBUF + 8) = (v2u){vreg.z, vreg.w};
        bool more = true;
        if (++ttn == 4) { ttn = 0; remn &= remn - 1; more = remn != 0u; if (more) jn = __builtin_ctz(remn); }
        if (more) { kreg = *(const v4u*)(kg + (size_t)(4 * jn + ttn) * 64 * D); vreg = *(const v4u*)(vg + (size_t)(4 * jn + ttn) * 64); }
        __syncthreads();
        const bool own = (j == qi);
        const bool rowsel = ((selmask >> j) & 1u) != 0u;
        bool skip = own ? (64 * tt > wave * 32 + 31) : (__builtin_amdgcn_ballot_w64(rowsel) == 0ull);
        if (skip) { if (!more) break; continue; }
        const LAS unsigned char* kb = lds + AT_K + buf * AT_KBUF + r32 * AT_KPITCH + hi * 16;
        f32x16 p0 = cb0, p1 = cb1;
#pragma unroll
        for (int d0 = 0; d0 < 4; ++d0) {
            const bf16x8 a0 = *(const LAS bf16x8*)(kb + d0 * 32), a1 = *(const LAS bf16x8*)(kb + 32 * AT_KPITCH + d0 * 32);
            p0 = __builtin_amdgcn_mfma_f32_32x32x16_bf16(a0, qr[d0], p0, 0, 0, 0);
            p1 = __builtin_amdgcn_mfma_f32_32x32x16_bf16(a1, qr[d0], p1, 0, 0, 0);
        }
        if (own) {
#pragma unroll
            for (int r = 0; r < 16; ++r) { const int kk = 64 * tt + (r & 3) + 8 * (r >> 2) + 4 * hi; if (kk > qrel) p0[r] = -INFINITY; if (kk + 32 > qrel) p1[r] = -INFINITY; }
        }
        float tm = max3f(p0[0], p0[1], p1[0]), tm2 = max3f(p0[2], p0[3], p1[1]);
        tm = max3f(tm, p1[2], p1[3]);
#pragma unroll
        for (int r = 4; r < 16; r += 4) { tm = max3f(tm, p0[r], p0[r + 1]); tm2 = max3f(tm2, p0[r + 2], p0[r + 3]); tm = max3f(tm, p1[r], p1[r + 1]); tm2 = max3f(tm2, p1[r + 2], p1[r + 3]); }
        tm = max3f(tm, tm2, __shfl_xor(fmaxf(tm, tm2), 32));
        const float toff = slope2 * (float)(64 * tl - q0 - 255);
        const float mnew = rowsel ? fmaxf(m_run, tm + toff) : m_run;
        const float alpha = __builtin_amdgcn_exp2f(m_run - mnew);
        const float msub = rowsel ? (mnew - toff) : INFINITY;
        m_run = mnew;
        f32x2 ls2 = {0.f, 0.f}; const f32x2 nms = {-msub, -msub};
#pragma unroll
        for (int r = 0; r < 16; r += 2) { const f32x2 a = (f32x2){p0[r], p0[r + 1]} + nms, c = (f32x2){p1[r], p1[r + 1]} + nms;
            p0[r] = __builtin_amdgcn_exp2f(a.x); p0[r + 1] = __builtin_amdgcn_exp2f(a.y); p1[r] = __builtin_amdgcn_exp2f(c.x); p1[r + 1] = __builtin_amdgcn_exp2f(c.y);
            ls2 += (f32x2){p0[r], p0[r + 1]}; ls2 += (f32x2){p1[r], p1[r + 1]}; }
        l_run = l_run * alpha + (ls2.x + ls2.y);
        if (__builtin_amdgcn_ballot_w64(alpha != 1.0f) != 0ull) { o0 = o0 * alpha; o1 = o1 * alpha; }
        bf16x8 pb[4];
#pragma unroll
        for (int s = 0; s < 4; ++s) {
            unsigned w[4];
#pragma unroll
            for (int q = 0; q < 4; ++q) w[q] = (s < 2) ? pk2(p0[8 * (s & 1) + 2 * q], p0[8 * (s & 1) + 2 * q + 1]) : pk2(p1[8 * (s & 1) + 2 * q], p1[8 * (s & 1) + 2 * q + 1]);
            pb[s] = __builtin_bit_cast(bf16x8, (v4u){w[0], w[1], w[2], w[3]});
        }
        const LAS unsigned char* vb = lds + AT_V + buf * AT_VBUF + r32 * AT_VPITCH + hi * 8;
#pragma unroll
        for (int s = 0; s < 4; ++s) {
            const int kk2 = (32 * (s >> 1) + 16 * (s & 1)) * 2;
            const v2u a0l = *(const LAS v2u*)(vb + kk2), a0h = *(const LAS v2u*)(vb + kk2 + 16);
            const v2u a1l = *(const LAS v2u*)(vb + 32 * AT_VPITCH + kk2), a1h = *(const LAS v2u*)(vb + 32 * AT_VPITCH + kk2 + 16);
            const bf16x8 va0 = __builtin_bit_cast(bf16x8, (v4u){a0l.x, a0l.y, a0h.x, a0h.y}), va1 = __builtin_bit_cast(bf16x8, (v4u){a1l.x, a1l.y, a1h.x, a1h.y});
            o0 = __builtin_amdgcn_mfma_f32_32x32x16_bf16(va0, pb[s], o0, 0, 0, 0);
            o1 = __builtin_amdgcn_mfma_f32_32x32x16_bf16(va1, pb[s], o1, 0, 0, 0);
        }
        if (!more) break;
    }
    const float ltot = l_run + __shfl_xor(l_run, 32);
    const float inv = 1.0f / ltot;
    bf16_t* orow = O + (size_t)(b * S + q0 + wave * 32 + r32) * D + h * HD;
#pragma unroll
    for (int g = 0; g < 4; ++g) {
        v2u w0, w1;
        w0.x = pk2(o0[4 * g] * inv, o0[4 * g + 1] * inv); w0.y = pk2(o0[4 * g + 2] * inv, o0[4 * g + 3] * inv);
        w1.x = pk2(o1[4 * g] * inv, o1[4 * g + 1] * inv); w1.y = pk2(o1[4 * g + 2] * inv, o1[4 * g + 3] * inv);
        *(v2u*)(orow + 8 * g + 4 * hi) = w0; *(v2u*)(orow + 32 + 8 * g + 4 * hi) = w1;
    }
    __syncthreads();
}
#define ATS_TILE(KB, VB, RS, TOFF, CAUS) do { \
        const LAS unsigned char* kb_ = (KB) + r32 * AT_KPITCH + hi * 16; f32x16 p0 = cb0, p1 = cb1; \
        _Pragma("unroll") for (int d0 = 0; d0 < 4; ++d0) { const bf16x8 a0_ = *(const LAS bf16x8*)(kb_ + d0 * 32), a1_ = *(const LAS bf16x8*)(kb_ + 32 * AT_KPITCH + d0 * 32); \
            p0 = __builtin_amdgcn_mfma_f32_32x32x16_bf16(a0_, qr[d0], p0, 0, 0, 0); p1 = __builtin_amdgcn_mfma_f32_32x32x16_bf16(a1_, qr[d0], p1, 0, 0, 0); } \
        if ((CAUS) >= 0 && (CAUS) + 63 > wave * 32) { _Pragma("unroll") for (int r = 0; r < 16; ++r) { const int kk = (CAUS) + (r & 3) + 8 * (r >> 2) + 4 * hi; if (kk > qrel) p0[r] = -INFINITY; if (kk + 32 > qrel) p1[r] = -INFINITY; } } \
        float tm = max3f(p0[0], p0[1], p1[0]), tm2 = max3f(p0[2], p0[3], p1[1]); tm = max3f(tm, p1[2], p1[3]); \
        _Pragma("unroll") for (int r = 4; r < 16; r += 4) { tm = max3f(tm, p0[r], p0[r + 1]); tm2 = max3f(tm2, p0[r + 2], p0[r + 3]); tm = max3f(tm, p1[r], p1[r + 1]); tm2 = max3f(tm2, p1[r + 2], p1[r + 3]); } \
        tm = max3f(tm, tm2, __shfl_xor(fmaxf(tm, tm2), 32)); \
        const float toff_ = (TOFF); const bool rs_ = (RS); \
        const float mnew = rs_ ? fmaxf(m_run, tm + toff_) : m_run; const float alpha = __builtin_amdgcn_exp2f(m_run - mnew); const float msub = rs_ ? (mnew - toff_) : INFINITY; m_run = mnew; \
        f32x2 ls2 = {0.f, 0.f}; const f32x2 nms = {-msub, -msub}; \
        _Pragma("unroll") for (int r = 0; r < 16; r += 2) { const f32x2 a = (f32x2){p0[r], p0[r + 1]} + nms, c = (f32x2){p1[r], p1[r + 1]} + nms; \
            p0[r] = __builtin_amdgcn_exp2f(a.x); p0[r + 1] = __builtin_amdgcn_exp2f(a.y); p1[r] = __builtin_amdgcn_exp2f(c.x); p1[r + 1] = __builtin_amdgcn_exp2f(c.y); \
            ls2 += (f32x2){p0[r], p0[r + 1]}; ls2 += (f32x2){p1[r], p1[r + 1]}; } \
        l_run = l_run * alpha + (ls2.x + ls2.y); \
        if (__builtin_amdgcn_ballot_w64(alpha != 1.0f) != 0ull) { o0 = o0 * alpha; o1 = o1 * alpha; } \
        bf16x8 pb[4]; \
        _Pragma("unroll") for (int s4 = 0; s4 < 4; ++s4) { unsigned w[4]; \
            _Pragma("unroll") for (int q = 0; q < 4; ++q) w[q] = (s4 < 2) ? pk2(p0[8 * (s4 & 1) + 2 * q], p0[8 * (s4 & 1) + 2 * q + 1]) : pk2(p1[8 * (s4 & 1) + 2 * q], p1[8 * (s4 & 1) + 2 * q + 1]); \
            pb[s4] = __builtin_bit_cast(bf16x8, (v4u){w[0], w[1], w[2], w[3]}); } \
        const LAS unsigned char* vb_ = (VB) + r32 * AT_VPITCH + hi * 8; \
        _Pragma("unroll") for (int s4 = 0; s4 < 4; ++s4) { const int kk2 = (32 * (s4 >> 1) + 16 * (s4 & 1)) * 2; \
            const v2u a0l = *(const LAS v2u*)(vb_ + kk2), a0h = *(const LAS v2u*)(vb_ + kk2 + 16); \
            const v2u a1l = *(const LAS v2u*)(vb_ + 32 * AT_VPITCH + kk2), a1h = *(const LAS v2u*)(vb_ + 32 * AT_VPITCH + kk2 + 16); \
            const bf16x8 va0 = __builtin_bit_cast(bf16x8, (v4u){a0l.x, a0l.y, a0h.x, a0h.y}), va1 = __builtin_bit_cast(bf16x8, (v4u){a1l.x, a1l.y, a1h.x, a1h.y}); \
            o0 = __builtin_amdgcn_mfma_f32_32x32x16_bf16(va0, pb[s4], o0, 0, 0, 0); o1 = __builtin_amdgcn_mfma_f32_32x32x16_bf16(va1, pb[s4], o1, 0, 0, 0); } } while (0)
constexpr int ATS_TILEB = 64 * AT_KPITCH + 64 * AT_VPITCH;
__device__ __forceinline__ void ats_stage_block(const bf16_t* K, const bf16_t* Vt, int b, int h, int jb, LAS unsigned char* lds, int tid) {
    const int srow = tid >> 3, sch = tid & 7;
    const bf16_t* kg = K + (size_t)(b * S + 256 * jb + srow) * D + h * HD + sch * 8;
    const bf16_t* vg = Vt + (size_t)(h * HD + srow) * T + b * S + 256 * jb + sch * 8;
    v4u kr[4], vr[4];
#pragma unroll
    for (int tt = 0; tt < 4; ++tt) { kr[tt] = *(const v4u*)(kg + (size_t)tt * 64 * D); vr[tt] = *(const v4u*)(vg + tt * 64); }
#pragma unroll
    for (int tt = 0; tt < 4; ++tt) { LAS unsigned char* tb = lds + tt * ATS_TILEB;
        *(LAS v4u*)(tb + srow * AT_KPITCH + sch * 16) = kr[tt];
        *(LAS v2u*)(tb + 64 * AT_KPITCH + srow * AT_VPITCH + sch * 16) = (v2u){vr[tt].x, vr[tt].y}; *(LAS v2u*)(tb + 64 * AT_KPITCH + srow * AT_VPITCH + sch * 16 + 8) = (v2u){vr[tt].z, vr[tt].w}; }
    __syncthreads();
}
__device__ __forceinline__ void attn_gate_phase(const bf16_t* Q, const float* kmean, const float* kabs, unsigned short* takebits, int* gcnt, int* selinfo, float* pml_mark, LAS unsigned char* lds, int wg, int G, int wave, int lane) {
    LAS float* km = (LAS float*)(lds + wave * 4096);
    for (int item = wg * NWAVES + wave; item < NB * NH * (S / 64); item += G * NWAVES) {
        const int tg = item & (S / 64 - 1), bh = item >> 6, b = bh >> 4, h = bh & 15;
        const int t = tg * 64 + lane, qi = tg >> 2;
#pragma unroll
        for (int q = 0; q < 4; ++q) *((LAS f32x4*)km + lane + 64 * q) = *((const f32x4*)(kmean + (size_t)bh * NBLK * HD) + lane + 64 * q);
        const bf16_t* qrow = Q + (size_t)(b * S + t) * D + h * HD;
        v4u qv[8];
#pragma unroll
        for (int k = 0; k < 8; ++k) qv[k] = *(const v4u*)(qrow + 8 * k);
        float l1 = 0.f;
#pragma unroll
        for (int k = 0; k < 8; ++k) l1 += (fabsf(bflo(qv[k].x)) + fabsf(bfhi(qv[k].x))) + (fabsf(bflo(qv[k].y)) + fabsf(bfhi(qv[k].y))) + (fabsf(bflo(qv[k].z)) + fabsf(bfhi(qv[k].z))) + (fabsf(bflo(qv[k].w)) + fabsf(bfhi(qv[k].w)));
        float gate[NBLK];
#pragma unroll
        for (int n = 0; n < NBLK; ++n) { float sg = 0.f;
            if (n < qi) {
#pragma unroll
                for (int k = 0; k < 8; ++k) { const f32x4 k0 = *((const LAS f32x4*)(km + n * HD + 8 * k)), k1 = *((const LAS f32x4*)(km + n * HD + 8 * k + 4));
                    sg += (bflo(qv[k].x) * k0[0] + bfhi(qv[k].x) * k0[1]) + (bflo(qv[k].y) * k0[2] + bfhi(qv[k].y) * k0[3]) + (bflo(qv[k].z) * k1[0] + bfhi(qv[k].z) * k1[1]) + (bflo(qv[k].w) * k1[2] + bfhi(qv[k].w) * k1[3]); } }
            gate[n] = sg; }
        unsigned sel = 0u;
#pragma unroll
        for (int r = 0; r < 3; ++r) { int best = -1; float bv = 0.f;
#pragma unroll
            for (int n = 0; n < NBLK; ++n) if (n < qi && !((sel >> n) & 1u)) { if (best < 0 || gate[n] > bv) { best = n; bv = gate[n]; } }
            if (best >= 0) sel |= 1u << best; }
        const float slope2 = exp2f(-8.0f * (float)(h + 1) / (float)NH) * LOG2E;
        const float* kab = kabs + bh * NBLK; const float kown = kab[qi];
        int slot = 0; unsigned tmask = 0u;
        for (int n = 0; n < NBLK; ++n) {
            bool take = n < qi && ((sel >> n) & 1u) != 0u;
            if (take) { const float bound = l1 * (kab[n] + kown) * 1.02f + 160.0f; if (slope2 * (float)(t - 256 * n - 255) > bound) take = false; }
            if (take) { tmask |= 1u << n; ++slot; }
            const unsigned long long mk = __builtin_amdgcn_ballot_w64(take);
            if (lane == 0) ST_WT(gcnt + (size_t)(bh * NBLK + n) * 64 + tg, (int)__builtin_popcountll(mk));
        }
        ST_WT(takebits + (size_t)(b * S + t) * NH + h, (unsigned short)tmask);
        ST_WT(selinfo + (size_t)(b * S + t) * NH + h, slot);
        if (DIAG_CHECK_LISTS) { for (int r = 0; r < 3; ++r) pml_mark[(((size_t)r * T + (size_t)(b * S + t)) * NH + h) * 2 + 1] = -1.0f; }
    }
}
__device__ __forceinline__ void attn_list_phase(const unsigned short* takebits, const int* gcnt, int* cnt, unsigned* lists, int wg, int G, int wave, int lane) {
    for (int item = wg * NWAVES + wave; item < NB * NH * (S / 64); item += G * NWAVES) {
        const int tg = item & (S / 64 - 1), bh = item >> 6, b = bh >> 4, h = bh & 15;
        const int t = tg * 64 + lane, qi = tg >> 2;
        const unsigned tmask = takebits[(size_t)(b * S + t) * NH + h];
        for (int n = 0; n < qi; ++n) {
            const int v = gcnt[(size_t)(bh * NBLK + n) * 64 + lane];
            int pre = lane < tg ? v : 0, tot = v;
#pragma unroll
            for (int o = 1; o < 64; o <<= 1) { pre += __shfl_xor(pre, o); tot += __shfl_xor(tot, o); }
            const bool take = ((tmask >> n) & 1u) != 0u;
            const unsigned long long mk = __builtin_amdgcn_ballot_w64(take);
            if (take) { const int rank = (int)__builtin_popcountll(mk & ((1ull << lane) - 1ull)), slot = __builtin_popcount(tmask & ((1u << n) - 1u));
                ST_WT(lists + (size_t)(bh * NBLK + n) * 4096 + pre + rank, (unsigned)t | ((unsigned)slot << 12)); }
            if (tg == S / 64 - 1 && lane == 0) ST_WT(cnt + bh * NBLK + n, tot);
        }
        if (tg == S / 64 - 1 && lane == 0) ST_WT(cnt + bh * NBLK + NBLK - 1, 0);
    }
}
__device__ __forceinline__ void attn_sort_phase(const int* cnt, unsigned* lists, LAS unsigned char* lds, int wg, int G, int tid) {
    LAS unsigned* bm = (LAS unsigned*)lds;
    LAS unsigned char* sl = (LAS unsigned char*)(lds + 1024);
    LAS int* pre = (LAS int*)(lds + 8192);
    for (int e = wg; e < NB * NH * NBLK; e += G) {
        const int n = __hip_atomic_load(cnt + e, __ATOMIC_RELAXED, __HIP_MEMORY_SCOPE_AGENT);
        if (tid < 128) bm[tid] = 0u; __syncthreads();
        for (int i = tid; i < n; i += NTHR) { const unsigned ent = lists[(size_t)e * 4096 + i]; const unsigned t = ent & 4095u; sl[t] = (unsigned char)(ent >> 12); __hip_atomic_fetch_or(bm + (t >> 5), 1u << (t & 31u), __ATOMIC_RELAXED, __HIP_MEMORY_SCOPE_WORKGROUP); }
        __syncthreads();
        if (tid == 0) { int a = 0; for (int w = 0; w < 128; ++w) { pre[w] = a; a += __builtin_popcount(bm[w]); } }
        __syncthreads();
        if (DIAG_SORT_LISTS == 2) { for (int i = tid; i < n; i += NTHR) { const unsigned ent = lists[(size_t)e * 4096 + i]; asm volatile("" ::: "memory"); lists[(size_t)e * 4096 + i] = ent; } }
        else if (tid < 128) { unsigned m = bm[tid]; int o = pre[tid]; while (m) { const int bpos = __builtin_ctz(m); m &= m - 1u; const unsigned t = (unsigned)(tid * 32 + bpos); lists[(size_t)e * 4096 + o++] = t | ((unsigned)sl[t] << 12); } }
        __syncthreads();
    }
}
__device__ __forceinline__ void attn_sel_phase(const bf16_t* Q, const bf16_t* K, const bf16_t* Vt, const int* cnt, const unsigned* lists, bf16_t* po, float* pml, unsigned* dflag, LAS unsigned char* lds, int wg, int G, int tid, int wave, int lane) {
    const int r32 = lane & 31, hi = lane >> 5, qrel = 0; (void)qrel;
    LAS int* lc = (LAS int*)(lds + 4 * ATS_TILEB);
    for (int i = tid; i < NB * NH * NBLK; i += NTHR) lc[i] = __hip_atomic_load(cnt + i, __ATOMIC_RELAXED, __HIP_MEMORY_SCOPE_AGENT);
    __syncthreads();
    if (DIAG_CHECK_LISTS) {
        LAS unsigned* bm = (LAS unsigned*)lds;
        for (int e = wg; e < NB * NH * NBLK; e += G) { const int n = lc[e], j = e & 15;
            if (tid < 128) bm[tid] = 0u; __syncthreads();
            unsigned bad = 0u;
            for (int i = tid; i < n; i += NTHR) { const unsigned ent = lists[(size_t)e * 4096 + i]; const unsigned t = ent & 4095u, sl = ent >> 12;
                if (sl > 2u || (int)(t >> 8) <= j) bad = 1u; const unsigned old = __hip_atomic_fetch_or(bm + (t >> 5), 1u << (t & 31u), __ATOMIC_RELAXED, __HIP_MEMORY_SCOPE_WORKGROUP); if (old & (1u << (t & 31u))) bad = 1u; }
            if (n > 3840) bad = 1u;
            if (bad) __hip_atomic_store(dflag, 1u, __ATOMIC_RELAXED, __HIP_MEMORY_SCOPE_AGENT);
            __syncthreads(); }
    }
    int u = 0;
    for (int e = 0; e < NB * NH * NBLK; ++e) {
        const int n = DIAG_FIXED_LISTS ? ((e & 15) < 15 ? (15 - (e & 15)) * 256 : 0) : lc[e]; if (n == 0) continue;
        const int nch = (n + 255) >> 8, bh = e >> 4, j = e & 15, b = bh >> 4, h = bh & 15;
        for (int c = 0; c < nch; ++c, ++u) {
            if (u % G != wg) continue;
            ats_stage_block(K, Vt, b, h, j, lds, tid);
            const int idx = 256 * c + 32 * wave + r32; bool valid = idx < n;
            if (256 * c + 32 * wave < n) {
                unsigned ent = lists[(size_t)e * 4096 + (valid ? idx : n - 1)];
                if (DIAG_FIXED_LISTS) { if (ent == 0xffffffffu) { valid = false; ent = (unsigned)(256 * (j + 1) + idx); } }
                const int t = (int)(ent & 4095u), slot = (int)(ent >> 12);
                const bf16_t* qrow = Q + (size_t)(b * S + t) * D + h * HD;
                bf16x8 qr[4];
#pragma unroll
                for (int d0 = 0; d0 < 4; ++d0) qr[d0] = *(const bf16x8*)(qrow + d0 * 16 + hi * 8);
                const float slope2 = exp2f(-8.0f * (float)(h + 1) / (float)NH) * LOG2E;
                f32x16 cb0, cb1;
#pragma unroll
                for (int r = 0; r < 16; ++r) { const int kk = (r & 3) + 8 * (r >> 2) + 4 * hi; cb0[r] = slope2 * (float)kk; cb1[r] = slope2 * (float)(kk + 32); }
                f32x16 o0 = {}, o1 = {}; float m_run = -1.0e30f, l_run = 0.f;
                const float tbase = slope2 * (float)(256 * j - ((t & ~255) + 255));
#pragma unroll 1
                for (int tt = 0; tt < 4; ++tt) ATS_TILE(lds + tt * ATS_TILEB, lds + tt * ATS_TILEB + 64 * AT_KPITCH, valid, tbase + slope2 * (float)(64 * tt), -1);
                const float ltot = l_run + __shfl_xor(l_run, 32);
                if (valid) { const float inv = 1.0f / ltot; const size_t row = ((size_t)slot * T + (size_t)(b * S + t)) * NH + h;
                    bf16_t* op = po + row * HD;
#pragma unroll
                    for (int g = 0; g < 4; ++g) { v2u w0, w1;
                        w0.x = pk2(o0[4 * g] * inv, o0[4 * g + 1] * inv); w0.y = pk2(o0[4 * g + 2] * inv, o0[4 * g + 3] * inv);
                        w1.x = pk2(o1[4 * g] * inv, o1[4 * g + 1] * inv); w1.y = pk2(o1[4 * g + 2] * inv, o1[4 * g + 3] * inv);
                        *(v2u*)(op + 8 * g + 4 * hi) = w0; *(v2u*)(op + 32 + 8 * g + 4 * hi) = w1; }
                    if (hi == 0) { ST_WT(pml + row * 2, m_run); ST_WT(pml + row * 2 + 1, ltot); } }
            }
            __syncthreads();
        }
    }
}
__device__ __forceinline__ void attn_own_phase(const bf16_t* Q, const bf16_t* K, const bf16_t* Vt, const int* selinfo, const bf16_t* po, const float* pml, bf16_t* O, unsigned* dflag, LAS unsigned char* lds, int wg, int G, int tid, int wave, int lane) {
    const int r32 = lane & 31, hi = lane >> 5;
    for (int unit = wg; unit < NB * NH * NBLK; unit += G) {
        const int qi = unit & 15, bh = unit >> 4, b = bh >> 4, h = bh & 15, q0 = qi * 256;
        ats_stage_block(K, Vt, b, h, qi, lds, tid);
        const int qrel = wave * 32 + r32, t = q0 + qrel;
        const bf16_t* qrow = Q + (size_t)(b * S + t) * D + h * HD;
        bf16x8 qr[4];
#pragma unroll
        for (int d0 = 0; d0 < 4; ++d0) qr[d0] = *(const bf16x8*)(qrow + d0 * 16 + hi * 8);
        const float slope2 = exp2f(-8.0f * (float)(h + 1) / (float)NH) * LOG2E;
        f32x16 cb0, cb1;
#pragma unroll
        for (int r = 0; r < 16; ++r) { const int kk = (r & 3) + 8 * (r >> 2) + 4 * hi; cb0[r] = slope2 * (float)kk; cb1[r] = slope2 * (float)(kk + 32); }
        f32x16 o0 = {}, o1 = {}; float m_run = -1.0e30f, l_run = 0.f;
        const int nsl = selinfo[(size_t)(b * S + t) * NH + h];
        float pm[3], pl[3];
#pragma unroll
        for (int r = 0; r < 3; ++r) { const size_t row = ((size_t)r * T + (size_t)(b * S + t)) * NH + h; pm[r] = -1.0e30f; pl[r] = 0.f; if (r < nsl) { pm[r] = pml[row * 2]; pl[r] = pml[row * 2 + 1]; if (DIAG_CHECK_LISTS && pl[r] < 0.f) __hip_atomic_store(dflag, 2u, __ATOMIC_RELAXED, __HIP_MEMORY_SCOPE_AGENT); } }
        m_run = fmaxf(fmaxf(pm[0], pm[1]), pm[2]);
#pragma unroll
        for (int r = 0; r < 3; ++r) if (r < nsl) {
            const float w = pl[r] * __builtin_amdgcn_exp2f(pm[r] - m_run); l_run += w;
            const bf16_t* op = po + (((size_t)r * T + (size_t)(b * S + t)) * NH + h) * HD;
#pragma unroll
            for (int g = 0; g < 4; ++g) { const v2u w0 = *(const v2u*)(op + 8 * g + 4 * hi), w1 = *(const v2u*)(op + 32 + 8 * g + 4 * hi);
                o0[4 * g] += w * bflo(w0.x); o0[4 * g + 1] += w * bfhi(w0.x); o0[4 * g + 2] += w * bflo(w0.y); o0[4 * g + 3] += w * bfhi(w0.y);
                o1[4 * g] += w * bflo(w1.x); o1[4 * g + 1] += w * bfhi(w1.x); o1[4 * g + 2] += w * bflo(w1.y); o1[4 * g + 3] += w * bfhi(w1.y); } }
        l_run *= 0.5f;
#pragma unroll 1
        for (int tt = 0; tt < 4; ++tt) { if (64 * tt > wave * 32 + 31) break;
            ATS_TILE(lds + tt * ATS_TILEB, lds + tt * ATS_TILEB + 64 * AT_KPITCH, true, slope2 * (float)(64 * tt - 255), 64 * tt); }
        const float ltot = l_run + __shfl_xor(l_run, 32);
        float inv = 1.0f / ltot;
        if (DIAG_CHECK_LISTS) { if (__hip_atomic_load(dflag, __ATOMIC_RELAXED, __HIP_MEMORY_SCOPE_AGENT) != 0u) inv = __builtin_nanf(""); }
        bf16_t* orow = O + (size_t)(b * S + t) * D + h * HD;
#pragma unroll
        for (int g = 0; g < 4; ++g) { v2u w0, w1;
            w0.x = pk2(o0[4 * g] * inv, o0[4 * g + 1] * inv); w0.y = pk2(o0[4 * g + 2] * inv, o0[4 * g + 3] * inv);
            w1.x = pk2(o1[4 * g] * inv, o1[4 * g + 1] * inv); w1.y = pk2(o1[4 * g + 2] * inv, o1[4 * g + 3] * inv);
            *(v2u*)(orow + 8 * g + 4 * hi) = w0; *(v2u*)(orow + 32 + 8 * g + 4 * hi) = w1; }
        __syncthreads();
    }
}
struct AttnOrder { unsigned char hq[256]; };
constexpr AttnOrder make_attn_order() {
    AttnOrder o{}; int cost[256] = {}; const int nb[16] = {1, 2, 2, 3, 4, 6, 8, 11, 15, 15, 15, 15, 15, 15, 15, 15};
    for (int k = 0; k < 256; ++k) { const int h = k >> 4, i = k & 15; o.hq[k] = (unsigned char)k; cost[k] = 8 * (i < nb[h] ? i : nb[h]) + 5; }
    for (int a = 1; a < 256; ++a) { const int c = cost[a]; const unsigned char v = o.hq[a]; int q = a - 1; while (q >= 0 && cost[q] < c) { cost[q + 1] = cost[q]; o.hq[q + 1] = o.hq[q]; --q; } cost[q + 1] = c; o.hq[q + 1] = v; }
    return o;
}
__device__ constexpr AttnOrder ATTN_ORDER = make_attn_order();
__device__ __forceinline__ void attn_phase(const bf16_t* Q, const bf16_t* K, const bf16_t* Vt, const float* kmean, const float* kabs, bf16_t* O, LAS unsigned char* lds, int wg, int G, int tid, int wave, int lane) {
    for (int r = 0; r < 4; ++r) {
        const int u = (r == 0) ? wg : (r == 1) ? 511 - wg : (r == 2) ? 512 + wg : 1023 - wg;
        const int hq = ATTN_ORDER.hq[u >> 2], b = u & 3;
        attn_unit(b, hq >> 4, hq & 15, Q, K, Vt, kmean, kabs, O, lds, tid, wave, lane);
    }
}

#ifndef REP_ATTN
#define REP_ATTN 1
#endif
#ifndef REP_B1
#define REP_B1 1
#endif
#ifndef REP_CI
#define REP_CI 1
#endif
#ifndef REP_CONV
#define REP_CONV 1
#endif
#ifndef REP_E0
#define REP_E0 1
#endif
#ifndef REP_E1
#define REP_E1 1
#endif
#ifndef REP_E2
#define REP_E2 1
#endif
#ifndef REP_F1
#define REP_F1 1
#endif
#ifndef REP_F2
#define REP_F2 1
#endif
#ifndef REP_P0
#define REP_P0 1
#endif
#ifndef REP_ROW
#define REP_ROW 1
#endif
#ifndef REP_X3
#define REP_X3 1
#endif
#ifndef TPROBE
#define TPROBE -1
#endif
#ifndef TP_MULT
#define TP_MULT 2
#endif
#define PH_BEGIN(REP, CLS) if (lo <= ph && ph < hi) { if (TPROBE >= 0) { unsigned long long now_ = __builtin_amdgcn_s_memrealtime(); \
                 if (tp.cls == TPROBE) { const unsigned long long d_ = (now_ - tp.t0) * TP_MULT; while (__builtin_amdgcn_s_memrealtime() - now_ < d_) __builtin_amdgcn_s_sleep(8); now_ = __builtin_amdgcn_s_memrealtime(); } \
                 tp.t0 = now_; tp.cls = (CLS); } \
                 for (int rep_i = 0; rep_i < (REP); ++rep_i) { if (rep_i) xcd_barrier(bar); int tid = threadIdx.x; asm volatile("" : "+v"(tid)); const int lane = tid & 63, wave = __builtin_amdgcn_readfirstlane(tid >> 6); \
                 int wg = vwg; asm volatile("" : "+s"(wg)); unsigned char* ws = args.ws; asm volatile("" : "+s"(ws)); (void)lane; (void)wave; (void)wg;
#define PH_END   } if (ph + 1 < hi) xcd_barrier(bar); } ++ph;
struct TProbe { unsigned long long acc, t0; int cls; };
#define WSP(Ty, off) ((Ty*)(ws + (off)))
#define MODP  WSP(float, WS_MOD)


template <int L> __device__ __forceinline__ void layer_phases(const Args& args, LAS unsigned char* lds, const XcdBarrier& bar, const int lo, const int hi, const int G, const int vwg, TProbe& tp) {
    constexpr int l = L;
    int ph = 2 + (L >= 1 ? 7 : 0) + (L >= 2 ? 8 : 0) + (L >= 3 ? 7 + (SPARSE_ATTN ? 3 + (DIAG_SORT_LISTS ? 1 : 0) : 0) : 0);
#define MLP   (MODP + (size_t)l * NB * 6 * D)
#define XIN   ((l == 0) ? (const void*)args.in[0] : (const void*)(ws + WS_X0 + (size_t)(2 * l - 1) * 64 * MiB))
#define X1P   ((bf16_t*)(ws + WS_X0 + (size_t)(2 * l) * 64 * MiB))
#define X2P   ((bf16_t*)(ws + WS_X0 + (size_t)(2 * l + 1) * 64 * MiB))
        if (l < NA) {
            PH_BEGIN(REP_CI, 2)
                constexpr bool F8 = FP8_CONV != 0; constexpr int EB = F8 ? 1 : 2;
                pg8::Gemm g{WSP(bf16_t, WS_HBF), (const bf16_t*)(ws + W_CI + (size_t)l * 2 * D * D * EB), T, 2 * D, D * EB / 2}; pg8::StaticOrder So; So.init(T, 2 * D, G, wg);
                pg8::EpiGated<0, 0> E{WSP(bf16_t, WS_U), D, args.in[7] + l * 2 * D, D, F8 ? 1.0f / (S8_H * S8_WP) : 1.0f, 1.0f};
                pg8::gemm_phase<pg8::EpiGated<0, 0>, pg8::StaticOrder, true, true, F8>(lds, g, So, E);
            PH_END
            PH_BEGIN(REP_CONV, 3)
                conv_phase(WSP(bf16_t, WS_U), args.in[8] + l * CONVK * D, args.in[9] + l * D, args.in[10] + l * D, args.in[11] + l * D, WSP(bf16_t, WS_U2), lds, wg, tid, wave, lane);
            PH_END
        } else {
            PH_BEGIN(REP_B1, 4)
                constexpr bool AF8 = FP8_ATTN != 0; constexpr int AEB = AF8 ? 1 : 2;
                if (l == NA) {
                    { pg8::Gemm g{WSP(bf16_t, WS_HKV), WSP(const bf16_t, W_KV), T, D, D * AEB / 2}; pg8::StaticOrder So; So.init(T, D, G, wg);
                      pg8::EpiK E{WSP(bf16_t, WS_K), D, WSP(float, WS_KMEAN), WSP(unsigned, WS_KABS), AF8 ? 1.0f / (S8_H * S8_WP) : 1.0f};
                      pg8::gemm_phase<pg8::EpiK, pg8::StaticOrder, true, true, AF8>(lds, g, So, E); }
                    { pg8::Gemm g{(const bf16_t*)(ws + W_KV + (size_t)D * D * AEB), WSP(bf16_t, WS_HKV), D, T, D * AEB / 2}; pg8::StaticOrder So; So.init(D, T, G, wg);
                      pg8::EpiBf16S E{WSP(bf16_t, WS_VT), T, AF8 ? 1.0f / (S8_H * S8_WP) : 1.0f};
                      pg8::gemm_phase<pg8::EpiBf16S, pg8::StaticOrder, true, true, AF8>(lds, g, So, E); }
                }
                { pg8::Gemm g{WSP(bf16_t, WS_HBF), (const bf16_t*)(ws + W_Q + (size_t)(l - NA) * D * D * AEB), T, D, D * AEB / 2}; pg8::StaticOrder So; So.init(T, D, G, wg);
                  pg8::EpiBf16S E{WSP(bf16_t, WS_U), D, AF8 ? QSCALE / (S8_H * S8_WP) : QSCALE};
                  pg8::gemm_phase<pg8::EpiBf16S, pg8::StaticOrder, true, true, AF8>(lds, g, So, E); }
            PH_END
            if constexpr (SPARSE_ATTN != 0) {
                PH_BEGIN(REP_ATTN, 5)
                    attn_gate_phase(WSP(bf16_t, WS_U), WSP(float, WS_KMEAN), WSP(float, WS_KABS), WSP(unsigned short, WS_ATAKE), WSP(int, WS_AGCNT), WSP(int, WS_ASEL), WSP(float, WS_APML), lds, wg, G, wave, lane);
                PH_END
                PH_BEGIN(REP_ATTN, 5)
                    attn_list_phase(WSP(unsigned short, WS_ATAKE), WSP(int, WS_AGCNT), WSP(int, WS_ACNT) + (l - NA) * (NB * NH * NBLK), WSP(unsigned, WS_ALIST), wg, G, wave, lane);
                PH_END
                if constexpr (DIAG_SORT_LISTS != 0) {
                PH_BEGIN(REP_ATTN, 5)
                    attn_sort_phase(WSP(int, WS_ACNT) + (l - NA) * (NB * NH * NBLK), WSP(unsigned, WS_ALIST), lds, wg, G, tid);
                PH_END
                }
                PH_BEGIN(REP_ATTN, 5)
                    attn_sel_phase(WSP(bf16_t, WS_U), WSP(bf16_t, WS_K), WSP(bf16_t, WS_VT), WSP(int, WS_ACNT) + (l - NA) * (NB * NH * NBLK), WSP(unsigned, WS_ALIST), WSP(bf16_t, WS_APO), WSP(float, WS_APML), WSP(unsigned, WS_CTL) + 2048, lds, wg, G, tid, wave, lane);
                PH_END
                PH_BEGIN(REP_ATTN, 5)
                    attn_own_phase(WSP(bf16_t, WS_U), WSP(bf16_t, WS_K), WSP(bf16_t, WS_VT), WSP(int, WS_ASEL), WSP(bf16_t, WS_APO), WSP(float, WS_APML), WSP(bf16_t, WS_U2), WSP(unsigned, WS_CTL) + 2048, lds, wg, G, tid, wave, lane);
                PH_END
            } else {
            PH_BEGIN(REP_ATTN, 5)
                attn_phase(WSP(bf16_t, WS_U), WSP(bf16_t, WS_K), WSP(bf16_t, WS_VT), WSP(float, WS_KMEAN), WSP(float, WS_KABS), WSP(bf16_t, WS_U2), lds, wg, G, tid, wave, lane);
            PH_END
            }
        }
        PH_BEGIN(REP_X3, 6)
            constexpr bool F8 = (L < NA) ? (FP8_CONV != 0) : (FP8_ATTN != 0); constexpr int EB = F8 ? 1 : 2;
            const bf16_t* Bt = (l < NA) ? (const bf16_t*)(ws + W_CO + (size_t)l * D * D * EB) : (const bf16_t*)(ws + W_O + (size_t)(l - NA) * D * D * EB);
            const float* mixbias = (l < NA) ? args.in[13] + l * D : nullptr;
            pg8::Gemm g{WSP(bf16_t, WS_U2), Bt, T, D, D * EB / 2}; pg8::StaticOrder So; So.init(T, D, G, wg);
            pg8::EpiResid<(L == 0)> E{XIN, WSP(bf16_t, WS_Y), MLP + 2 * D, 6 * D, mixbias, ALPHA, F8 ? 1.0f / (S8_U * S8_WO) : 1.0f};
            pg8::gemm_phase<pg8::EpiResid<(L == 0)>, pg8::StaticOrder, true, true, F8>(lds, g, So, E);
        PH_END
        PH_BEGIN(REP_ROW, 1)
            RowArgs A{}; A.oscale = 1.0f; A.mode = 1; A.y = WSP(bf16_t, WS_Y); A.lng = args.in[4] + (l * 2) * D; A.lnb = args.in[5] + (l * 2) * D; A.x_out = X1P;
            A.sh = MLP + 3 * D; A.sc = MLP + 4 * D; A.mstride = 6 * D;
            if (((l & 1) && FP8_MOE) || (!(l & 1) && FP8_FFN)) A.h8_out = WSP(unsigned char, WS_HBF); else A.h_out = WSP(bf16_t, WS_HBF);
            if (l & 1) { A.rw = args.in[21] + (size_t)(l >> 1) * D * NE; A.rb = args.in[22] + (l >> 1) * NE; A.tok_e = WSP(int, WS_ROUTE + RT_TOKE); A.tok_w = WSP(float, WS_ROUTE + RT_TOKW); A.cntwg = WSP(int, WS_ROUTE + RT_CNTWG); }
            row_phase<((L & 1) ? 2 : 4)>(A, lds, wg, tid, wave, lane);
        PH_END
        if ((l & 1) == 0) {
            PH_BEGIN(REP_F1, 7)
                constexpr bool F8 = FP8_FFN != 0; constexpr int EB = F8 ? 1 : 2;
                pg8::Gemm g{WSP(bf16_t, WS_HBF), (const bf16_t*)(ws + W_F13 + (size_t)(l >> 1) * 2 * DFF * D * EB), T, 2 * DFF, D * EB / 2}; pg8::StaticOrder So; So.init(T, 2 * DFF, G, wg);
                pg8::EpiGated<1, 0, F8> E{WSP(bf16_t, WS_HM), DFF, nullptr, 0, F8 ? 1.0f / (S8_H * S8_W13) : 1.0f, S8_HM};
                pg8::gemm_phase<pg8::EpiGated<1, 0, F8>, pg8::StaticOrder, true, true, F8>(lds, g, So, E);
                if (L == 0) tail_convert(args, ws, M1A7, 8 * CG7_PER, M1A8, 8 * CG8_PER, ((T / 256) * (2 * DFF / 256)) % GRID, lds, wg, G, wave, lane);
                else        tail_convert(args, ws, M3A7, 16 * CG7_PER, M3A8, 16 * CG8_PER, ((T / 256) * (2 * DFF / 256)) % GRID, lds, wg, G, wave, lane);
            PH_END
            PH_BEGIN(REP_F2, 8)
                constexpr bool F8 = FP8_FFN != 0; constexpr int EB = F8 ? 1 : 2;
                pg8::Gemm g{WSP(bf16_t, WS_HM), (const bf16_t*)(ws + W_F2 + (size_t)(l >> 1) * D * DFF * EB), T, D, DFF * EB / 2}; pg8::StaticOrder So; So.init(T, D, G, wg);
                pg8::EpiResid<false> E{X1P, WSP(bf16_t, WS_Y), MLP + 5 * D, 6 * D, nullptr, ALPHA, F8 ? 1.0f / (S8_HM * S8_W2) : 1.0f};
                pg8::gemm_phase<pg8::EpiResid<false>, pg8::StaticOrder, true, true, F8>(lds, g, So, E);
            PH_END
        } else {
            PH_BEGIN(REP_E0, 9)
                moe_assign(WSP(int, WS_ROUTE + RT_CNTWG), WSP(int, WS_ROUTE + RT_TOKE), WSP(float, WS_ROUTE + RT_TOKW), WSP(int, WS_ROUTE + RT_RINFO), WSP(float, WS_ROUTE + RT_RW), WSP(int, WS_ROUTE + RT_META),
                           WSP(unsigned char, WS_HBF), WSP(unsigned char, WS_HPERM), FP8_MOE ? 1024 : 2048, lds, wg, tid, wave, lane);
            PH_END
            PH_BEGIN(REP_E1, 10)
                const int* meta = WSP(int, WS_ROUTE + RT_META); const int NT = __builtin_amdgcn_readfirstlane(meta[9]);
                constexpr bool F8 = FP8_MOE != 0; constexpr int EB = F8 ? 1 : 2;
                pg8::Gemm g{WSP(bf16_t, WS_HPERM), (const bf16_t*)(ws + W_M13 + (size_t)(l >> 1) * NE * 2 * DFE * D * EB), NT * 256, 2 * DFE, D * EB / 2}; pg8::MoeOrder So; So.init(NT, 2 * DFE / 256, G, wg, meta + 16);
                pg8::EpiGated<1, 28, F8> E{WSP(bf16_t, WS_HM), DFE, nullptr, 0, F8 ? 1.0f / (S8_H * S8_W13) : 1.0f, S8_HM};
                pg8::gemm_phase<pg8::EpiGated<1, 28, F8>, pg8::MoeOrder, true, true, F8>(lds, g, So, E);
            PH_END
            PH_BEGIN(REP_E2, 11)
                const int* meta = WSP(int, WS_ROUTE + RT_META); const int NT = __builtin_amdgcn_readfirstlane(meta[9]);
                constexpr bool F8 = FP8_MOE != 0; constexpr int EB = F8 ? 1 : 2;
                pg8::Gemm g{WSP(bf16_t, WS_HM), (const bf16_t*)(ws + W_M2 + (size_t)(l >> 1) * NE * D * DFE * EB), NT * 256, D, DFE * EB / 2}; pg8::MoeOrder So; So.init(NT, D / 256, G, wg, meta + 16);
                pg8::EpiMoeOut E{WSP(bf16_t, WS_MOEO), WSP(int, WS_ROUTE + RT_RINFO), WSP(float, WS_ROUTE + RT_RW), F8 ? 1.0f / (S8_HM * S8_W2) : 1.0f, (size_t)0};
                pg8::gemm_phase<pg8::EpiMoeOut, pg8::MoeOrder, true, true, F8>(lds, g, So, E);
                if (L == 1) tail_convert(args, ws, 8 * CG7_PER, M3A7, 8 * CG8_PER, M3A8, (NT * (D / 256)) % GRID, lds, wg, G, wave, lane);
            PH_END
        }
        PH_BEGIN(REP_ROW, 1)
            RowArgs A{}; A.oscale = 1.0f;
            A.lng = args.in[4] + (l * 2 + 1) * D; A.lnb = args.in[5] + (l * 2 + 1) * D; if (l == DEPTH - 1) A.x_out32 = args.out; else A.x_out = X2P;
            if ((l & 1) == 0) { A.mode = 1; A.y = WSP(bf16_t, WS_Y); } else { A.mode = 2; A.x_in = X1P; A.moeo = WSP(bf16_t, WS_MOEO); A.gate = MLP + 5 * D; A.gstride = 6 * D; }
            if (l + 1 < DEPTH) { const float* mn = MODP + (size_t)(l + 1) * NB * 6 * D; A.sh = mn; A.sc = mn + D; A.mstride = 6 * D;
                if ((l + 1 < NA) ? (FP8_CONV != 0) : (FP8_ATTN != 0)) A.h8_out = WSP(unsigned char, WS_HBF); else A.h_out = WSP(bf16_t, WS_HBF); }
            if (l + 1 == NA) { const float* kvmod = MODP + (size_t)DEPTH * NB * 6 * D; A.kvsh = kvmod; A.kvsc = kvmod + D; if (FP8_ATTN) A.hkv8_out = WSP(unsigned char, WS_HKV); else A.hkv_out = WSP(bf16_t, WS_HKV); }
            row_phase<((L & 1) ? 2 : 4)>(A, lds, wg, tid, wave, lane);
        PH_END
}
#undef MLP
#undef XIN
#undef X1P
#undef X2P
__global__ void __launch_bounds__(NTHR, 2) mega_fwd(Args args) {
    extern __shared__ __attribute__((aligned(16))) unsigned char lds_raw[];
    LAS unsigned char* lds = (LAS unsigned char*)lds_raw;
    const int G = gridDim.x;
    for (int u = threadIdx.x; u < (LDS_BYTES - LDSCTL_OFF) / 4; u += NTHR) ((LAS unsigned*)(lds + LDSCTL_OFF))[u] = 0u;
    __syncthreads();
    XcdBarrier bar = xcd_barrier_post((unsigned*)(args.ws + WS_CTL) + CW_BAR, (volatile LAS unsigned*)(lds + LDSCTL_OFF));
    if (threadIdx.x == 0) { const unsigned xcc = xb_xcc_id() & 7u; const unsigned rank = __hip_atomic_fetch_add((unsigned*)(args.ws + WS_CTL) + CW_VWG + 64 * xcc, 1u, __ATOMIC_RELAXED, __HIP_MEMORY_SCOPE_AGENT);
        if (rank >= 32u) __hip_atomic_store((unsigned*)(args.ws + WS_CTL) + CW_VWG + 64 * 8, 1u, __ATOMIC_RELAXED, __HIP_MEMORY_SCOPE_AGENT);
        ((volatile LAS unsigned*)(lds + LDSCTL_OFF))[4] = xcc + 8u * (rank & 31u); }
    __syncthreads();
    int vwg = blockIdx.x;
    const int lo = args.ph_lo, hi = args.ph_hi;
    int ph = 0; TProbe tp{0ull, 0ull, -1};
    PH_BEGIN(REP_P0, 0)
        LAS float* ca = (LAS float*)lds; LAS float* red = (LAS float*)(lds + 16384);
        for (int i = tid; i < NB * D; i += NTHR) ca[i] = silu_f(args.in[1][i]);
        __syncthreads();
        for (int unit = wg; unit < (DEPTH * 6 * D + 2 * D) / 64; unit += G) mod_unit(unit, args.in[2], args.in[3], args.in[14], args.in[15], MODP, ca, red, wave, lane);
        __syncthreads();
        { LAS unsigned* scr = (LAS unsigned*)(lds + 32768 + wave * 8448); const int gw = wg * NWAVES + wave, ngw = G * NWAVES;
#pragma unroll
          for (int g = 0; g < 7; ++g) { const ConvGroup Gq = conv_group(g); conv_range(args, ws, g, 0, Gq.count * (Gq.K / 64) * (Gq.N / 64), scr, (gw + 37 * g) % ngw, ngw, lane); }
          conv_range(args, ws, 7, 0, M1A7, scr, gw, ngw, lane); conv_range(args, ws, 8, 0, M1A8, scr, (gw + 1024) % ngw, ngw, lane); }
    PH_END
    if (VWG_MODE && lo == 0 && hi > 1) { const unsigned bad_ = __hip_atomic_load((unsigned*)(args.ws + WS_CTL) + CW_VWG + 64 * 8, __ATOMIC_RELAXED, __HIP_MEMORY_SCOPE_AGENT);
        if (!bad_) vwg = __builtin_amdgcn_readfirstlane((int)((volatile LAS unsigned*)(lds + LDSCTL_OFF))[4]); }
    PH_BEGIN(REP_ROW, 1)
        RowArgs A{}; A.oscale = 1.0f; A.mode = 0; A.x_in = args.in[0]; A.sh = MODP; A.sc = MODP + D; A.mstride = 6 * D; if (FP8_CONV) A.h8_out = WSP(unsigned char, WS_HBF); else A.h_out = WSP(bf16_t, WS_HBF);
        row_phase<4>(A, lds, wg, tid, wave, lane);
    PH_END
    layer_phases<0>(args, lds, bar, lo, hi, G, vwg, tp);
    layer_phases<1>(args, lds, bar, lo, hi, G, vwg, tp);
    layer_phases<2>(args, lds, bar, lo, hi, G, vwg, tp);
    layer_phases<3>(args, lds, bar, lo, hi, G, vwg, tp);
}
#undef PH_BEGIN
#undef PH_END
constexpr int N_PHASES = 2 + 7 + 8 + 7 + 8 + (SPARSE_ATTN ? 6 : 0);
__host__ inline int phases_through_sublayer(int s) { const int per[4] = {7, 8, 7 + (SPARSE_ATTN ? 3 + (DIAG_SORT_LISTS ? 1 : 0) : 0), 8 + (SPARSE_ATTN ? 3 + (DIAG_SORT_LISTS ? 1 : 0) : 0)}; const int l = s / 2; int p = 2; for (int i = 0; i < l; ++i) p += per[i]; p += (s & 1) ? per[l] : 4; return p; }
}
extern "C" void kernel_launch(void* const* d_in, const int* in_sizes, int n_in, void* d_out, int out_size, void* d_ws, size_t ws_size, hipStream_t stream) {
    using namespace mk;
    static int grid = 0;
    if (grid == 0) {
        if (n_in != 25 || in_sizes[0] != T * D || out_size != T * D || ws_size < WS_END3) { fprintf(stderr, "kernel_launch: unexpected problem shape / workspace (n_in %d, ws %zu < %zu); nothing launched\n", n_in, ws_size, (size_t)WS_END3); grid = -1; return; }
        int dev = 0, cus = 0, per_cu = 0;
        if (hipGetDevice(&dev) != hipSuccess || hipDeviceGetAttribute(&cus, hipDeviceAttributeMultiprocessorCount, dev) != hipSuccess) { grid = -1; return; }
        if (hipFuncSetAttribute((const void*)mega_fwd, hipFuncAttributeMaxDynamicSharedMemorySize, LDS_BYTES) != hipSuccess) { fprintf(stderr, "kernel_launch: hipFuncSetAttribute failed\n"); grid = -1; return; }
        if (hipOccupancyMaxActiveBlocksPerMultiprocessor(&per_cu, (const void*)mega_fwd, NTHR, LDS_BYTES) != hipSuccess || per_cu < 1) { fprintf(stderr, "kernel_launch: occupancy query says %d blocks per CU\n", per_cu); (void)hipGetLastError(); grid = -1; return; }
        if (cus != GRID) { fprintf(stderr, "kernel_launch: built for a 256-CU device (one workgroup per CU), found %d CUs; nothing launched\n", cus); grid = -1; return; }
        grid = GRID;
    }
    if (grid < 0) return;
    (void)hipMemsetAsync((char*)d_ws + WS_CTL, 0, CTL_ZERO_BYTES, stream);
    Args a{};
    for (int i = 0; i < 25; ++i) a.in[i] = (const float*)d_in[i];
    a.out = (float*)d_out; a.ws = (unsigned char*)d_ws;
    const int P = phases_through_sublayer(HYB_SUB);
#if MK_PER_PHASE
    for (int p = 0; p < P; ++p) { a.ph_lo = p; a.ph_hi = p + 1; hipLaunchKernelGGL(mega_fwd, dim3(grid), dim3(NTHR), LDS_BYTES, stream, a); }
#else
    a.ph_lo = 0; a.ph_hi = P;
    hipLaunchKernelGGL(mega_fwd, dim3(grid), dim3(NTHR), LDS_BYTES, stream, a);
#endif
#if HYB_SUB < 7
    nv::forward(d_in, (float*)d_out, (char*)d_ws + NAIVE_BASE, stream, HYB_SUB + 1, (const float*)((char*)d_ws + WS_X0 + (size_t)HYB_SUB * 64 * MiB), (const float*)((char*)d_ws + WS_X0 + (size_t)3 * 64 * MiB));
#endif
}
```

```cpp
#include <hip/hip_runtime.h>
#include <cstdio>
#include <cstdint>
#ifndef HYB_SUB
#define HYB_SUB 7
#endif
#ifndef MK_PER_PHASE
#define MK_PER_PHASE 0
#endif
namespace pg8 {
#define PG8_LAS __attribute__((address_space(3)))
#define PG8_GAS __attribute__((address_space(1)))
typedef unsigned short bf16_t;
typedef short bf16x8 __attribute__((ext_vector_type(8)));
typedef float f32x4 __attribute__((ext_vector_type(4)));
typedef unsigned u32x4 __attribute__((ext_vector_type(4)));
constexpr int BM = 256, BK = 64, HALF = 128, HTB = HALF * BK * 2  , STAGE_BYTES = 8 * HTB, NXCD = 8, WGM = 8;

__host__ __device__ __forceinline__ int lds_byte(int r, int c) { const int st = (r >> 4) * 2 + (c >> 5), rr = r & 15, cc = c & 31, ob = rr * 64 + cc * 2; return st * 1024 + (ob ^ (((ob >> 9) & 1) << 5)); }
__host__ __device__ __forceinline__ void stage_rc(int b, int& R, int& C) { const int st = b / 1024, sb = b % 1024, swz = sb ^ (((sb >> 9) & 1) << 5); R = (st >> 1) * 16 + swz / 64; C = (st & 1) * 32 + (swz % 64) / 2; }
__host__ __device__ __forceinline__ int perm32(int rho) { const int n = rho >> 4, i = rho & 15; return 8 * (i >> 2) + 4 * n + (i & 3); }

struct Unit { int pm, pn, ko; };
struct Gemm { const bf16_t* A; const bf16_t* Bt; int M, N, K, ld; };

struct StaticOrder {
    int nM, nN, nwg, G, c;
    __host__ __device__ void init(int M, int N, int G_, int c_) { nM = M / BM; nN = N / BM; nwg = nM * nN; G = G_; c = c_; }
    __host__ __device__ bool next(int i, Unit& u) const {
        const long L = (long)i * G + c; if (L >= nwg) return false;
        int wgid = (int)L; { const int q = nwg / NXCD, r = nwg % NXCD, xcd = wgid % NXCD, off = wgid / NXCD; wgid = (xcd < r ? xcd * (q + 1) : r * (q + 1) + (xcd - r) * q) + off; }
        const int nig = WGM * nN, gid = wgid / nig, fm = gid * WGM, gsz = (nM - fm) < WGM ? (nM - fm) : WGM;
        u.pm = fm + ((wgid % nig) % gsz); u.pn = (wgid % nig) / gsz; u.ko = 0; return true;
    }
    __device__ __forceinline__ void a_ready(const Unit&) const {}
    __device__ __forceinline__ void done(const Unit&) const {}
};

__device__ __forceinline__ unsigned cvt_pk_bf16(float lo, float hi) { unsigned r; asm volatile("v_cvt_pk_bf16_f32 %0, %1, %2" : "=v"(r) : "v"(lo), "v"(hi)); return r; }
typedef float f32x2 __attribute__((ext_vector_type(2)));
typedef int i32x4v __attribute__((ext_vector_type(4)));
typedef int i32x8v __attribute__((ext_vector_type(8)));
__device__ __forceinline__ i32x8v cat8(bf16x8 lo, bf16x8 hi) { const i32x4v a = __builtin_bit_cast(i32x4v, lo), b = __builtin_bit_cast(i32x4v, hi); return __builtin_shufflevector(a, b, 0, 1, 2, 3, 4, 5, 6, 7); }
template <class Epi, class Sched, bool ALIGN_EPI = false, bool SP2 = false, bool FP8 = false>
__device__ __forceinline__ void gemm_phase(PG8_LAS unsigned char* lds, const Gemm g, const Sched& S, const Epi& E) {
    int tid_ = threadIdx.x; asm volatile("" : "+v"(tid_));
    const int tid = tid_, wid = __builtin_amdgcn_readfirstlane(tid >> 6), lane = tid & 63, wr = wid >> 2, wc = wid & 3, fr = lane & 15, fq = lane >> 4;
    const int K = g.K, nt = K / BK, LD = g.ld ? g.ld : g.K;
    unsigned voffA[2], voffB[2];
#pragma unroll
    for (int i = 0; i < 2; ++i) { int R, C; stage_rc(tid * 16 + i * 8192, R, C); const int Rb = Epi::PERM ? ((R & ~31) + perm32(R & 31)) : R;
        voffA[i] = (unsigned)(R * LD + C) * 2u; voffB[i] = (unsigned)(Rb * LD + C) * 2u; }
    const size_t kstep = (size_t)(BK * 2);
    const size_t hstep = (size_t)HALF * LD * 2;
    const size_t tstep = 2 * hstep;
    const unsigned ldsw = (unsigned)wid * 1024u;
    const int aoff = lds_byte(wr * 64 + fr, fq * 8), boff = lds_byte(wc * 32 + fr, fq * 8);
    const int aoff8 = lds_byte(wr * 64 + fr, (fq >> 1) * 32 + (fq & 1) * 16), boff8 = lds_byte(wc * 32 + fr, (fq >> 1) * 32 + (fq & 1) * 16);
#define PG8_SA(b, h) (((b) * 2 + (h)) * HTB)
#define PG8_SB(b, h) ((4 + (b) * 2 + (h)) * HTB)
#define PG8_STAGE(bufoff, gbase, voff) do { _Pragma("unroll") for (int _i = 0; _i < 2; ++_i) \
        __builtin_amdgcn_global_load_lds((const unsigned*)((const char*)(gbase) + (voff)[_i]), (PG8_LAS unsigned*)(lds + (bufoff) + ldsw + _i * 8192), 16, 0, 0); } while (0)
#define PG8_LDA(dst, b, h) do { if constexpr (FP8) { _Pragma("unroll") for (int m = 0; m < 4; ++m) dst##8[m] = *(const PG8_LAS i32x8v*)(lds + PG8_SA(b, h) + aoff8 + m * 2048); } else { \
        _Pragma("unroll") for (int m = 0; m < 4; ++m) _Pragma("unroll") for (int k = 0; k < 2; ++k) dst[m][k] = *(const PG8_LAS bf16x8*)(lds + PG8_SA(b, h) + aoff + m * 2048 + k * 1024); } } while (0)
#define PG8_LDB(dst, b, h) do { if constexpr (FP8) { _Pragma("unroll") for (int n = 0; n < 2; ++n) dst##8[n] = *(const PG8_LAS i32x8v*)(lds + PG8_SB(b, h) + boff8 + n * 2048); } else { \
        _Pragma("unroll") for (int n = 0; n < 2; ++n) _Pragma("unroll") for (int k = 0; k < 2; ++k) dst[n][k] = *(const PG8_LAS bf16x8*)(lds + PG8_SB(b, h) + boff + n * 2048 + k * 1024); } } while (0)
#define PG8_MMA(ai, bj, AF, BF) do { __builtin_amdgcn_s_setprio(1); if constexpr (FP8) { \
        _Pragma("unroll") for (int m = 0; m < 4; ++m) _Pragma("unroll") for (int n = 0; n < 2; ++n) \
            asm volatile("v_mfma_f32_16x16x128_f8f6f4 %0, %1, %2, %0" : "+v"(acc[ai][bj][m][n]) : "v"(BF##8[n]), "v"(AF##8[m])); \
        } else { _Pragma("unroll") for (int m = 0; m < 4; ++m) _Pragma("unroll") for (int n = 0; n < 2; ++n) _Pragma("unroll") for (int k = 0; k < 2; ++k) \
        acc[ai][bj][m][n] = __builtin_amdgcn_mfma_f32_16x16x32_bf16(BF[n][k], AF[m][k], acc[ai][bj][m][n], 0, 0, 0); } __builtin_amdgcn_s_setprio(0); } while (0)
#define PG8_WAIT_V(n) asm volatile("s_waitcnt vmcnt(" #n ")" ::: "memory")
#define PG8_WAIT_L(n) asm volatile("s_waitcnt lgkmcnt(" #n ")" ::: "memory")
#define PG8_BAR __builtin_amdgcn_s_barrier()
#define PG8_SCHED __builtin_amdgcn_sched_barrier(0)
    Unit cur, nxt; int ui = 0;
    if (!S.next(0, cur)) return;
    f32x4 acc[2][2][4][2];
#pragma unroll
    for (int a = 0; a < 2; ++a)
#pragma unroll
        for (int b = 0; b < 2; ++b)
#pragma unroll
            for (int m = 0; m < 4; ++m)
#pragma unroll
                for (int n = 0; n < 2; ++n) acc[a][b][m][n] = (f32x4){0.f, 0.f, 0.f, 0.f};
    bf16x8 At[4][2], B0[2][2], B1[2][2]; i32x8v At8[4], B08[2], B18[2];
    const char* cA = (const char*)g.A + (size_t)cur.pm * tstep + cur.ko; const char* cB = (const char*)g.Bt + (size_t)cur.pn * tstep + cur.ko;
    S.a_ready(cur);
    if constexpr (SP2) {
        PG8_STAGE(PG8_SB(0, 0), cB, voffB); PG8_STAGE(PG8_SB(0, 1), cB + hstep, voffB); PG8_STAGE(PG8_SA(0, 0), cA, voffA); PG8_STAGE(PG8_SA(0, 1), cA + hstep, voffA);
        if (wr == 1) PG8_BAR;
        PG8_WAIT_V(2); PG8_BAR;
        PG8_STAGE(PG8_SB(1, 0), cB + kstep, voffB); PG8_STAGE(PG8_SA(1, 0), cA + kstep, voffA); PG8_STAGE(PG8_SB(1, 1), cB + hstep + kstep, voffB);
        PG8_WAIT_V(6); PG8_BAR;
    } else {
        PG8_STAGE(PG8_SB(0, 0), cB, voffB); PG8_STAGE(PG8_SA(0, 0), cA, voffA); PG8_STAGE(PG8_SB(0, 1), cB + hstep, voffB); PG8_STAGE(PG8_SA(0, 1), cA + hstep, voffA);
        if (wr == 1) PG8_BAR;
        PG8_WAIT_V(4); PG8_BAR;
        PG8_STAGE(PG8_SB(1, 0), cB + kstep, voffB); PG8_STAGE(PG8_SA(1, 0), cA + kstep, voffA); PG8_STAGE(PG8_SB(1, 1), cB + hstep + kstep, voffB);
        PG8_WAIT_V(6); PG8_BAR;
    }
    for (;;) {
        const bool has_next = S.next(ui + 1, nxt);
        const char* nA = has_next ? (const char*)g.A + (size_t)nxt.pm * tstep + nxt.ko : cA; const char* nB = has_next ? (const char*)g.Bt + (size_t)nxt.pn * tstep + nxt.ko : cB;
        for (int t = 0; t < nt; t += 2) {
            const bool last = (t == nt - 2);
            const char* a1 = cA + (size_t)(t + 1) * kstep;
            const char* a2 = last ? nA : cA + (size_t)(t + 2) * kstep; const char* b2 = last ? nB : cB + (size_t)(t + 2) * kstep;
            const char* a3 = a2 + kstep; const char* b3 = b2 + kstep;
            if (last && has_next) S.a_ready(nxt);
            if constexpr (SP2) {
            PG8_LDB(B0, 0, 0); PG8_LDB(B1, 0, 1); PG8_SCHED; PG8_LDA(At, 0, 0); PG8_STAGE(PG8_SA(1, 1), a1 + hstep, voffA);
            PG8_WAIT_V(8); PG8_WAIT_L(0); PG8_BAR; PG8_MMA(0, 0, At, B0); PG8_MMA(0, 1, At, B1); PG8_BAR; PG8_SCHED;
            PG8_LDA(At, 0, 1); PG8_STAGE(PG8_SB(0, 0), b2, voffB); PG8_STAGE(PG8_SB(0, 1), b2 + hstep, voffB); PG8_STAGE(PG8_SA(0, 0), a2, voffA);
            PG8_WAIT_V(8); PG8_WAIT_L(0); PG8_BAR; PG8_MMA(1, 0, At, B0); PG8_MMA(1, 1, At, B1); PG8_BAR; PG8_SCHED;
            PG8_LDB(B0, 1, 0); PG8_LDB(B1, 1, 1); PG8_SCHED; PG8_LDA(At, 1, 0); PG8_STAGE(PG8_SA(0, 1), a2 + hstep, voffA);
            PG8_WAIT_V(8); PG8_WAIT_L(0); PG8_BAR; PG8_MMA(0, 0, At, B0); PG8_MMA(0, 1, At, B1); PG8_BAR; PG8_SCHED;
            PG8_LDA(At, 1, 1); PG8_STAGE(PG8_SB(1, 0), b3, voffB); PG8_STAGE(PG8_SB(1, 1), b3 + hstep, voffB); PG8_STAGE(PG8_SA(1, 0), a3, voffA);
            PG8_WAIT_V(8); PG8_WAIT_L(0); PG8_BAR; PG8_MMA(1, 0, At, B0); PG8_MMA(1, 1, At, B1); PG8_BAR; PG8_SCHED;
            } else {
            PG8_LDB(B0, 0, 0); PG8_SCHED; PG8_LDA(At, 0, 0); PG8_STAGE(PG8_SA(1, 1), a1 + hstep, voffA);
            PG8_WAIT_L(8); PG8_BAR; PG8_WAIT_L(0); PG8_MMA(0, 0, At, B0); PG8_BAR; PG8_SCHED;
            PG8_LDB(B1, 0, 1); PG8_STAGE(PG8_SB(0, 0), b2, voffB);
            PG8_BAR; PG8_WAIT_L(0); PG8_MMA(0, 1, At, B1); PG8_BAR;
            PG8_LDA(At, 0, 1); PG8_STAGE(PG8_SA(0, 0), a2, voffA);
            PG8_BAR; PG8_WAIT_L(0); PG8_MMA(1, 0, At, B0); PG8_BAR; PG8_SCHED;
            PG8_STAGE(PG8_SB(0, 1), b2 + hstep, voffB);
            PG8_WAIT_V(6); PG8_BAR; PG8_MMA(1, 1, At, B1); PG8_BAR;
            PG8_LDB(B0, 1, 0); PG8_SCHED; PG8_LDA(At, 1, 0); PG8_STAGE(PG8_SA(0, 1), a2 + hstep, voffA);
            PG8_WAIT_L(8); PG8_BAR; PG8_WAIT_L(0); PG8_MMA(0, 0, At, B0); PG8_BAR; PG8_SCHED;
            PG8_LDB(B1, 1, 1); PG8_STAGE(PG8_SB(1, 0), b3, voffB);
            PG8_BAR; PG8_WAIT_L(0); PG8_MMA(0, 1, At, B1); PG8_BAR;
            PG8_LDA(At, 1, 1); PG8_STAGE(PG8_SA(1, 0), a3, voffA);
            PG8_BAR; PG8_WAIT_L(0); PG8_MMA(1, 0, At, B0); PG8_BAR; PG8_SCHED;
            PG8_STAGE(PG8_SB(1, 1), b3 + hstep, voffB);
            PG8_WAIT_V(6); PG8_BAR; PG8_MMA(1, 1, At, B1); PG8_BAR;
            }
        }
        if constexpr (FP8) asm volatile("s_nop 15\n\ts_nop 15" ::: "memory");
        if constexpr (ALIGN_EPI) { if (wr == 0) PG8_BAR; }
        if constexpr (!Epi::AFTER_DRAIN) { E(acc, cur, wr, wc, fr, fq); S.done(cur); }
        if (!has_next) break;
#pragma unroll
        for (int a = 0; a < 2; ++a)
#pragma unroll
            for (int b = 0; b < 2; ++b)
#pragma unroll
                for (int m = 0; m < 4; ++m)
#pragma unroll
                    for (int n = 0; n < 2; ++n) acc[a][b][m][n] = (f32x4){0.f, 0.f, 0.f, 0.f};
        cur = nxt; cA = nA; cB = nB; ++ui;
        if constexpr (ALIGN_EPI) { if (wr == 1) PG8_BAR; }
    }
    PG8_WAIT_V(0);
    if constexpr (!ALIGN_EPI) { if (wr == 0) PG8_BAR; }
    PG8_BAR;
    if constexpr (Epi::AFTER_DRAIN) { E.fused(acc, cur, wr, wc, fr, fq, lds, wid, lane); S.done(cur); }
#undef PG8_SA
#undef PG8_SB
#undef PG8_STAGE
#undef PG8_LDA
#undef PG8_LDB
#undef PG8_MMA
#undef PG8_WAIT_V
#undef PG8_WAIT_L
#undef PG8_BAR
#undef PG8_SCHED
}
}
namespace pg8 {
typedef unsigned u32x2 __attribute__((ext_vector_type(2)));
__device__ __forceinline__ float fast_sigmoid(float v) { return __builtin_amdgcn_rcpf(1.0f + __expf(-v)); }
__device__ __forceinline__ unsigned cvt4_fp8(float a, float b, float c, float d) {
    a = __builtin_amdgcn_fmed3f(a, -448.f, 448.f); b = __builtin_amdgcn_fmed3f(b, -448.f, 448.f); c = __builtin_amdgcn_fmed3f(c, -448.f, 448.f); d = __builtin_amdgcn_fmed3f(d, -448.f, 448.f);
    int r = __builtin_amdgcn_cvt_pk_fp8_f32(a, b, 0, false); r = __builtin_amdgcn_cvt_pk_fp8_f32(c, d, r, true); return (unsigned)r; }

template <int MODE, int NCT, bool OUT8 = false> struct EpiGated {
    static constexpr bool PERM = true, AFTER_DRAIN = false;
    bf16_t* O; int ldc; const float* bias; int goff; float sin, sout;
    __device__ __forceinline__ void operator()(const f32x4 (&acc)[2][2][4][2], const Unit& u, int wr, int wc, int fr, int fq) const {
        const int ct = NCT ? (u.pn % (NCT ? NCT : 1)) : u.pn;
        const int row0 = u.pm * BM + wr * 64 + fr, col0 = ct * HALF + wc * 32 + 8 * fq;
        f32x4 ba[2], bg[2];
#pragma unroll
        for (int n = 0; n < 2; ++n) { ba[n] = MODE == 0 ? *(const PG8_GAS f32x4*)(bias + col0 + 4 * n) : (f32x4){0.f, 0.f, 0.f, 0.f}; bg[n] = MODE == 0 ? *(const PG8_GAS f32x4*)(bias + goff + col0 + 4 * n) : (f32x4){0.f, 0.f, 0.f, 0.f}; }
#pragma unroll
        for (int ai = 0; ai < 2; ++ai)
#pragma unroll
            for (int m = 0; m < 4; ++m) {
                f32x4 o[2];
#pragma unroll
                for (int n = 0; n < 2; ++n) { const f32x4 a = acc[ai][0][m][n] * sin + ba[n], g = acc[ai][1][m][n] * sin + bg[n];
#pragma unroll
                    for (int e = 0; e < 4; ++e) o[n][e] = MODE == 0 ? a[e] * fast_sigmoid(g[e]) : a[e] * fast_sigmoid(a[e]) * g[e]; }
                if constexpr (OUT8) { u32x2 w; w.x = cvt4_fp8(o[0][0] * sout, o[0][1] * sout, o[0][2] * sout, o[0][3] * sout); w.y = cvt4_fp8(o[1][0] * sout, o[1][1] * sout, o[1][2] * sout, o[1][3] * sout);
                    *(PG8_GAS u32x2*)((unsigned char*)O + (size_t)(row0 + ai * HALF + m * 16) * ldc + col0) = w; }
                else { bf16_t* rowp = O + (size_t)(row0 + ai * HALF + m * 16) * ldc + col0;
                    u32x4 w; w.x = cvt_pk_bf16(o[0][0], o[0][1]); w.y = cvt_pk_bf16(o[0][2], o[0][3]); w.z = cvt_pk_bf16(o[1][0], o[1][1]); w.w = cvt_pk_bf16(o[1][2], o[1][3]);
                    *(PG8_GAS u32x4*)rowp = w; }
            }
    }
};

struct EpiBf16S {
    static constexpr bool PERM = true, AFTER_DRAIN = false;
    bf16_t* O; int ldc; float scale;
    __device__ __forceinline__ void operator()(const f32x4 (&acc)[2][2][4][2], const Unit& u, int wr, int wc, int fr, int fq) const {
        const int row0 = u.pm * BM + wr * 64 + fr, col0 = u.pn * BM + wc * 32 + 8 * fq;
#pragma unroll
        for (int ai = 0; ai < 2; ++ai)
#pragma unroll
            for (int m = 0; m < 4; ++m) { bf16_t* rowp = O + (size_t)(row0 + ai * HALF + m * 16) * ldc + col0;
#pragma unroll
                for (int bj = 0; bj < 2; ++bj) { const f32x4 v0 = acc[ai][bj][m][0] * scale, v1 = acc[ai][bj][m][1] * scale;
                    u32x4 w; w.x = cvt_pk_bf16(v0[0], v0[1]); w.y = cvt_pk_bf16(v0[2], v0[3]); w.z = cvt_pk_bf16(v1[0], v1[1]); w.w = cvt_pk_bf16(v1[2], v1[3]);
                    *(PG8_GAS u32x4*)(rowp + bj * HALF) = w; } }
    }
};

struct EpiK {
    static constexpr bool PERM = true, AFTER_DRAIN = false;
    bf16_t* O; int ldc; float* kmean; unsigned* kabs; float sin;
    __device__ __forceinline__ void operator()(const f32x4 (&acc)[2][2][4][2], const Unit& u, int wr, int wc, int fr, int fq) const {
        const int row0 = u.pm * BM + wr * 64 + fr, col0 = u.pn * BM + wc * 32 + 8 * fq;
        f32x4 cs[2][2];
#pragma unroll
        for (int bj = 0; bj < 2; ++bj)
#pragma unroll
            for (int n = 0; n < 2; ++n) cs[bj][n] = (f32x4){0.f, 0.f, 0.f, 0.f};
#pragma unroll
        for (int ai = 0; ai < 2; ++ai)
#pragma unroll
            for (int m = 0; m < 4; ++m) { bf16_t* rowp = O + (size_t)(row0 + ai * HALF + m * 16) * ldc + col0;
#pragma unroll
                for (int bj = 0; bj < 2; ++bj) { const f32x4 v0 = acc[ai][bj][m][0] * sin, v1 = acc[ai][bj][m][1] * sin; cs[bj][0] += v0; cs[bj][1] += v1;
                    u32x4 w; w.x = cvt_pk_bf16(v0[0], v0[1]); w.y = cvt_pk_bf16(v0[2], v0[3]); w.z = cvt_pk_bf16(v1[0], v1[1]); w.w = cvt_pk_bf16(v1[2], v1[3]);
                    *(PG8_GAS u32x4*)(rowp + bj * HALF) = w; } }
        const int b = u.pm >> 4, nb = u.pm & 15;
#pragma unroll
        for (int bj = 0; bj < 2; ++bj) {
            float mx = 0.f;
#pragma unroll
            for (int ai = 0; ai < 2; ++ai)
#pragma unroll
                for (int m = 0; m < 4; ++m)
#pragma unroll
                    for (int n = 0; n < 2; ++n)
#pragma unroll
                        for (int e = 0; e < 4; ++e) mx = fmaxf(mx, fabsf(acc[ai][bj][m][n][e]) * sin);
#pragma unroll
            for (int o = 32; o >= 1; o >>= 1) mx = fmaxf(mx, __shfl_xor(mx, o));
            if (fr == 0 && fq == 0) atomicMax(kabs + (b * 16 + ((u.pn * BM + bj * HALF + wc * 32) >> 6)) * 16 + nb, __float_as_uint(mx));
        }
#pragma unroll
        for (int bj = 0; bj < 2; ++bj)
#pragma unroll
            for (int n = 0; n < 2; ++n)
#pragma unroll
                for (int e = 0; e < 4; ++e) { float s = cs[bj][n][e];
                    s += __shfl_xor(s, 1); s += __shfl_xor(s, 2); s += __shfl_xor(s, 4); s += __shfl_xor(s, 8);
                    if (fr == 0) { const int c = col0 + bj * HALF + 4 * n + e, h = c >> 6, d = c & 63;
                        atomicAdd(kmean + ((size_t)((b * 16 + h) * 16 + nb) * 64 + d), s * (1.0f / 256.0f)); } }
    }
};

__device__ __forceinline__ float bf_lo(unsigned w) { return __uint_as_float(w << 16); }
__device__ __forceinline__ float bf_hi(unsigned w) { return __uint_as_float(w & 0xffff0000u); }
template <bool XF32> struct EpiResid {
    static constexpr bool PERM = true, AFTER_DRAIN = false;
    const void* x; bf16_t* y; const float* gate; int gstride; const float* bias; float alpha; float sin;
    __device__ __forceinline__ void operator()(const f32x4 (&acc)[2][2][4][2], const Unit& u, int wr, int wc, int fr, int fq) const {
        const int row0 = u.pm * BM + wr * 64 + fr, col0 = u.pn * BM + wc * 32 + 8 * fq, b = u.pm >> 4;
        f32x4 gv[2][2], bv[2][2];
#pragma unroll
        for (int bj = 0; bj < 2; ++bj)
#pragma unroll
            for (int n = 0; n < 2; ++n) { const int c = col0 + bj * HALF + n * 4; gv[bj][n] = *(const PG8_GAS f32x4*)(gate + (size_t)b * gstride + c) + 1.0f;
                bv[bj][n] = bias ? *(const PG8_GAS f32x4*)(bias + c) : (f32x4){0.f, 0.f, 0.f, 0.f}; }
#pragma unroll
        for (int ai = 0; ai < 2; ++ai)
#pragma unroll
            for (int m = 0; m < 4; ++m) { const size_t off = (size_t)(row0 + ai * HALF + m * 16) * 1024 + col0;
#pragma unroll
                for (int bj = 0; bj < 2; ++bj) { f32x4 x0, x1;
                    if constexpr (XF32) { x0 = *(const PG8_GAS f32x4*)((const float*)x + off + bj * HALF); x1 = *(const PG8_GAS f32x4*)((const float*)x + off + bj * HALF + 4); }
                    else { const u32x4 xw = *(const PG8_GAS u32x4*)((const bf16_t*)x + off + bj * HALF); x0 = (f32x4){bf_lo(xw.x), bf_hi(xw.x), bf_lo(xw.y), bf_hi(xw.y)}; x1 = (f32x4){bf_lo(xw.z), bf_hi(xw.z), bf_lo(xw.w), bf_hi(xw.w)}; }
                    const f32x4 o0 = x0 * alpha + gv[bj][0] * (acc[ai][bj][m][0] * sin + bv[bj][0]), o1 = x1 * alpha + gv[bj][1] * (acc[ai][bj][m][1] * sin + bv[bj][1]);
                    u32x4 w; w.x = cvt_pk_bf16(o0[0], o0[1]); w.y = cvt_pk_bf16(o0[2], o0[3]); w.z = cvt_pk_bf16(o1[0], o1[1]); w.w = cvt_pk_bf16(o1[2], o1[3]);
                    *(PG8_GAS u32x4*)(y + off + bj * HALF) = w; } }
    }
};

struct EpiMoeOut {
    static constexpr bool PERM = true, AFTER_DRAIN = false;
    bf16_t* O; const int* rowinfo; const float* roww; float sin; size_t kplane;
    __device__ __forceinline__ void operator()(const f32x4 (&acc)[2][2][4][2], const Unit& u, int wr, int wc, int fr, int fq) const {
        const int row0 = u.pm * BM + wr * 64 + fr, col0 = (u.pn & 3) * BM + wc * 32 + 8 * fq;
#pragma unroll
        for (int ai = 0; ai < 2; ++ai)
#pragma unroll
            for (int m = 0; m < 4; ++m) { const int r = row0 + ai * HALF + m * 16; const int info = ((const PG8_GAS int*)rowinfo)[r]; const float w = ((const PG8_GAS float*)roww)[r] * sin;
                if (info >= 0) { bf16_t* op = O + (u.ko ? kplane : (size_t)0) + (size_t)info * 1024 + col0;
#pragma unroll
                    for (int bj = 0; bj < 2; ++bj) { const f32x4 v0 = acc[ai][bj][m][0] * w, v1 = acc[ai][bj][m][1] * w;
                        u32x4 o; o.x = cvt_pk_bf16(v0[0], v0[1]); o.y = cvt_pk_bf16(v0[2], v0[3]); o.z = cvt_pk_bf16(v1[0], v1[1]); o.w = cvt_pk_bf16(v1[2], v1[3]);
                        *(PG8_GAS u32x4*)(op + bj * HALF) = o; } } }
    }
};

struct MoeOrder {
    StaticOrder so; const int* tile_e; int nct, kbytes;
    __device__ void init(int NT, int nct_, int G, int c, const int* te, int kbytes_ = 0) { so.init(NT * BM, nct_ * (kbytes_ ? 2 : 1) * BM, G, c); tile_e = te; nct = nct_; kbytes = kbytes_; }
    __device__ bool next(int i, Unit& u) const { if (!so.next(i, u)) return false; const int kh = u.pn / nct; u.pn = u.pn % nct + __builtin_amdgcn_readfirstlane(tile_e[u.pm]) * nct; u.ko = kh * kbytes; return true; }
    __device__ __forceinline__ void a_ready(const Unit&) const {}
    __device__ __forceinline__ void done(const Unit&) const {}
};
}
#define GAS __attribute__((address_space(1)))
#define LAS __attribute__((address_space(3)))
#define XB_TMO      128
#define XB_XCNT(j)  (256  + 64 * (j))
#define XB_XSUB(j)  (1280 + 64 * (j))
#define XB_XGEN(j)  (2304 + 64 * (j))
#define XB_TOP      3328
#define XB_TOPGEN   3392
#define XCD_BAR_WORDS 3456
#define XB_SPIN_CAP (1u << 18)

__device__ __forceinline__ unsigned xb_ld(unsigned* p)              { return __hip_atomic_load(p, __ATOMIC_RELAXED, __HIP_MEMORY_SCOPE_AGENT); }
__device__ __forceinline__ unsigned xb_add(unsigned* p, unsigned v) { return __hip_atomic_fetch_add(p, v, __ATOMIC_RELAXED, __HIP_MEMORY_SCOPE_AGENT); }
__device__ __forceinline__ unsigned xb_xcc_id() { return (unsigned)__builtin_amdgcn_s_getreg((3 << 11) | 20) & 0xFu; }
#define XB_SPIN(cond, bar) do { unsigned _sp = 0; while (cond) { __builtin_amdgcn_s_sleep(1); \
    if ((++_sp & 255u) == 0u) { if (xb_ld(&(bar)[XB_TMO])) break; if (_sp > XB_SPIN_CAP) { atomicAdd(&(bar)[XB_TMO], 1u); break; } } } } while (0)

struct XcdBarrier {
    unsigned* bar; unsigned x;
    volatile LAS unsigned* st;
};

__device__ __forceinline__ XcdBarrier xcd_barrier_post(unsigned* bar, volatile LAS unsigned* st) {
    XcdBarrier b; b.bar = bar; b.x = xb_xcc_id(); b.st = st;
    if (threadIdx.x == 0) (void)xb_add(&bar[XB_XCNT(b.x)], 1u);
    return b;
}
__device__ __forceinline__ void xcd_barrier_complete(unsigned* bar, unsigned x, unsigned& nloc, unsigned& nx) {
    const unsigned G = gridDim.x * gridDim.y * gridDim.z;
    unsigned sum, cnt, mine, sp = 0u;
    for (;;) {
        sum = 0u; cnt = 0u; mine = 0u;
#pragma unroll
        for (unsigned j = 0; j < 16; ++j) { const unsigned c = xb_ld(&bar[XB_XCNT(j)]); sum += c; cnt += (c > 0u) ? 1u : 0u; mine = (j == x) ? c : mine; }
        if (sum == G) break;
        __builtin_amdgcn_s_sleep(1);
        if ((++sp & 255u) == 0u) { if (xb_ld(&bar[XB_TMO])) break; if (sp > XB_SPIN_CAP) { atomicAdd(&bar[XB_TMO], 1u); break; } }
    }
    nloc = mine > 0u ? mine : 1u; nx = cnt > 0u ? cnt : 1u;
}

__device__ __forceinline__ void xcd_barrier(const XcdBarrier& b) {
    asm volatile("s_waitcnt vmcnt(0)" ::: "memory");
    __syncthreads();
    if (threadIdx.x == 0) {
        unsigned* bar = b.bar;
        __builtin_amdgcn_s_waitcnt(0);
        unsigned nloc = b.st[0], nx = b.st[1];
        if (nloc == 0u) { xcd_barrier_complete(bar, b.x, nloc, nx); b.st[0] = nloc; b.st[1] = nx; }
        const unsigned old = xb_add(&bar[XB_XSUB(b.x)], 1u);
        const unsigned gen = old / nloc;
        if (old + 1u == (gen + 1u) * nloc) {
            __builtin_amdgcn_fence(__ATOMIC_RELEASE, "agent");
            asm volatile("s_waitcnt vmcnt(0)" ::: "memory");
            const unsigned og = xb_add(&bar[XB_TOP], 1u);
            const unsigned tg = og / nx;
            if (og + 1u == (tg + 1u) * nx) xb_add(&bar[XB_TOPGEN], 1u);
            else XB_SPIN(xb_ld(&bar[XB_TOPGEN]) == tg, bar);
            __builtin_amdgcn_fence(__ATOMIC_ACQUIRE, "agent");
            xb_add(&bar[XB_XGEN(b.x)], 1u);
            asm volatile("s_waitcnt vmcnt(0)" ::: "memory");
        } else {
            XB_SPIN(xb_ld(&bar[XB_XGEN(b.x)]) == gen, bar);
            __builtin_amdgcn_fence(__ATOMIC_ACQUIRE, "agent");
            asm volatile("s_waitcnt vmcnt(0)" ::: "memory");
        }
    }
    __syncthreads();
}

namespace mk {
using pg8::bf16_t;
typedef unsigned v4u __attribute__((ext_vector_type(4)));
typedef unsigned v2u __attribute__((ext_vector_type(2)));
typedef float f32x4 __attribute__((ext_vector_type(4)));
typedef short bf16x8 __attribute__((ext_vector_type(8)));
typedef short s16x4 __attribute__((ext_vector_type(4)));
typedef float f32x16 __attribute__((ext_vector_type(16)));

constexpr int D = 1024, NB = 4, S = 4096, T = NB * S, DEPTH = 4, NA = 2, CONVK = 31, NH = 16, HD = 64, NBLK = 16, DFF = 2816, NE = 8, DFE = 3584;
constexpr int NWAVES = 8, NTHR = NWAVES * 64, GRID = 256;
constexpr float ALPHA = 1.681792830507429f, LN_EPS = 1e-5f;
constexpr float QSCALE = 0.125f * 1.4426950408889634f, LOG2E = 1.4426950408889634f;
#ifndef FP8_MOE
#define FP8_MOE 1
#endif
#ifndef FP8_CONV
#define FP8_CONV 0
#endif
#ifndef FP8_ATTN
#define FP8_ATTN 0
#endif
#ifndef FP8_FFN
#define FP8_FFN 0
#endif
constexpr float S8_H = 16.f, S8_W13 = 256.f, S8_HM = 8.f, S8_W2 = 1024.f, S8_WP = 256.f, S8_WO = 512.f, S8_U = 16.f;
static_assert(FP8_CONV == 0 && FP8_ATTN == 0, "the e4m3 paths of the conv / attention projections were removed");
constexpr int MAXROWS = 2 * T + NE * 256;

constexpr size_t MiB = 1u << 20;
constexpr size_t WS_CTL = 0, CTL_ZERO_BYTES = 2 * MiB;
constexpr int CW_BAR = 4096;
constexpr int CW_VWG = 1024;
#ifndef VWG_MODE
#define VWG_MODE 1
#endif
constexpr size_t WS_KMEAN = 1 * MiB;
constexpr size_t WS_KABS = WS_KMEAN + 512 * 1024;
constexpr size_t WS_MOD = 2 * MiB;
constexpr size_t WS_ROUTE = 3 * MiB;
constexpr size_t RT_TOKE = 0, RT_TOKW = 128 * 1024, RT_RINFO = 256 * 1024, RT_RW = 512 * 1024, RT_CNTWG = 768 * 1024, RT_META = 800 * 1024;
constexpr size_t WS_X0 = 4 * MiB;
constexpr size_t WS_W = 516 * MiB;
constexpr size_t W_CI = WS_W, W_CO = W_CI + 8 * MiB, W_KV = W_CO + 4 * MiB, W_Q = W_KV + 4 * MiB, W_O = W_Q + 4 * MiB, W_F13 = W_O + 4 * MiB, W_F2 = W_F13 + 22 * MiB,
                 W_M13 = W_F2 + 11 * MiB, W_M2 = W_M13 + 224 * MiB, W_END = W_M2 + 112 * MiB;
constexpr size_t WS_Y = W_END, WS_HBF = WS_Y + 64 * MiB, WS_HKV = WS_HBF + 32 * MiB, WS_U = WS_HKV + 32 * MiB, WS_U2 = WS_U + 32 * MiB, WS_K = WS_U2 + 32 * MiB, WS_VT = WS_K + 32 * MiB,
                 WS_HM = WS_VT + 32 * MiB, WS_HPERM = WS_HM + 240 * MiB, WS_MOEO = WS_HPERM + 68 * MiB, WS_END = WS_MOEO + 128 * MiB;
static_assert(W_END == 909 * MiB && WS_END == 1601 * MiB, "d_ws map");
constexpr size_t WS_ALIST = WS_END, WS_APO = WS_ALIST + 16 * MiB, WS_APML = WS_APO + 96 * MiB, WS_ASEL = WS_APML + 6 * MiB, WS_END2 = WS_ASEL + 1 * MiB;
constexpr size_t WS_ACNT = WS_KMEAN + 768 * 1024;
constexpr size_t WS_ATAKE = WS_END2, WS_AGCNT = WS_ATAKE + 1 * MiB, WS_END3 = WS_AGCNT + 1 * MiB;
#ifndef DIAG_SORT_LISTS
#define DIAG_SORT_LISTS 0
#endif
#ifndef DIAG_CHECK_LISTS
#define DIAG_CHECK_LISTS 0
#endif
#ifndef DIAG_FIXED_LISTS
#define DIAG_FIXED_LISTS 0
#endif
#ifndef SPARSE_ATTN
#define SPARSE_ATTN 0
#endif
static_assert((size_t)MAXROWS * DFE * 2 <= 240 * MiB && (size_t)MAXROWS * D * 2 <= 68 * MiB, "MoE buffers");
constexpr size_t NAIVE_BASE = 516 * MiB;

constexpr int RING_BYTES = 131072, LDSCTL_OFF = RING_BYTES, LDS_BYTES = 147456;

#define RLX_AGENT __ATOMIC_RELAXED, __HIP_MEMORY_SCOPE_AGENT
#define ST_WT(p, v) __hip_atomic_store((__attribute__((address_space(1))) __typeof__(*(p))*)(p), (v), __ATOMIC_RELAXED, __HIP_MEMORY_SCOPE_AGENT)
__device__ __forceinline__ float bf2f(unsigned short h) { return __uint_as_float((unsigned)h << 16); }
__device__ __forceinline__ float bflo(unsigned w) { return __uint_as_float(w << 16); }
__device__ __forceinline__ float bfhi(unsigned w) { return __uint_as_float(w & 0xffff0000u); }
__device__ __forceinline__ unsigned pk2(float lo, float hi) { return pg8::cvt_pk_bf16(lo, hi); }
__device__ __forceinline__ float wave_sum(float v) {
#pragma unroll
    for (int o = 1; o < 64; o <<= 1) v += __shfl_xor(v, o);
    return v;
}
__device__ __forceinline__ float silu_f(float v) { return v * __builtin_amdgcn_rcpf(1.0f + __expf(-v)); }

struct Args { const float* in[25]; float* out; unsigned char* ws; int ph_lo, ph_hi; };

__device__ __forceinline__ void mod_unit(int unit, const float* ada_w, const float* ada_b, const float* kv_ada_w, const float* kv_ada_b, float* mod, LAS float* ca, LAS float* red, int wave, int lane) {
    const int col = unit * 64 + lane, NMAIN = DEPTH * 6 * D;
    const float* w; int ldw; float bias; float* outp; int ostride;
    if (col < NMAIN) { const int l = col / (6 * D), j = col % (6 * D); w = ada_w + (size_t)l * D * 6 * D + j; ldw = 6 * D; bias = ada_b[l * 6 * D + j]; outp = mod + (size_t)l * NB * 6 * D + j; ostride = 6 * D; }
    else { const int j = col - NMAIN; w = kv_ada_w + j; ldw = 2 * D; bias = kv_ada_b[j]; outp = mod + (size_t)DEPTH * NB * 6 * D + j; ostride = 2 * D; }
    float a0 = 0.f, a1 = 0.f, a2 = 0.f, a3 = 0.f;
    const int k0 = wave * 128;
#pragma unroll 32
    for (int k = k0; k < k0 + 128; ++k) { const float wv = ((const GAS float*)w)[(size_t)k * ldw]; a0 += ca[k] * wv; a1 += ca[D + k] * wv; a2 += ca[2 * D + k] * wv; a3 += ca[3 * D + k] * wv; }
    red[(wave * 4 + 0) * 64 + lane] = a0; red[(wave * 4 + 1) * 64 + lane] = a1; red[(wave * 4 + 2) * 64 + lane] = a2; red[(wave * 4 + 3) * 64 + lane] = a3;
    __syncthreads();
    if (wave < 4) { float s = 0.f;
#pragma unroll
        for (int q = 0; q < 8; ++q) s += red[(q * 4 + wave) * 64 + lane];
        ((GAS float*)outp)[(size_t)wave * ostride] = s + bias; }
    __syncthreads();
}

struct ItemRegs { f32x4 v[16]; };
__device__ __forceinline__ void conv_load(ItemRegs& r, const float* W, int K, int N, int item, int lane) {
    const int nblk = N / 64, kb = item / nblk, nb = item % nblk, k0 = 64 * kb, n0 = 64 * nb; (void)K;
    const int kr = lane >> 4, nc = (lane & 15) * 4;
#pragma unroll
    for (int p = 0; p < 8; ++p) { const float* wp = W + (size_t)(k0 + 8 * p + 2 * kr) * N + n0 + nc; r.v[2 * p] = *(const GAS f32x4*)wp; r.v[2 * p + 1] = *(const GAS f32x4*)(wp + N); }
}
__device__ __forceinline__ void conv_store(const ItemRegs& r, int K, int N, int gateF, bf16_t* WT, int item, LAS unsigned* scr, int lane) {
    const int nblk = N / 64, kb = item / nblk, nb = item % nblk, k0 = 64 * kb, n0 = 64 * nb;
    const int kr = lane >> 4, nc = (lane & 15) * 4;
#pragma unroll
    for (int p = 0; p < 8; ++p)
#pragma unroll
        for (int j = 0; j < 4; ++j) scr[(nc + j) * 33 + 4 * p + kr] = pk2(r.v[2 * p][j], r.v[2 * p + 1][j]);
    asm volatile("s_waitcnt lgkmcnt(0)" ::: "memory");
    int drow0;
    if (gateF) { const int half = n0 / gateF, jj = n0 % gateF; drow0 = (jj / 128) * 256 + half * 128 + (jj % 128); } else drow0 = n0;
    const int c = lane & 7;
#pragma unroll
    for (int jj = 0; jj < 8; ++jj) { const int n = (lane >> 3) + 8 * jj; const LAS unsigned* sp = scr + n * 33 + 4 * c;
        v4u o; o.x = sp[0]; o.y = sp[1]; o.z = sp[2]; o.w = sp[3];
        *(GAS v4u*)(WT + (size_t)(drow0 + n) * K + k0 + 8 * c) = o; }
    asm volatile("s_waitcnt lgkmcnt(0)" ::: "memory");
}
__device__ __forceinline__ void conv_load8(ItemRegs& r, const float* W, int K, int N, int item, int lane) {
    const int nblk = N / 64, kb = item / nblk, nb = item % nblk, k0 = 64 * kb, n0 = 64 * nb; (void)K;
    const int kr = lane >> 4, nc = (lane & 15) * 4;
#pragma unroll
    for (int p = 0; p < 4; ++p) { const float* wp = W + (size_t)(k0 + 16 * p + 4 * kr) * N + n0 + nc;
        r.v[4 * p] = *(const GAS f32x4*)wp; r.v[4 * p + 1] = *(const GAS f32x4*)(wp + N); r.v[4 * p + 2] = *(const GAS f32x4*)(wp + 2 * (size_t)N); r.v[4 * p + 3] = *(const GAS f32x4*)(wp + 3 * (size_t)N); }
}
__device__ __forceinline__ void conv_store8(const ItemRegs& r, int K, int N, int gateF, unsigned char* WT, int item, float scale, LAS unsigned* scr, int lane) {
    const int nblk = N / 64, kb = item / nblk, nb = item % nblk, k0 = 64 * kb, n0 = 64 * nb;
    const int kr = lane >> 4, nc = (lane & 15) * 4;
#pragma unroll
    for (int p = 0; p < 4; ++p)
#pragma unroll
        for (int j = 0; j < 4; ++j) scr[(nc + j) * 17 + 4 * p + kr] = pg8::cvt4_fp8(r.v[4 * p][j] * scale, r.v[4 * p + 1][j] * scale, r.v[4 * p + 2][j] * scale, r.v[4 * p + 3][j] * scale);
    asm volatile("s_waitcnt lgkmcnt(0)" ::: "memory");
    int drow0;
    if (gateF) { const int half = n0 / gateF, jj = n0 % gateF; drow0 = (jj / 128) * 256 + half * 128 + (jj % 128); } else drow0 = n0;
    const int c = lane & 3;
#pragma unroll
    for (int jj = 0; jj < 4; ++jj) { const int n = (lane >> 2) + 16 * jj; const LAS unsigned* sp = scr + n * 17 + 4 * c;
        v4u o; o.x = sp[0]; o.y = sp[1]; o.z = sp[2]; o.w = sp[3];
        *(GAS v4u*)(WT + (size_t)(drow0 + n) * K + k0 + 16 * c) = o; }
    asm volatile("s_waitcnt lgkmcnt(0)" ::: "memory");
}
struct ConvGroup { int src; int count, K, N, gateF; size_t dst; float s8; };
__device__ __forceinline__ ConvGroup conv_group(int g) {
    switch (g) {
        case 0: return {6, 2, D, 2 * D, D, W_CI, FP8_CONV ? S8_WP : 0.f};      case 1: return {12, 2, D, D, 0, W_CO, FP8_CONV ? S8_WO : 0.f};   case 2: return {16, 1, D, 2 * D, 0, W_KV, FP8_ATTN ? S8_WP : 0.f};
        case 3: return {17, 2, D, D, 0, W_Q, FP8_ATTN ? S8_WP : 0.f};          case 4: return {18, 2, D, D, 0, W_O, FP8_ATTN ? S8_WO : 0.f};
        case 5: return {19, 2, D, 2 * DFF, DFF, W_F13, FP8_FFN ? S8_W13 : 0.f};   case 6: return {20, 2, DFF, D, 0, W_F2, FP8_FFN ? S8_W2 : 0.f};
        case 7: return {23, 16, D, 2 * DFE, DFE, W_M13, FP8_MOE ? S8_W13 : 0.f};  default: return {24, 16, DFE, D, 0, W_M2, FP8_MOE ? S8_W2 : 0.f};
    }
}
constexpr int CG7_PER = (D / 64) * (2 * DFE / 64), CG8_PER = (DFE / 64) * (D / 64);
__device__ __forceinline__ void conv_range(const Args& a, unsigned char* ws, int g, int i0, int i1, LAS unsigned* scr, int gw, int ngw, int lane) {
    const ConvGroup G = conv_group(g);
    const int per = (G.K / 64) * (G.N / 64), eb = G.s8 > 0.f ? 1 : 2;
    const float* W0 = a.in[G.src]; unsigned char* WT0 = ws + G.dst; const size_t msz = (size_t)G.K * G.N;
#define CV_LOAD(R, i) do { const int m_ = (i) / per, it_ = (i) % per; if (G.s8 > 0.f) conv_load8(R, W0 + m_ * msz, G.K, G.N, it_, lane); else conv_load(R, W0 + m_ * msz, G.K, G.N, it_, lane); } while (0)
#define CV_STORE(R, i) do { const int m_ = (i) / per, it_ = (i) % per; if (G.s8 > 0.f) conv_store8(R, G.K, G.N, G.gateF, WT0 + m_ * msz * eb, it_, G.s8, scr, lane); \
        else conv_store(R, G.K, G.N, G.gateF, (bf16_t*)(WT0 + m_ * msz * eb), it_, scr, lane); } while (0)
    ItemRegs ra, rb;
    int i = i0 + gw;
    if (i < i1) CV_LOAD(ra, i);
    while (i < i1) {
        const int i2 = i + ngw; if (i2 < i1) CV_LOAD(rb, i2);
        CV_STORE(ra, i);
        if (i2 >= i1) break;
        const int i3 = i2 + ngw; if (i3 < i1) CV_LOAD(ra, i3);
        CV_STORE(rb, i2);
        i = i3;
    }
#undef CV_LOAD
#undef CV_STORE
}
#ifndef MOE1_IN_P0_PCT
#define MOE1_IN_P0_PCT 100
#endif
#ifndef MOE3_IN_E2_PCT
#define MOE3_IN_E2_PCT 100
#endif
constexpr int M1A7 = (8 * CG7_PER * MOE1_IN_P0_PCT / 100) & ~63, M1A8 = (8 * CG8_PER * MOE1_IN_P0_PCT / 100) & ~63;
constexpr int M3A7 = 8 * CG7_PER + ((8 * CG7_PER * MOE3_IN_E2_PCT / 100) & ~63), M3A8 = 8 * CG8_PER + ((8 * CG8_PER * MOE3_IN_E2_PCT / 100) & ~63);
__device__ __forceinline__ void tail_convert(const Args& a, unsigned char* ws, int g7lo, int g7hi, int g8lo, int g8hi, int rem, LAS unsigned char* lds, int wg, int G, int wave, int lane) {
    const int first = (rem > 0 && rem < G) ? rem : 0;
    if (wg < first) return;
    LAS unsigned* scr = (LAS unsigned*)(lds + 32768 + wave * 8448);
    const int gw = (wg - first) * NWAVES + wave, ngw = (G - first) * NWAVES;
    conv_range(a, ws, 7, g7lo, g7hi, scr, gw, ngw, lane);
    conv_range(a, ws, 8, g8lo, g8hi, scr, gw, ngw, lane);
}

struct RowArgs {
    int mode;
    const void* x_in; const bf16_t* y; const bf16_t* moeo; const float* gate; int gstride;
    float oscale;
    const float* lng; const float* lnb; bf16_t* x_out; float* x_out32;
    const float* sh; const float* sc; int mstride; bf16_t* h_out;
    unsigned char* h8_out;
    const float* kvsh; const float* kvsc; bf16_t* hkv_out; unsigned char* hkv8_out;
    const float* rw; const float* rb; int* tok_e; float* tok_w; int* cntwg;
};
__device__ __forceinline__ void unpack8(const v4u w, f32x4& lo, f32x4& hi) { lo = (f32x4){bflo(w.x), bfhi(w.x), bflo(w.y), bfhi(w.y)}; hi = (f32x4){bflo(w.z), bfhi(w.z), bflo(w.w), bfhi(w.w)}; }
__device__ __forceinline__ v4u pack8(const f32x4 lo, const f32x4 hi) { v4u w; w.x = pk2(lo[0], lo[1]); w.y = pk2(lo[2], lo[3]); w.z = pk2(hi[0], hi[1]); w.w = pk2(hi[2], hi[3]); return w; }
template <int RB  >
__device__ __forceinline__ void row_phase(const RowArgs& A, LAS unsigned char* lds, int wg, int tid, int wave, int lane) {
    LAS float* rwT = (LAS float*)lds;
    LAS int* lcnt = (LAS int*)(lds + 32768);
    const bool route = A.rw != nullptr;
    if (route) {
        for (int i = tid; i < D * NE; i += NTHR) { const int d = i >> 3, e = i & 7; rwT[e * D + d] = ((const GAS float*)A.rw)[i]; }
        if (tid < NE) lcnt[tid] = 0;
        __syncthreads();
    }
    for (int ib = 0; ib < 8 / RB; ++ib) {
      v4u ry[RB][2], rm0[RB][2], rm1[RB][2]; f32x4 rx[RB][2][2];
#pragma unroll
      for (int ii = 0; ii < RB; ++ii) { const int t = wg * 64 + (ib * RB + ii) * 8 + wave;
#pragma unroll
          for (int j = 0; j < 2; ++j) { const int c = 8 * lane + 512 * j;
              if (A.mode == 0) { const GAS f32x4* xp = (const GAS f32x4*)((const float*)A.x_in + (size_t)t * D + c); rx[ii][j][0] = xp[0]; rx[ii][j][1] = xp[1]; }
              else if (A.mode == 1) ry[ii][j] = *(const GAS v4u*)(A.y + (size_t)t * D + c);
              else { ry[ii][j] = *(const GAS v4u*)((const bf16_t*)A.x_in + (size_t)t * D + c); rm0[ii][j] = *(const GAS v4u*)(A.moeo + (size_t)(2 * t) * D + c); rm1[ii][j] = *(const GAS v4u*)(A.moeo + (size_t)(2 * t + 1) * D + c); } } }
#pragma unroll
      for (int ii = 0; ii < RB; ++ii) {
        const int t = wg * 64 + (ib * RB + ii) * 8 + wave, b = t >> 12;
        f32x4 v[2][2];
        if (A.mode == 0) {
#pragma unroll
            for (int j = 0; j < 2; ++j) { v[j][0] = rx[ii][j][0]; v[j][1] = rx[ii][j][1]; }
        } else {
            if (A.mode == 1) {
#pragma unroll
                for (int j = 0; j < 2; ++j) unpack8(ry[ii][j], v[j][0], v[j][1]);
            } else {
#pragma unroll
                for (int j = 0; j < 2; ++j) { const int c = 8 * lane + 512 * j; f32x4 x0, x1, a0, a1, b0, b1;
                    unpack8(ry[ii][j], x0, x1); unpack8(rm0[ii][j], a0, a1); unpack8(rm1[ii][j], b0, b1);
                    const f32x4 g0 = *(const GAS f32x4*)(A.gate + (size_t)b * A.gstride + c), g1 = *(const GAS f32x4*)(A.gate + (size_t)b * A.gstride + c + 4);
                    v[j][0] = x0 * ALPHA + (g0 + 1.0f) * (a0 + b0); v[j][1] = x1 * ALPHA + (g1 + 1.0f) * (a1 + b1); }
            }
            float s = 0.f;
#pragma unroll
            for (int j = 0; j < 2; ++j)
#pragma unroll
                for (int q = 0; q < 2; ++q) s += (v[j][q][0] + v[j][q][1]) + (v[j][q][2] + v[j][q][3]);
            const float mean = wave_sum(s) * (1.0f / D); float qq = 0.f;
#pragma unroll
            for (int j = 0; j < 2; ++j)
#pragma unroll
                for (int q = 0; q < 2; ++q) { v[j][q] = v[j][q] - mean; qq += (v[j][q][0] * v[j][q][0] + v[j][q][1] * v[j][q][1]) + (v[j][q][2] * v[j][q][2] + v[j][q][3] * v[j][q][3]); }
            const float rstd = rsqrtf(wave_sum(qq) * (1.0f / D) + LN_EPS);
#pragma unroll
            for (int j = 0; j < 2; ++j) { const int c = 8 * lane + 512 * j;
#pragma unroll
                for (int q = 0; q < 2; ++q) { const f32x4 g = *(const GAS f32x4*)(A.lng + c + 4 * q), bb = *(const GAS f32x4*)(A.lnb + c + 4 * q); v[j][q] = v[j][q] * rstd * g + bb; }
                if (A.x_out) *(GAS v4u*)(A.x_out + (size_t)t * D + c) = pack8(v[j][0], v[j][1]);
                if (A.x_out32) { GAS f32x4* op = (GAS f32x4*)(A.x_out32 + (size_t)t * D + c); op[0] = v[j][0] * A.oscale; op[1] = v[j][1] * A.oscale; } }
        }
        if (A.hkv_out || A.hkv8_out) {
#pragma unroll
            for (int j = 0; j < 2; ++j) { const int c = 8 * lane + 512 * j; f32x4 h[2];
#pragma unroll
                for (int q = 0; q < 2; ++q) { const f32x4 sc = *(const GAS f32x4*)(A.kvsc + (size_t)b * 2 * D + c + 4 * q), sh = *(const GAS f32x4*)(A.kvsh + (size_t)b * 2 * D + c + 4 * q); h[q] = v[j][q] * (sc + 1.0f) + sh; }
                if (A.hkv_out) *(GAS v4u*)(A.hkv_out + (size_t)t * D + c) = pack8(h[0], h[1]);
                if (A.hkv8_out) { v2u w; w.x = pg8::cvt4_fp8(h[0][0] * S8_H, h[0][1] * S8_H, h[0][2] * S8_H, h[0][3] * S8_H); w.y = pg8::cvt4_fp8(h[1][0] * S8_H, h[1][1] * S8_H, h[1][2] * S8_H, h[1][3] * S8_H);
                    *(GAS v2u*)(A.hkv8_out + (size_t)t * D + c) = w; } }
        }
        if (A.h_out || A.h8_out) {
            float lg[NE];
#pragma unroll
            for (int e = 0; e < NE; ++e) lg[e] = 0.f;
#pragma unroll
            for (int j = 0; j < 2; ++j) { const int c = 8 * lane + 512 * j; f32x4 h[2];
#pragma unroll
                for (int q = 0; q < 2; ++q) { const f32x4 sc = *(const GAS f32x4*)(A.sc + (size_t)b * A.mstride + c + 4 * q), sh = *(const GAS f32x4*)(A.sh + (size_t)b * A.mstride + c + 4 * q); h[q] = v[j][q] * (sc + 1.0f) + sh; }
                if (A.h_out) *(GAS v4u*)(A.h_out + (size_t)t * D + c) = pack8(h[0], h[1]);
                if (A.h8_out) { v2u w; w.x = pg8::cvt4_fp8(h[0][0] * S8_H, h[0][1] * S8_H, h[0][2] * S8_H, h[0][3] * S8_H); w.y = pg8::cvt4_fp8(h[1][0] * S8_H, h[1][1] * S8_H, h[1][2] * S8_H, h[1][3] * S8_H);
                    *(GAS v2u*)(A.h8_out + (size_t)t * D + c) = w; }
                if (route) {
#pragma unroll
                    for (int e = 0; e < NE; ++e)
#pragma unroll
                        for (int q = 0; q < 2; ++q) { const f32x4 r = *(const LAS f32x4*)(rwT + e * D + c + 4 * q); lg[e] += (h[q][0] * r[0] + h[q][1] * r[1]) + (h[q][2] * r[2] + h[q][3] * r[3]); }
                } }
            if (route) {
#pragma unroll
                for (int e = 0; e < NE; ++e) lg[e] = wave_sum(lg[e]) + ((const GAS float*)A.rb)[e];
                int e0 = 0; float v0 = lg[0];
#pragma unroll
                for (int e = 1; e < NE; ++e) if (lg[e] > v0) { v0 = lg[e]; e0 = e; }
                int e1 = -1; float v1 = 0.f;
#pragma unroll
                for (int e = 0; e < NE; ++e) if (e != e0 && (e1 < 0 || lg[e] > v1)) { v1 = lg[e]; e1 = e; }
                if (lane == 0) { const float p1 = __expf(v1 - v0), w0 = 1.0f / (1.0f + p1);
                    ((GAS int*)A.tok_e)[t * 2] = e0; ((GAS int*)A.tok_e)[t * 2 + 1] = e1; ((GAS float*)A.tok_w)[t * 2] = w0; ((GAS float*)A.tok_w)[t * 2 + 1] = p1 * w0;
                    __hip_atomic_fetch_add(lcnt + e0, 1, __ATOMIC_RELAXED, __HIP_MEMORY_SCOPE_WORKGROUP); __hip_atomic_fetch_add(lcnt + e1, 1, __ATOMIC_RELAXED, __HIP_MEMORY_SCOPE_WORKGROUP); }
            }
        }
      }
    }
    if (route) { __syncthreads(); if (tid < NE) ST_WT(A.cntwg + wg * NE + tid, (int)lcnt[tid]); }
    __syncthreads();
}

__device__ __forceinline__ void moe_assign(const int* cntwg, const int* tok_e, const float* tok_w, int* rowinfo, float* roww, int* meta, const unsigned char* hsrc, unsigned char* hperm, const int rowbytes,
                                           LAS unsigned char* lds, int wg, int tid, int wave, int lane) {
    LAS int* arr = (LAS int*)lds;
    LAS int* tot = (LAS int*)(lds + 8192);
    LAS int* mybase = (LAS int*)(lds + 8192 + 64);
    LAS int* earr = (LAS int*)(lds + 8192 + 128);
    LAS int* posarr = (LAS int*)(lds + 8192 + 128 + 512);
    { const v4u c4 = *((const GAS v4u*)cntwg + tid); *((LAS v4u*)arr + tid) = c4; }
    if (tid < 128) earr[tid] = ((const GAS int*)tok_e)[wg * 128 + tid];
    __syncthreads();
    {
        const int e = wave; int s4[4]; int s = 0;
#pragma unroll
        for (int q = 0; q < 4; ++q) { s4[q] = arr[(4 * lane + q) * 8 + e]; s += s4[q]; }
        int inc = s;
#pragma unroll
        for (int o = 1; o < 64; o <<= 1) { const int y = __shfl_up(inc, o); if (lane >= o) inc += y; }
        const int total = __shfl(inc, 63);
        int excl = inc - s;
        const int lc = wg >> 2, qc = wg & 3;
#pragma unroll
        for (int q = 0; q < 4; ++q) if (q < qc) excl += s4[q];
        const int mine = __shfl(excl, lc);
        if (lane == 0) { tot[e] = total; mybase[e] = mine; }
    }
    __syncthreads();
    int off[NE + 1]; { int s = 0;
#pragma unroll
        for (int e = 0; e < NE; ++e) { off[e] = s; s += (tot[e] + 255) & ~255; } off[NE] = s; }
    if (tid < 128) {
        const int e = earr[tid]; int rank = 0;
        for (int j = 0; j < tid; ++j) rank += (earr[j] == e) ? 1 : 0;
        int o = 0;
#pragma unroll
        for (int q = 0; q < NE; ++q) o = (q == e) ? off[q] : o;
        const int pos = o + mybase[e] + rank;
        posarr[tid] = pos; ST_WT(rowinfo + pos, wg * 128 + tid); ST_WT(roww + pos, ((const GAS float*)tok_w)[wg * 128 + tid]);
    }
    __syncthreads();
    for (int it = wave; it < 128; it += NWAVES) {
        const int tok = wg * 64 + (it >> 1), pos = posarr[it];
        const GAS v4u* src = (const GAS v4u*)(hsrc + (size_t)tok * rowbytes); GAS v4u* dst = (GAS v4u*)(hperm + (size_t)pos * rowbytes);
        if (rowbytes == 2048) { const v4u a = src[lane], b = src[lane + 64]; dst[lane] = a; dst[lane + 64] = b; } else { dst[lane] = src[lane]; }
    }
    if (wg == 0) {
#pragma unroll
        for (int e = 0; e < NE; ++e) for (int r = off[e] + tot[e] + tid; r < off[e + 1]; r += NTHR) { ST_WT(rowinfo + r, -1); ST_WT(roww + r, 0.f); }
        const int NT = off[NE] >> 8;
        if (tid <= NE) { int o = 0;
#pragma unroll
            for (int q = 0; q <= NE; ++q) o = (q == tid) ? off[q] : o;
            meta[tid] = o; }
        if (tid == 0) meta[9] = NT;
        for (int tI = tid; tI < NT; tI += NTHR) { int e = 0;
#pragma unroll
            for (int q = 1; q < NE; ++q) if (tI * 256 >= off[q]) e = q;
            meta[16 + tI] = e; }
    }
    __syncthreads();
}

__device__ __forceinline__ void conv_phase(const bf16_t* u, const float* wdw, const float* bdw, const float* gn, const float* bn, bf16_t* u2, LAS unsigned char* lds, int wg, int tid, int wave, int lane) {
    LAS f32x4* wl = (LAS f32x4*)lds;
    for (int i = tid; i < CONVK * D / 4; i += NTHR) wl[i] = *((const GAS f32x4*)wdw + i);
    __syncthreads();
    for (int it = 0; it < 2; ++it) {
        const int tb = wg * 64 + it * 32 + wave * 4;
        const int ts0 = (tb & (S - 1)) - (CONVK - 1);
        const bf16_t* ub = u + (ptrdiff_t)(tb - (CONVK - 1)) * D + 8 * lane;
        f32x4 acc[4][4];
#pragma unroll
        for (int o = 0; o < 4; ++o)
#pragma unroll
            for (int q = 0; q < 4; ++q) acc[o][q] = *(const GAS f32x4*)(bdw + 8 * lane + 512 * (q >> 1) + 4 * (q & 1));
        f32x4 wwin[4][4];
#pragma unroll
        for (int r = 0; r < CONVK + 3; ++r) {
            if (r < CONVK) {
#pragma unroll
                for (int q = 0; q < 4; ++q) wwin[r & 3][q] = wl[r * 256 + 2 * lane + 128 * (q >> 1) + (q & 1)];
            }
            if (ts0 + r >= 0) {
                f32x4 uv[4];
#pragma unroll
                for (int j = 0; j < 2; ++j) unpack8(*(const GAS v4u*)(ub + (ptrdiff_t)r * D + 512 * j), uv[2 * j], uv[2 * j + 1]);
#pragma unroll
                for (int o = 0; o < 4; ++o) { const int k = r - o; if (k >= 0 && k < CONVK) {
#pragma unroll
                        for (int q = 0; q < 4; ++q) acc[o][q] += uv[q] * wwin[k & 3][q]; } }
            }
        }
#pragma unroll
        for (int o = 0; o < 4; ++o) {
            float sm = 0.f;
#pragma unroll
            for (int q = 0; q < 4; ++q) sm += (acc[o][q][0] + acc[o][q][1]) + (acc[o][q][2] + acc[o][q][3]);
            const float mean = wave_sum(sm) * (1.0f / D); float qq = 0.f;
#pragma unroll
            for (int q = 0; q < 4; ++q) { acc[o][q] = acc[o][q] - mean; qq += (acc[o][q][0] * acc[o][q][0] + acc[o][q][1] * acc[o][q][1]) + (acc[o][q][2] * acc[o][q][2] + acc[o][q][3] * acc[o][q][3]); }
            const float rstd = rsqrtf(wave_sum(qq) * (1.0f / D) + LN_EPS);
#pragma unroll
            for (int j = 0; j < 2; ++j) { f32x4 y[2];
#pragma unroll
                for (int hh = 0; hh < 2; ++hh) { const int c = 8 * lane + 512 * j + 4 * hh; const f32x4 v = acc[o][2 * j + hh] * rstd * *(const GAS f32x4*)(gn + c) + *(const GAS f32x4*)(bn + c);
                    y[hh] = (f32x4){silu_f(v[0]), silu_f(v[1]), silu_f(v[2]), silu_f(v[3])}; }
                *(GAS v4u*)(u2 + (size_t)(tb + o) * D + 8 * lane + 512 * j) = pack8(y[0], y[1]); }
        }
    }
    __syncthreads();
}

typedef float f32x2 __attribute__((ext_vector_type(2)));
__device__ __forceinline__ float max3f(float a, float b, float c) { float r; asm("v_max3_f32 %0, %1, %2, %3" : "=v"(r) : "v"(a), "v"(b), "v"(c)); return r; }
constexpr int AT_QM = 4096 + 2 * 64 * 144 + 2 * 64 * 136, AT_KM = 0, AT_K = 4096, AT_KPITCH = 144, AT_KBUF = 64 * AT_KPITCH, AT_V = AT_K + 2 * AT_KBUF, AT_VPITCH = 136, AT_VBUF = 64 * AT_VPITCH;
__device__ __forceinline__ void attn_unit(int b, int h, int qi, const bf16_t* Q, const bf16_t* K, const bf16_t* Vt, const float* kmean, const float* kabs, bf16_t* O, LAS unsigned char* lds, int tid, int wave, int lane) {
    const int r32 = lane & 31, hi = lane >> 5;
    const int q0 = qi * 256;
    if (tid < 256) *((LAS f32x4*)(lds + AT_KM) + tid) = *((const GAS f32x4*)(kmean + (size_t)(b * NH + h) * NBLK * HD) + tid);
    const bf16_t* qrow = Q + (size_t)(b * S + q0 + wave * 32 + r32) * D + h * HD;
    bf16x8 qr[4];
#pragma unroll
    for (int d0 = 0; d0 < 4; ++d0) qr[d0] = *(const GAS bf16x8*)(qrow + d0 * 16 + hi * 8);
    const int srow = tid >> 3, sch = tid & 7;
    const bf16_t* kg = K + (size_t)(b * S + srow) * D + h * HD + sch * 8;
    const bf16_t* vg = Vt + (size_t)(h * HD + srow) * T + b * S + sch * 8;
    const int kst = AT_K + srow * AT_KPITCH + sch * 16, vst = AT_V + srow * AT_VPITCH + sch * 16;
    { float l1 = 0.f;
#pragma unroll
      for (int d0 = 0; d0 < 4; ++d0)
#pragma unroll
          for (int e = 0; e < 8; ++e) l1 += fabsf(bf2f((unsigned short)qr[d0][e]));
      l1 += __shfl_xor(l1, 32);
#pragma unroll
      for (int o = 16; o >= 1; o >>= 1) l1 = fmaxf(l1, __shfl_xor(l1, o));
      if (lane == 0) *((LAS float*)(lds + AT_QM) + wave) = l1; }
    __syncthreads();
    const float slope2 = exp2f(-8.0f * (float)(h + 1) / (float)NH) * LOG2E;
    unsigned livemask = 1u << qi;
    { float qmax = 0.f;
#pragma unroll
      for (int w = 0; w < NWAVES; ++w) qmax = fmaxf(qmax, *((const LAS float*)(lds + AT_QM) + w));
      const GAS float* kab = (const GAS float*)kabs + (b * NH + h) * NBLK; const float kown = kab[qi];
#pragma unroll
      for (int n = 0; n < NBLK; ++n) if (n < qi) { const float bound = qmax * (kab[n] + kown) * 1.02f + 160.0f; if (!(slope2 * (float)(256 * (qi - n) - 255) > bound)) livemask |= 1u << n; }
      livemask = (unsigned)__builtin_amdgcn_readfirstlane((int)livemask); }
    unsigned remn = livemask; int jn = __builtin_ctz(remn), ttn = 0;
    v4u kreg = *(const GAS v4u*)(kg + (size_t)(4 * jn) * 64 * D), vreg = *(const GAS v4u*)(vg + (size_t)(4 * jn) * 64);
    unsigned selmask = 1u << qi;
    {
        float gate[NBLK];
#pragma unroll
        for (int n = 0; n < NBLK; ++n) {
            float s = 0.f;
            if (n < qi) {
#pragma unroll
                for (int d0 = 0; d0 < 4; ++d0) { const LAS f32x4* kmp = (const LAS f32x4*)(lds + AT_KM + (n * HD + d0 * 16 + hi * 8) * 4); const f32x4 k0 = kmp[0], k1 = kmp[1];
                    s += bf2f((unsigned short)qr[d0][0]) * k0[0] + bf2f((unsigned short)qr[d0][1]) * k0[1] + bf2f((unsigned short)qr[d0][2]) * k0[2] + bf2f((unsigned short)qr[d0][3]) * k0[3]
                       + bf2f((unsigned short)qr[d0][4]) * k1[0] + bf2f((unsigned short)qr[d0][5]) * k1[1] + bf2f((unsigned short)qr[d0][6]) * k1[2] + bf2f((unsigned short)qr[d0][7]) * k1[3]; }
                s += __shfl_xor(s, 32);
            }
            gate[n] = s;
        }
#pragma unroll
        for (int r = 0; r < 3; ++r) {
            int best = -1; float bv = 0.f;
#pragma unroll
            for (int n = 0; n < NBLK; ++n) if (n < qi && !((selmask >> n) & 1u)) { if (best < 0 || gate[n] > bv) { best = n; bv = gate[n]; } }
            if (best >= 0) selmask |= 1u << best;
        }
    }
    f32x16 cb0, cb1;
#pragma unroll
    for (int r = 0; r < 16; ++r) { const int kk = (r & 3) + 8 * (r >> 2) + 4 * hi; cb0[r] = slope2 * (float)kk; cb1[r] = slope2 * (float)(kk + 32); }
    f32x16 o0 = {}, o1 = {};
    float m_run = -1.0e30f, l_run = 0.f;
    const int qrel = wave * 32 + r32;
    for (int it = 0;; ++it) {
        const int buf = it & 1;
        const int j = jn, tt = ttn, tl = 4 * jn + ttn;
        *(LAS v4u*)(lds + kst + buf * AT_KBUF) = kreg;
        *(LAS v2u*)(lds + vst + buf * AT_VBUF) = (v2u){vreg.x, vreg.y}; *(LAS v2u*)(lds + vst + buf * AT_VBUF + 8) = (v2u){vreg.z, vreg.w};
        bool more = true;
        if (++ttn == 4) { ttn = 0; remn &= remn - 1; more = remn != 0u; if (more) jn = __builtin_ctz(remn); }
        if (more) { kreg = *(const GAS v4u*)(kg + (size_t)(4 * jn + ttn) * 64 * D); vreg = *(const GAS v4u*)(vg + (size_t)(4 * jn + ttn) * 64); }
        __syncthreads();
        const bool own = (j == qi);
        const bool rowsel = ((selmask >> j) & 1u) != 0u;
        bool skip = own ? (64 * tt > wave * 32 + 31) : (__builtin_amdgcn_ballot_w64(rowsel) == 0ull);
        if (skip) { if (!more) break; continue; }
        const LAS unsigned char* kb = lds + AT_K + buf * AT_KBUF + r32 * AT_KPITCH + hi * 16;
        f32x16 p0 = cb0, p1 = cb1;
#pragma unroll
        for (int d0 = 0; d0 < 4; ++d0) {
            const bf16x8 a0 = *(const LAS bf16x8*)(kb + d0 * 32), a1 = *(const LAS bf16x8*)(kb + 32 * AT_KPITCH + d0 * 32);
            p0 = __builtin_amdgcn_mfma_f32_32x32x16_bf16(a0, qr[d0], p0, 0, 0, 0);
            p1 = __builtin_amdgcn_mfma_f32_32x32x16_bf16(a1, qr[d0], p1, 0, 0, 0);
        }
        if (own) {
#pragma unroll
            for (int r = 0; r < 16; ++r) { const int kk = 64 * tt + (r & 3) + 8 * (r >> 2) + 4 * hi; if (kk > qrel) p0[r] = -INFINITY; if (kk + 32 > qrel) p1[r] = -INFINITY; }
        }
        float tm = max3f(p0[0], p0[1], p1[0]), tm2 = max3f(p0[2], p0[3], p1[1]);
        tm = max3f(tm, p1[2], p1[3]);
#pragma unroll
        for (int r = 4; r < 16; r += 4) { tm = max3f(tm, p0[r], p0[r + 1]); tm2 = max3f(tm2, p0[r + 2], p0[r + 3]); tm = max3f(tm, p1[r], p1[r + 1]); tm2 = max3f(tm2, p1[r + 2], p1[r + 3]); }
        tm = max3f(tm, tm2, __shfl_xor(fmaxf(tm, tm2), 32));
        const float toff = slope2 * (float)(64 * tl - q0 - 255);
        const float mnew = rowsel ? fmaxf(m_run, tm + toff) : m_run;
        const float alpha = __builtin_amdgcn_exp2f(m_run - mnew);
        const float msub = rowsel ? (mnew - toff) : INFINITY;
        m_run = mnew;
        f32x2 ls2 = {0.f, 0.f}; const f32x2 nms = {-msub, -msub};
#pragma unroll
        for (int r = 0; r < 16; r += 2) { const f32x2 a = (f32x2){p0[r], p0[r + 1]} + nms, c = (f32x2){p1[r], p1[r + 1]} + nms;
            p0[r] = __builtin_amdgcn_exp2f(a.x); p0[r + 1] = __builtin_amdgcn_exp2f(a.y); p1[r] = __builtin_amdgcn_exp2f(c.x); p1[r + 1] = __builtin_amdgcn_exp2f(c.y);
            ls2 += (f32x2){p0[r], p0[r + 1]}; ls2 += (f32x2){p1[r], p1[r + 1]}; }
        l_run = l_run * alpha + (ls2.x + ls2.y);
        if (__builtin_amdgcn_ballot_w64(alpha != 1.0f) != 0ull) { o0 = o0 * alpha; o1 = o1 * alpha; }
        bf16x8 pb[4];
#pragma unroll
        for (int s = 0; s < 4; ++s) {
            unsigned w[4];
#pragma unroll
            for (int q = 0; q < 4; ++q) w[q] = (s < 2) ? pk2(p0[8 * (s & 1) + 2 * q], p0[8 * (s & 1) + 2 * q + 1]) : pk2(p1[8 * (s & 1) + 2 * q], p1[8 * (s & 1) + 2 * q + 1]);
            pb[s] = __builtin_bit_cast(bf16x8, (v4u){w[0], w[1], w[2], w[3]});
        }
        const LAS unsigned char* vb = lds + AT_V + buf * AT_VBUF + r32 * AT_VPITCH + hi * 8;
#pragma unroll
        for (int s = 0; s < 4; ++s) {
            const int kk2 = (32 * (s >> 1) + 16 * (s & 1)) * 2;
            const v2u a0l = *(const LAS v2u*)(vb + kk2), a0h = *(const LAS v2u*)(vb + kk2 + 16);
            const v2u a1l = *(const LAS v2u*)(vb + 32 * AT_VPITCH + kk2), a1h = *(const LAS v2u*)(vb + 32 * AT_VPITCH + kk2 + 16);
            const bf16x8 va0 = __builtin_bit_cast(bf16x8, (v4u){a0l.x, a0l.y, a0h.x, a0h.y}), va1 = __builtin_bit_cast(bf16x8, (v4u){a1l.x, a1l.y, a1h.x, a1h.y});
            o0 = __builtin_amdgcn_mfma_f32_32x32x16_bf16(va0, pb[s], o0, 0, 0, 0);
            o1 = __builtin_amdgcn_mfma_f32_32x32x16_bf16(va1, pb[s], o1, 0, 0, 0);
        }
        if (!more) break;
    }
    const float ltot = l_run + __shfl_xor(l_run, 32);
    const float inv = 1.0f / ltot;
    bf16_t* orow = O + (size_t)(b * S + q0 + wave * 32 + r32) * D + h * HD;
#pragma unroll
    for (int g = 0; g < 4; ++g) {
        v2u w0, w1;
        w0.x = pk2(o0[4 * g] * inv, o0[4 * g + 1] * inv); w0.y = pk2(o0[4 * g + 2] * inv, o0[4 * g + 3] * inv);
        w1.x = pk2(o1[4 * g] * inv, o1[4 * g + 1] * inv); w1.y = pk2(o1[4 * g + 2] * inv, o1[4 * g + 3] * inv);
        *(GAS v2u*)(orow + 8 * g + 4 * hi) = w0; *(GAS v2u*)(orow + 32 + 8 * g + 4 * hi) = w1;
    }
    __syncthreads();
}
#define ATS_TILE(KB, VB, RS, TOFF, CAUS) do { \
        const LAS unsigned char* kb_ = (KB) + r32 * AT_KPITCH + hi * 16; f32x16 p0 = cb0, p1 = cb1; \
        _Pragma("unroll") for (int d0 = 0; d0 < 4; ++d0) { const bf16x8 a0_ = *(const LAS bf16x8*)(kb_ + d0 * 32), a1_ = *(const LAS bf16x8*)(kb_ + 32 * AT_KPITCH + d0 * 32); \
            p0 = __builtin_amdgcn_mfma_f32_32x32x16_bf16(a0_, qr[d0], p0, 0, 0, 0); p1 = __builtin_amdgcn_mfma_f32_32x32x16_bf16(a1_, qr[d0], p1, 0, 0, 0); } \
        if ((CAUS) >= 0 && (CAUS) + 63 > wave * 32) { _Pragma("unroll") for (int r = 0; r < 16; ++r) { const int kk = (CAUS) + (r & 3) + 8 * (r >> 2) + 4 * hi; if (kk > qrel) p0[r] = -INFINITY; if (kk + 32 > qrel) p1[r] = -INFINITY; } } \
        float tm = max3f(p0[0], p0[1], p1[0]), tm2 = max3f(p0[2], p0[3], p1[1]); tm = max3f(tm, p1[2], p1[3]); \
        _Pragma("unroll") for (int r = 4; r < 16; r += 4) { tm = max3f(tm, p0[r], p0[r + 1]); tm2 = max3f(tm2, p0[r + 2], p0[r + 3]); tm = max3f(tm, p1[r], p1[r + 1]); tm2 = max3f(tm2, p1[r + 2], p1[r + 3]); } \
        tm = max3f(tm, tm2, __shfl_xor(fmaxf(tm, tm2), 32)); \
        const float toff_ = (TOFF); const bool rs_ = (RS); \
        const float mnew = rs_ ? fmaxf(m_run, tm + toff_) : m_run; const float alpha = __builtin_amdgcn_exp2f(m_run - mnew); const float msub = rs_ ? (mnew - toff_) : INFINITY; m_run = mnew; \
        f32x2 ls2 = {0.f, 0.f}; const f32x2 nms = {-msub, -msub}; \
        _Pragma("unroll") for (int r = 0; r < 16; r += 2) { const f32x2 a = (f32x2){p0[r], p0[r + 1]} + nms, c = (f32x2){p1[r], p1[r + 1]} + nms; \
            p0[r] = __builtin_amdgcn_exp2f(a.x); p0[r + 1] = __builtin_amdgcn_exp2f(a.y); p1[r] = __builtin_amdgcn_exp2f(c.x); p1[r + 1] = __builtin_amdgcn_exp2f(c.y); \
            ls2 += (f32x2){p0[r], p0[r + 1]}; ls2 += (f32x2){p1[r], p1[r + 1]}; } \
        l_run = l_run * alpha + (ls2.x + ls2.y); \
        if (__builtin_amdgcn_ballot_w64(alpha != 1.0f) != 0ull) { o0 = o0 * alpha; o1 = o1 * alpha; } \
        bf16x8 pb[4]; \
        _Pragma("unroll") for (int s4 = 0; s4 < 4; ++s4) { unsigned w[4]; \
            _Pragma("unroll") for (int q = 0; q < 4; ++q) w[q] = (s4 < 2) ? pk2(p0[8 * (s4 & 1) + 2 * q], p0[8 * (s4 & 1) + 2 * q + 1]) : pk2(p1[8 * (s4 & 1) + 2 * q], p1[8 * (s4 & 1) + 2 * q + 1]); \
            pb[s4] = __builtin_bit_cast(bf16x8, (v4u){w[0], w[1], w[2], w[3]}); } \
        const LAS unsigned char* vb_ = (VB) + r32 * AT_VPITCH + hi * 8; \
        _Pragma("unroll") for (int s4 = 0; s4 < 4; ++s4) { const int kk2 = (32 * (s4 >> 1) + 16 * (s4 & 1)) * 2; \
            const v2u a0l = *(const LAS v2u*)(vb_ + kk2), a0h = *(const LAS v2u*)(vb_ + kk2 + 16); \
            const v2u a1l = *(const LAS v2u*)(vb_ + 32 * AT_VPITCH + kk2), a1h = *(const LAS v2u*)(vb_ + 32 * AT_VPITCH + kk2 + 16); \
            const bf16x8 va0 = __builtin_bit_cast(bf16x8, (v4u){a0l.x, a0l.y, a0h.x, a0h.y}), va1 = __builtin_bit_cast(bf16x8, (v4u){a1l.x, a1l.y, a1h.x, a1h.y}); \
            o0 = __builtin_amdgcn_mfma_f32_32x32x16_bf16(va0, pb[s4], o0, 0, 0, 0); o1 = __builtin_amdgcn_mfma_f32_32x32x16_bf16(va1, pb[s4], o1, 0, 0, 0); } } while (0)
constexpr int ATS_TILEB = 64 * AT_KPITCH + 64 * AT_VPITCH;
__device__ __forceinline__ void ats_stage_block(const bf16_t* K, const bf16_t* Vt, int b, int h, int jb, LAS unsigned char* lds, int tid) {
    const int srow = tid >> 3, sch = tid & 7;
    const bf16_t* kg = K + (size_t)(b * S + 256 * jb + srow) * D + h * HD + sch * 8;
    const bf16_t* vg = Vt + (size_t)(h * HD + srow) * T + b * S + 256 * jb + sch * 8;
    v4u kr[4], vr[4];
#pragma unroll
    for (int tt = 0; tt < 4; ++tt) { kr[tt] = *(const GAS v4u*)(kg + (size_t)tt * 64 * D); vr[tt] = *(const GAS v4u*)(vg + tt * 64); }
#pragma unroll
    for (int tt = 0; tt < 4; ++tt) { LAS unsigned char* tb = lds + tt * ATS_TILEB;
        *(LAS v4u*)(tb + srow * AT_KPITCH + sch * 16) = kr[tt];
        *(LAS v2u*)(tb + 64 * AT_KPITCH + srow * AT_VPITCH + sch * 16) = (v2u){vr[tt].x, vr[tt].y}; *(LAS v2u*)(tb + 64 * AT_KPITCH + srow * AT_VPITCH + sch * 16 + 8) = (v2u){vr[tt].z, vr[tt].w}; }
    __syncthreads();
}
__device__ __forceinline__ void attn_gate_phase(const bf16_t* Q, const float* kmean, const float* kabs, unsigned short* takebits, int* gcnt, int* selinfo, float* pml_mark, LAS unsigned char* lds, int wg, int G, int wave, int lane) {
    LAS float* km = (LAS float*)(lds + wave * 4096);
    for (int item = wg * NWAVES + wave; item < NB * NH * (S / 64); item += G * NWAVES) {
        const int tg = item & (S / 64 - 1), bh = item >> 6, b = bh >> 4, h = bh & 15;
        const int t = tg * 64 + lane, qi = tg >> 2;
#pragma unroll
        for (int q = 0; q < 4; ++q) *((LAS f32x4*)km + lane + 64 * q) = *((const GAS f32x4*)(kmean + (size_t)bh * NBLK * HD) + lane + 64 * q);
        const bf16_t* qrow = Q + (size_t)(b * S + t) * D + h * HD;
        v4u qv[8];
#pragma unroll
        for (int k = 0; k < 8; ++k) qv[k] = *(const GAS v4u*)(qrow + 8 * k);
        float l1 = 0.f;
#pragma unroll
        for (int k = 0; k < 8; ++k) l1 += (fabsf(bflo(qv[k].x)) + fabsf(bfhi(qv[k].x))) + (fabsf(bflo(qv[k].y)) + fabsf(bfhi(qv[k].y))) + (fabsf(bflo(qv[k].z)) + fabsf(bfhi(qv[k].z))) + (fabsf(bflo(qv[k].w)) + fabsf(bfhi(qv[k].w)));
        float gate[NBLK];
#pragma unroll
        for (int n = 0; n < NBLK; ++n) { float sg = 0.f;
            if (n < qi) {
#pragma unroll
                for (int k = 0; k < 8; ++k) { const f32x4 k0 = *((const LAS f32x4*)(km + n * HD + 8 * k)), k1 = *((const LAS f32x4*)(km + n * HD + 8 * k + 4));
                    sg += (bflo(qv[k].x) * k0[0] + bfhi(qv[k].x) * k0[1]) + (bflo(qv[k].y) * k0[2] + bfhi(qv[k].y) * k0[3]) + (bflo(qv[k].z) * k1[0] + bfhi(qv[k].z) * k1[1]) + (bflo(qv[k].w) * k1[2] + bfhi(qv[k].w) * k1[3]); } }
            gate[n] = sg; }
        unsigned sel = 0u;
#pragma unroll
        for (int r = 0; r < 3; ++r) { int best = -1; float bv = 0.f;
#pragma unroll
            for (int n = 0; n < NBLK; ++n) if (n < qi && !((sel >> n) & 1u)) { if (best < 0 || gate[n] > bv) { best = n; bv = gate[n]; } }
            if (best >= 0) sel |= 1u << best; }
        const float slope2 = exp2f(-8.0f * (float)(h + 1) / (float)NH) * LOG2E;
        const float* kab = kabs + bh * NBLK; const float kown = kab[qi];
        int slot = 0; unsigned tmask = 0u;
        for (int n = 0; n < NBLK; ++n) {
            bool take = n < qi && ((sel >> n) & 1u) != 0u;
            if (take) { const float bound = l1 * (kab[n] + kown) * 1.02f + 160.0f; if (slope2 * (float)(t - 256 * n - 255) > bound) take = false; }
            if (take) { tmask |= 1u << n; ++slot; }
            const unsigned long long mk = __builtin_amdgcn_ballot_w64(take);
            if (lane == 0) ST_WT(gcnt + (size_t)(bh * NBLK + n) * 64 + tg, (int)__builtin_popcountll(mk));
        }
        ST_WT(takebits + (size_t)(b * S + t) * NH + h, (unsigned short)tmask);
        ST_WT(selinfo + (size_t)(b * S + t) * NH + h, slot);
        if (DIAG_CHECK_LISTS) { for (int r = 0; r < 3; ++r) pml_mark[(((size_t)r * T + (size_t)(b * S + t)) * NH + h) * 2 + 1] = -1.0f; }
    }
}
__device__ __forceinline__ void attn_list_phase(const unsigned short* takebits, const int* gcnt, int* cnt, unsigned* lists, int wg, int G, int wave, int lane) {
    for (int item = wg * NWAVES + wave; item < NB * NH * (S / 64); item += G * NWAVES) {
        const int tg = item & (S / 64 - 1), bh = item >> 6, b = bh >> 4, h = bh & 15;
        const int t = tg * 64 + lane, qi = tg >> 2;
        const unsigned tmask = takebits[(size_t)(b * S + t) * NH + h];
        for (int n = 0; n < qi; ++n) {
            const int v = gcnt[(size_t)(bh * NBLK + n) * 64 + lane];
            int pre = lane < tg ? v : 0, tot = v;
#pragma unroll
            for (int o = 1; o < 64; o <<= 1) { pre += __shfl_xor(pre, o); tot += __shfl_xor(tot, o); }
            const bool take = ((tmask >> n) & 1u) != 0u;
            const unsigned long long mk = __builtin_amdgcn_ballot_w64(take);
            if (take) { const int rank = (int)__builtin_popcountll(mk & ((1ull << lane) - 1ull)), slot = __builtin_popcount(tmask & ((1u << n) - 1u));
                ST_WT(lists + (size_t)(bh * NBLK + n) * 4096 + pre + rank, (unsigned)t | ((unsigned)slot << 12)); }
            if (tg == S / 64 - 1 && lane == 0) ST_WT(cnt + bh * NBLK + n, tot);
        }
        if (tg == S / 64 - 1 && lane == 0) ST_WT(cnt + bh * NBLK + NBLK - 1, 0);
    }
}
__device__ __forceinline__ void attn_sort_phase(const int* cnt, unsigned* lists, LAS unsigned char* lds, int wg, int G, int tid) {
    LAS unsigned* bm = (LAS unsigned*)lds;
    LAS unsigned char* sl = (LAS unsigned char*)(lds + 1024);
    LAS int* pre = (LAS int*)(lds + 8192);
    for (int e = wg; e < NB * NH * NBLK; e += G) {
        const int n = __hip_atomic_load(cnt + e, __ATOMIC_RELAXED, __HIP_MEMORY_SCOPE_AGENT);
        if (tid < 128) bm[tid] = 0u; __syncthreads();
        for (int i = tid; i < n; i += NTHR) { const unsigned ent = lists[(size_t)e * 4096 + i]; const unsigned t = ent & 4095u; sl[t] = (unsigned char)(ent >> 12); __hip_atomic_fetch_or(bm + (t >> 5), 1u << (t & 31u), __ATOMIC_RELAXED, __HIP_MEMORY_SCOPE_WORKGROUP); }
        __syncthreads();
        if (tid == 0) { int a = 0; for (int w = 0; w < 128; ++w) { pre[w] = a; a += __builtin_popcount(bm[w]); } }
        __syncthreads();
        if (DIAG_SORT_LISTS == 2) { for (int i = tid; i < n; i += NTHR) { const unsigned ent = lists[(size_t)e * 4096 + i]; asm volatile("" ::: "memory"); lists[(size_t)e * 4096 + i] = ent; } }
        else if (tid < 128) { unsigned m = bm[tid]; int o = pre[tid]; while (m) { const int bpos = __builtin_ctz(m); m &= m - 1u; const unsigned t = (unsigned)(tid * 32 + bpos); lists[(size_t)e * 4096 + o++] = t | ((unsigned)sl[t] << 12); } }
        __syncthreads();
    }
}
__device__ __forceinline__ void attn_sel_phase(const bf16_t* Q, const bf16_t* K, const bf16_t* Vt, const int* cnt, const unsigned* lists, bf16_t* po, float* pml, unsigned* dflag, LAS unsigned char* lds, int wg, int G, int tid, int wave, int lane) {
    const int r32 = lane & 31, hi = lane >> 5, qrel = 0; (void)qrel;
    LAS int* lc = (LAS int*)(lds + 4 * ATS_TILEB);
    for (int i = tid; i < NB * NH * NBLK; i += NTHR) lc[i] = __hip_atomic_load(cnt + i, __ATOMIC_RELAXED, __HIP_MEMORY_SCOPE_AGENT);
    __syncthreads();
    if (DIAG_CHECK_LISTS) {
        LAS unsigned* bm = (LAS unsigned*)lds;
        for (int e = wg; e < NB * NH * NBLK; e += G) { const int n = lc[e], j = e & 15;
            if (tid < 128) bm[tid] = 0u; __syncthreads();
            unsigned bad = 0u;
            for (int i = tid; i < n; i += NTHR) { const unsigned ent = lists[(size_t)e * 4096 + i]; const unsigned t = ent & 4095u, sl = ent >> 12;
                if (sl > 2u || (int)(t >> 8) <= j) bad = 1u; const unsigned old = __hip_atomic_fetch_or(bm + (t >> 5), 1u << (t & 31u), __ATOMIC_RELAXED, __HIP_MEMORY_SCOPE_WORKGROUP); if (old & (1u << (t & 31u))) bad = 1u; }
            if (n > 3840) bad = 1u;
            if (bad) __hip_atomic_store(dflag, 1u, __ATOMIC_RELAXED, __HIP_MEMORY_SCOPE_AGENT);
            __syncthreads(); }
    }
    int u = 0;
    for (int e = 0; e < NB * NH * NBLK; ++e) {
        const int n = DIAG_FIXED_LISTS ? ((e & 15) < 15 ? (15 - (e & 15)) * 256 : 0) : lc[e]; if (n == 0) continue;
        const int nch = (n + 255) >> 8, bh = e >> 4, j = e & 15, b = bh >> 4, h = bh & 15;
        for (int c = 0; c < nch; ++c, ++u) {
            if (u % G != wg) continue;
            ats_stage_block(K, Vt, b, h, j, lds, tid);
            const int idx = 256 * c + 32 * wave + r32; bool valid = idx < n;
            if (256 * c + 32 * wave < n) {
                unsigned ent = lists[(size_t)e * 4096 + (valid ? idx : n - 1)];
                if (DIAG_FIXED_LISTS) { if (ent == 0xffffffffu) { valid = false; ent = (unsigned)(256 * (j + 1) + idx); } }
                const int t = (int)(ent & 4095u), slot = (int)(ent >> 12);
                const bf16_t* qrow = Q + (size_t)(b * S + t) * D + h * HD;
                bf16x8 qr[4];
#pragma unroll
                for (int d0 = 0; d0 < 4; ++d0) qr[d0] = *(const GAS bf16x8*)(qrow + d0 * 16 + hi * 8);
                const float slope2 = exp2f(-8.0f * (float)(h + 1) / (float)NH) * LOG2E;
                f32x16 cb0, cb1;
#pragma unroll
                for (int r = 0; r < 16; ++r) { const int kk = (r & 3) + 8 * (r >> 2) + 4 * hi; cb0[r] = slope2 * (float)kk; cb1[r] = slope2 * (float)(kk + 32); }
                f32x16 o0 = {}, o1 = {}; float m_run = -1.0e30f, l_run = 0.f;
                const float tbase = slope2 * (float)(256 * j - ((t & ~255) + 255));
#pragma unroll 1
                for (int tt = 0; tt < 4; ++tt) ATS_TILE(lds + tt * ATS_TILEB, lds + tt * ATS_TILEB + 64 * AT_KPITCH, valid, tbase + slope2 * (float)(64 * tt), -1);
                const float ltot = l_run + __shfl_xor(l_run, 32);
                if (valid) { const float inv = 1.0f / ltot; const size_t row = ((size_t)slot * T + (size_t)(b * S + t)) * NH + h;
                    bf16_t* op = po + row * HD;
#pragma unroll
                    for (int g = 0; g < 4; ++g) { v2u w0, w1;
                        w0.x = pk2(o0[4 * g] * inv, o0[4 * g + 1] * inv); w0.y = pk2(o0[4 * g + 2] * inv, o0[4 * g + 3] * inv);
                        w1.x = pk2(o1[4 * g] * inv, o1[4 * g + 1] * inv); w1.y = pk2(o1[4 * g + 2] * inv, o1[4 * g + 3] * inv);
                        *(GAS v2u*)(op + 8 * g + 4 * hi) = w0; *(GAS v2u*)(op + 32 + 8 * g + 4 * hi) = w1; }
                    if (hi == 0) { ST_WT(pml + row * 2, m_run); ST_WT(pml + row * 2 + 1, ltot); } }
            }
            __syncthreads();
        }
    }
}
__device__ __forceinline__ void attn_own_phase(const bf16_t* Q, const bf16_t* K, const bf16_t* Vt, const int* selinfo, const bf16_t* po, const float* pml, bf16_t* O, unsigned* dflag, LAS unsigned char* lds, int wg, int G, int tid, int wave, int lane) {
    const int r32 = lane & 31, hi = lane >> 5;
    for (int unit = wg; unit < NB * NH * NBLK; unit += G) {
        const int qi = unit & 15, bh = unit >> 4, b = bh >> 4, h = bh & 15, q0 = qi * 256;
        ats_stage_block(K, Vt, b, h, qi, lds, tid);
        const int qrel = wave * 32 + r32, t = q0 + qrel;
        const bf16_t* qrow = Q + (size_t)(b * S + t) * D + h * HD;
        bf16x8 qr[4];
#pragma unroll
        for (int d0 = 0; d0 < 4; ++d0) qr[d0] = *(const GAS bf16x8*)(qrow + d0 * 16 + hi * 8);
        const float slope2 = exp2f(-8.0f * (float)(h + 1) / (float)NH) * LOG2E;
        f32x16 cb0, cb1;
#pragma unroll
        for (int r = 0; r < 16; ++r) { const int kk = (r & 3) + 8 * (r >> 2) + 4 * hi; cb0[r] = slope2 * (float)kk; cb1[r] = slope2 * (float)(kk + 32); }
        f32x16 o0 = {}, o1 = {}; float m_run = -1.0e30f, l_run = 0.f;
        const int nsl = selinfo[(size_t)(b * S + t) * NH + h];
        float pm[3], pl[3];
#pragma unroll
        for (int r = 0; r < 3; ++r) { const size_t row = ((size_t)r * T + (size_t)(b * S + t)) * NH + h; pm[r] = -1.0e30f; pl[r] = 0.f; if (r < nsl) { pm[r] = pml[row * 2]; pl[r] = pml[row * 2 + 1]; if (DIAG_CHECK_LISTS && pl[r] < 0.f) __hip_atomic_store(dflag, 2u, __ATOMIC_RELAXED, __HIP_MEMORY_SCOPE_AGENT); } }
        m_run = fmaxf(fmaxf(pm[0], pm[1]), pm[2]);
#pragma unroll
        for (int r = 0; r < 3; ++r) if (r < nsl) {
            const float w = pl[r] * __builtin_amdgcn_exp2f(pm[r] - m_run); l_run += w;
            const bf16_t* op = po + (((size_t)r * T + (size_t)(b * S + t)) * NH + h) * HD;
#pragma unroll
            for (int g = 0; g < 4; ++g) { const v2u w0 = *(const GAS v2u*)(op + 8 * g + 4 * hi), w1 = *(const GAS v2u*)(op + 32 + 8 * g + 4 * hi);
                o0[4 * g] += w * bflo(w0.x); o0[4 * g + 1] += w * bfhi(w0.x); o0[4 * g + 2] += w * bflo(w0.y); o0[4 * g + 3] += w * bfhi(w0.y);
                o1[4 * g] += w * bflo(w1.x); o1[4 * g + 1] += w * bfhi(w1.x); o1[4 * g + 2] += w * bflo(w1.y); o1[4 * g + 3] += w * bfhi(w1.y); } }
        l_run *= 0.5f;
#pragma unroll 1
        for (int tt = 0; tt < 4; ++tt) { if (64 * tt > wave * 32 + 31) break;
            ATS_TILE(lds + tt * ATS_TILEB, lds + tt * ATS_TILEB + 64 * AT_KPITCH, true, slope2 * (float)(64 * tt - 255), 64 * tt); }
        const float ltot = l_run + __shfl_xor(l_run, 32);
        float inv = 1.0f / ltot;
        if (DIAG_CHECK_LISTS) { if (__hip_atomic_load(dflag, __ATOMIC_RELAXED, __HIP_MEMORY_SCOPE_AGENT) != 0u) inv = __builtin_nanf(""); }
        bf16_t* orow = O + (size_t)(b * S + t) * D + h * HD;
#pragma unroll
        for (int g = 0; g < 4; ++g) { v2u w0, w1;
            w0.x = pk2(o0[4 * g] * inv, o0[4 * g + 1] * inv); w0.y = pk2(o0[4 * g + 2] * inv, o0[4 * g + 3] * inv);
            w1.x = pk2(o1[4 * g] * inv, o1[4 * g + 1] * inv); w1.y = pk2(o1[4 * g + 2] * inv, o1[4 * g + 3] * inv);
            *(GAS v2u*)(orow + 8 * g + 4 * hi) = w0; *(GAS v2u*)(orow + 32 + 8 * g + 4 * hi) = w1; }
        __syncthreads();
    }
}
struct AttnOrder { unsigned char hq[256]; };
constexpr AttnOrder make_attn_order() {
    AttnOrder o{}; int cost[256] = {}; const int nb[16] = {1, 2, 2, 3, 4, 6, 8, 11, 15, 15, 15, 15, 15, 15, 15, 15};
    for (int k = 0; k < 256; ++k) { const int h = k >> 4, i = k & 15; o.hq[k] = (unsigned char)k; cost[k] = 8 * (i < nb[h] ? i : nb[h]) + 5; }
    for (int a = 1; a < 256; ++a) { const int c = cost[a]; const unsigned char v = o.hq[a]; int q = a - 1; while (q >= 0 && cost[q] < c) { cost[q + 1] = cost[q]; o.hq[q + 1] = o.hq[q]; --q; } cost[q + 1] = c; o.hq[q + 1] = v; }
    return o;
}
__device__ constexpr AttnOrder ATTN_ORDER = make_attn_order();
__device__ __forceinline__ void attn_phase(const bf16_t* Q, const bf16_t* K, const bf16_t* Vt, const float* kmean, const float* kabs, bf16_t* O, LAS unsigned char* lds, int wg, int G, int tid, int wave, int lane) {
    for (int r = 0; r < 4; ++r) {
        const int u = (r == 0) ? wg : (r == 1) ? 511 - wg : (r == 2) ? 512 + wg : 1023 - wg;
        const int hq = ATTN_ORDER.hq[u >> 2], b = u & 3;
        attn_unit(b, hq >> 4, hq & 15, Q, K, Vt, kmean, kabs, O, lds, tid, wave, lane);
    }
}

#ifndef REP_ATTN
#define REP_ATTN 1
#endif
#ifndef REP_B1
#define REP_B1 1
#endif
#ifndef REP_CI
#define REP_CI 1
#endif
#ifndef REP_CONV
#define REP_CONV 1
#endif
#ifndef REP_E0
#define REP_E0 1
#endif
#ifndef REP_E1
#define REP_E1 1
#endif
#ifndef REP_E2
#define REP_E2 1
#endif
#ifndef REP_F1
#define REP_F1 1
#endif
#ifndef REP_F2
#define REP_F2 1
#endif
#ifndef REP_P0
#define REP_P0 1
#endif
#ifndef REP_ROW
#define REP_ROW 1
#endif
#ifndef REP_X3
#define REP_X3 1
#endif
#ifndef TPROBE
#define TPROBE -1
#endif
#ifndef TP_MULT
#define TP_MULT 2
#endif
#define PH_BEGIN(REP, CLS) if (lo <= ph && ph < hi) { if (TPROBE >= 0) { unsigned long long now_ = __builtin_amdgcn_s_memrealtime(); \
                 if (tp.cls == TPROBE) { const unsigned long long d_ = (now_ - tp.t0) * TP_MULT; while (__builtin_amdgcn_s_memrealtime() - now_ < d_) __builtin_amdgcn_s_sleep(8); now_ = __builtin_amdgcn_s_memrealtime(); } \
                 tp.t0 = now_; tp.cls = (CLS); } \
                 for (int rep_i = 0; rep_i < (REP); ++rep_i) { if (rep_i) xcd_barrier(bar); int tid = threadIdx.x; asm volatile("" : "+v"(tid)); const int lane = tid & 63, wave = __builtin_amdgcn_readfirstlane(tid >> 6); \
                 int wg = vwg; asm volatile("" : "+s"(wg)); unsigned char* ws = args.ws; asm volatile("" : "+s"(ws)); (void)lane; (void)wave; (void)wg;
#define PH_END   } if (ph + 1 < hi) xcd_barrier(bar); } ++ph;
struct TProbe { unsigned long long acc, t0; int cls; };
#define WSP(Ty, off) ((Ty*)(ws + (off)))
#define MODP  WSP(float, WS_MOD)


template <int L> __device__ __forceinline__ void layer_phases(const Args& args, LAS unsigned char* lds, const XcdBarrier& bar, const int lo, const int hi, const int G, const int vwg, TProbe& tp) {
    constexpr int l = L;
    int ph = 2 + (L >= 1 ? 7 : 0) + (L >= 2 ? 8 : 0) + (L >= 3 ? 7 + (SPARSE_ATTN ? 3 + (DIAG_SORT_LISTS ? 1 : 0) : 0) : 0);
#define MLP   (MODP + (size_t)l * NB * 6 * D)
#define XIN   ((l == 0) ? (const void*)args.in[0] : (const void*)(ws + WS_X0 + (size_t)(2 * l - 1) * 64 * MiB))
#define X1P   ((bf16_t*)(ws + WS_X0 + (size_t)(2 * l) * 64 * MiB))
#define X2P   ((bf16_t*)(ws + WS_X0 + (size_t)(2 * l + 1) * 64 * MiB))
        if (l < NA) {
            PH_BEGIN(REP_CI, 2)
                constexpr bool F8 = FP8_CONV != 0; constexpr int EB = F8 ? 1 : 2;
                pg8::Gemm g{WSP(bf16_t, WS_HBF), (const bf16_t*)(ws + W_CI + (size_t)l * 2 * D * D * EB), T, 2 * D, D * EB / 2}; pg8::StaticOrder So; So.init(T, 2 * D, G, wg);
                pg8::EpiGated<0, 0> E{WSP(bf16_t, WS_U), D, args.in[7] + l * 2 * D, D, F8 ? 1.0f / (S8_H * S8_WP) : 1.0f, 1.0f};
                pg8::gemm_phase<pg8::EpiGated<0, 0>, pg8::StaticOrder, true, true, F8>(lds, g, So, E);
            PH_END
            PH_BEGIN(REP_CONV, 3)
                conv_phase(WSP(bf16_t, WS_U), args.in[8] + l * CONVK * D, args.in[9] + l * D, args.in[10] + l * D, args.in[11] + l * D, WSP(bf16_t, WS_U2), lds, wg, tid, wave, lane);
            PH_END
        } else {
            PH_BEGIN(REP_B1, 4)
                constexpr bool AF8 = FP8_ATTN != 0; constexpr int AEB = AF8 ? 1 : 2;
                if (l == NA) {
                    { pg8::Gemm g{WSP(bf16_t, WS_HKV), WSP(const bf16_t, W_KV), T, D, D * AEB / 2}; pg8::StaticOrder So; So.init(T, D, G, wg);
                      pg8::EpiK E{WSP(bf16_t, WS_K), D, WSP(float, WS_KMEAN), WSP(unsigned, WS_KABS), AF8 ? 1.0f / (S8_H * S8_WP) : 1.0f};
                      pg8::gemm_phase<pg8::EpiK, pg8::StaticOrder, true, true, AF8>(lds, g, So, E); }
                    { pg8::Gemm g{(const bf16_t*)(ws + W_KV + (size_t)D * D * AEB), WSP(bf16_t, WS_HKV), D, T, D * AEB / 2}; pg8::StaticOrder So; So.init(D, T, G, wg);
                      pg8::EpiBf16S E{WSP(bf16_t, WS_VT), T, AF8 ? 1.0f / (S8_H * S8_WP) : 1.0f};
                      pg8::gemm_phase<pg8::EpiBf16S, pg8::StaticOrder, true, true, AF8>(lds, g, So, E); }
                }
                { pg8::Gemm g{WSP(bf16_t, WS_HBF), (const bf16_t*)(ws + W_Q + (size_t)(l - NA) * D * D * AEB), T, D, D * AEB / 2}; pg8::StaticOrder So; So.init(T, D, G, wg);
                  pg8::EpiBf16S E{WSP(bf16_t, WS_U), D, AF8 ? QSCALE / (S8_H * S8_WP) : QSCALE};
                  pg8::gemm_phase<pg8::EpiBf16S, pg8::StaticOrder, true, true, AF8>(lds, g, So, E); }
            PH_END
            if constexpr (SPARSE_ATTN != 0) {
                PH_BEGIN(REP_ATTN, 5)
                    attn_gate_phase(WSP(bf16_t, WS_U), WSP(float, WS_KMEAN), WSP(float, WS_KABS), WSP(unsigned short, WS_ATAKE), WSP(int, WS_AGCNT), WSP(int, WS_ASEL), WSP(float, WS_APML), lds, wg, G, wave, lane);
                PH_END
                PH_BEGIN(REP_ATTN, 5)
                    attn_list_phase(WSP(unsigned short, WS_ATAKE), WSP(int, WS_AGCNT), WSP(int, WS_ACNT) + (l - NA) * (NB * NH * NBLK), WSP(unsigned, WS_ALIST), wg, G, wave, lane);
                PH_END
                if constexpr (DIAG_SORT_LISTS != 0) {
                PH_BEGIN(REP_ATTN, 5)
                    attn_sort_phase(WSP(int, WS_ACNT) + (l - NA) * (NB * NH * NBLK), WSP(unsigned, WS_ALIST), lds, wg, G, tid);
                PH_END
                }
                PH_BEGIN(REP_ATTN, 5)
                    attn_sel_phase(WSP(bf16_t, WS_U), WSP(bf16_t, WS_K), WSP(bf16_t, WS_VT), WSP(int, WS_ACNT) + (l - NA) * (NB * NH * NBLK), WSP(unsigned, WS_ALIST), WSP(bf16_t, WS_APO), WSP(float, WS_APML), WSP(unsigned, WS_CTL) + 2048, lds, wg, G, tid, wave, lane);
                PH_END
                PH_BEGIN(REP_ATTN, 5)
                    attn_own_phase(WSP(bf16_t, WS_U), WSP(bf16_t, WS_K), WSP(bf16_t, WS_VT), WSP(int, WS_ASEL), WSP(bf16_t, WS_APO), WSP(float, WS_APML), WSP(bf16_t, WS_U2), WSP(unsigned, WS_CTL) + 2048, lds, wg, G, tid, wave, lane);
                PH_END
            } else {
            PH_BEGIN(REP_ATTN, 5)
                attn_phase(WSP(bf16_t, WS_U), WSP(bf16_t, WS_K), WSP(bf16_t, WS_VT), WSP(float, WS_KMEAN), WSP(float, WS_KABS), WSP(bf16_t, WS_U2), lds, wg, G, tid, wave, lane);
            PH_END
            }
        }
        PH_BEGIN(REP_X3, 6)
            constexpr bool F8 = (L < NA) ? (FP8_CONV != 0) : (FP8_ATTN != 0); constexpr int EB = F8 ? 1 : 2;
            const bf16_t* Bt = (l < NA) ? (const bf16_t*)(ws + W_CO + (size_t)l * D * D * EB) : (const bf16_t*)(ws + W_O + (size_t)(l - NA) * D * D * EB);
            const float* mixbias = (l < NA) ? args.in[13] + l * D : nullptr;
            pg8::Gemm g{WSP(bf16_t, WS_U2), Bt, T, D, D * EB / 2}; pg8::StaticOrder So; So.init(T, D, G, wg);
            pg8::EpiResid<(L == 0)> E{XIN, WSP(bf16_t, WS_Y), MLP + 2 * D, 6 * D, mixbias, ALPHA, F8 ? 1.0f / (S8_U * S8_WO) : 1.0f};
            pg8::gemm_phase<pg8::EpiResid<(L == 0)>, pg8::StaticOrder, true, true, F8>(lds, g, So, E);
        PH_END
        PH_BEGIN(REP_ROW, 1)
            RowArgs A{}; A.oscale = 1.0f; A.mode = 1; A.y = WSP(bf16_t, WS_Y); A.lng = args.in[4] + (l * 2) * D; A.lnb = args.in[5] + (l * 2) * D; A.x_out = X1P;
            A.sh = MLP + 3 * D; A.sc = MLP + 4 * D; A.mstride = 6 * D;
            if (((l & 1) && FP8_MOE) || (!(l & 1) && FP8_FFN)) A.h8_out = WSP(unsigned char, WS_HBF); else A.h_out = WSP(bf16_t, WS_HBF);
            if (l & 1) { A.rw = args.in[21] + (size_t)(l >> 1) * D * NE; A.rb = args.in[22] + (l >> 1) * NE; A.tok_e = WSP(int, WS_ROUTE + RT_TOKE); A.tok_w = WSP(float, WS_ROUTE + RT_TOKW); A.cntwg = WSP(int, WS_ROUTE + RT_CNTWG); }
            row_phase<((L & 1) ? 2 : 4)>(A, lds, wg, tid, wave, lane);
        PH_END
        if ((l & 1) == 0) {
            PH_BEGIN(REP_F1, 7)
                constexpr bool F8 = FP8_FFN != 0; constexpr int EB = F8 ? 1 : 2;
                pg8::Gemm g{WSP(bf16_t, WS_HBF), (const bf16_t*)(ws + W_F13 + (size_t)(l >> 1) * 2 * DFF * D * EB), T, 2 * DFF, D * EB / 2}; pg8::StaticOrder So; So.init(T, 2 * DFF, G, wg);
                pg8::EpiGated<1, 0, F8> E{WSP(bf16_t, WS_HM), DFF, nullptr, 0, F8 ? 1.0f / (S8_H * S8_W13) : 1.0f, S8_HM};
                pg8::gemm_phase<pg8::EpiGated<1, 0, F8>, pg8::StaticOrder, true, true, F8>(lds, g, So, E);
                if (L == 0) tail_convert(args, ws, M1A7, 8 * CG7_PER, M1A8, 8 * CG8_PER, ((T / 256) * (2 * DFF / 256)) % GRID, lds, wg, G, wave, lane);
                else        tail_convert(args, ws, M3A7, 16 * CG7_PER, M3A8, 16 * CG8_PER, ((T / 256) * (2 * DFF / 256)) % GRID, lds, wg, G, wave, lane);
            PH_END
            PH_BEGIN(REP_F2, 8)
                constexpr bool F8 = FP8_FFN != 0; constexpr int EB = F8 ? 1 : 2;
                pg8::Gemm g{WSP(bf16_t, WS_HM), (const bf16_t*)(ws + W_F2 + (size_t)(l >> 1) * D * DFF * EB), T, D, DFF * EB / 2}; pg8::StaticOrder So; So.init(T, D, G, wg);
                pg8::EpiResid<false> E{X1P, WSP(bf16_t, WS_Y), MLP + 5 * D, 6 * D, nullptr, ALPHA, F8 ? 1.0f / (S8_HM * S8_W2) : 1.0f};
                pg8::gemm_phase<pg8::EpiResid<false>, pg8::StaticOrder, true, true, F8>(lds, g, So, E);
            PH_END
        } else {
            PH_BEGIN(REP_E0, 9)
                moe_assign(WSP(int, WS_ROUTE + RT_CNTWG), WSP(int, WS_ROUTE + RT_TOKE), WSP(float, WS_ROUTE + RT_TOKW), WSP(int, WS_ROUTE + RT_RINFO), WSP(float, WS_ROUTE + RT_RW), WSP(int, WS_ROUTE + RT_META),
                           WSP(unsigned char, WS_HBF), WSP(unsigned char, WS_HPERM), FP8_MOE ? 1024 : 2048, lds, wg, tid, wave, lane);
            PH_END
            PH_BEGIN(REP_E1, 10)
                const int* meta = WSP(int, WS_ROUTE + RT_META); const int NT = __builtin_amdgcn_readfirstlane(meta[9]);
                constexpr bool F8 = FP8_MOE != 0; constexpr int EB = F8 ? 1 : 2;
                pg8::Gemm g{WSP(bf16_t, WS_HPERM), (const bf16_t*)(ws + W_M13 + (size_t)(l >> 1) * NE * 2 * DFE * D * EB), NT * 256, 2 * DFE, D * EB / 2}; pg8::MoeOrder So; So.init(NT, 2 * DFE / 256, G, wg, meta + 16);
                pg8::EpiGated<1, 28, F8> E{WSP(bf16_t, WS_HM), DFE, nullptr, 0, F8 ? 1.0f / (S8_H * S8_W13) : 1.0f, S8_HM};
                pg8::gemm_phase<pg8::EpiGated<1, 28, F8>, pg8::MoeOrder, true, true, F8>(lds, g, So, E);
            PH_END
            PH_BEGIN(REP_E2, 11)
                const int* meta = WSP(int, WS_ROUTE + RT_META); const int NT = __builtin_amdgcn_readfirstlane(meta[9]);
                constexpr bool F8 = FP8_MOE != 0; constexpr int EB = F8 ? 1 : 2;
                pg8::Gemm g{WSP(bf16_t, WS_HM), (const bf16_t*)(ws + W_M2 + (size_t)(l >> 1) * NE * D * DFE * EB), NT * 256, D, DFE * EB / 2}; pg8::MoeOrder So; So.init(NT, D / 256, G, wg, meta + 16);
                pg8::EpiMoeOut E{WSP(bf16_t, WS_MOEO), WSP(int, WS_ROUTE + RT_RINFO), WSP(float, WS_ROUTE + RT_RW), F8 ? 1.0f / (S8_HM * S8_W2) : 1.0f, (size_t)0};
                pg8::gemm_phase<pg8::EpiMoeOut, pg8::MoeOrder, true, true, F8>(lds, g, So, E);
                if (L == 1) tail_convert(args, ws, 8 * CG7_PER, M3A7, 8 * CG8_PER, M3A8, (NT * (D / 256)) % GRID, lds, wg, G, wave, lane);
            PH_END
        }
        PH_BEGIN(REP_ROW, 1)
            RowArgs A{}; A.oscale = 1.0f;
            A.lng = args.in[4] + (l * 2 + 1) * D; A.lnb = args.in[5] + (l * 2 + 1) * D; if (l == DEPTH - 1) A.x_out32 = args.out; else A.x_out = X2P;
            if ((l & 1) == 0) { A.mode = 1; A.y = WSP(bf16_t, WS_Y); } else { A.mode = 2; A.x_in = X1P; A.moeo = WSP(bf16_t, WS_MOEO); A.gate = MLP + 5 * D; A.gstride = 6 * D; }
            if (l + 1 < DEPTH) { const float* mn = MODP + (size_t)(l + 1) * NB * 6 * D; A.sh = mn; A.sc = mn + D; A.mstride = 6 * D;
                if ((l + 1 < NA) ? (FP8_CONV != 0) : (FP8_ATTN != 0)) A.h8_out = WSP(unsigned char, WS_HBF); else A.h_out = WSP(bf16_t, WS_HBF); }
            if (l + 1 == NA) { const float* kvmod = MODP + (size_t)DEPTH * NB * 6 * D; A.kvsh = kvmod; A.kvsc = kvmod + D; if (FP8_ATTN) A.hkv8_out = WSP(unsigned char, WS_HKV); else A.hkv_out = WSP(bf16_t, WS_HKV); }
            row_phase<((L & 1) ? 2 : 4)>(A, lds, wg, tid, wave, lane);
        PH_END
}
#undef MLP
#undef XIN
#undef X1P
#undef X2P
__global__ void __launch_bounds__(NTHR, 2) mega_fwd(Args args) {
    extern __shared__ __attribute__((aligned(16))) unsigned char lds_raw[];
    LAS unsigned char* lds = (LAS unsigned char*)lds_raw;
    const int G = gridDim.x;
    for (int u = threadIdx.x; u < (LDS_BYTES - LDSCTL_OFF) / 4; u += NTHR) ((LAS unsigned*)(lds + LDSCTL_OFF))[u] = 0u;
    __syncthreads();
    XcdBarrier bar = xcd_barrier_post((unsigned*)(args.ws + WS_CTL) + CW_BAR, (volatile LAS unsigned*)(lds + LDSCTL_OFF));
    if (threadIdx.x == 0) { const unsigned xcc = xb_xcc_id() & 7u; const unsigned rank = __hip_atomic_fetch_add((unsigned*)(args.ws + WS_CTL) + CW_VWG + 64 * xcc, 1u, __ATOMIC_RELAXED, __HIP_MEMORY_SCOPE_AGENT);
        if (rank >= 32u) __hip_atomic_store((unsigned*)(args.ws + WS_CTL) + CW_VWG + 64 * 8, 1u, __ATOMIC_RELAXED, __HIP_MEMORY_SCOPE_AGENT);
        ((volatile LAS unsigned*)(lds + LDSCTL_OFF))[4] = xcc + 8u * (rank & 31u); }
    __syncthreads();
    int vwg = blockIdx.x;
    const int lo = args.ph_lo, hi = args.ph_hi;
    int ph = 0; TProbe tp{0ull, 0ull, -1};
    PH_BEGIN(REP_P0, 0)
        LAS float* ca = (LAS float*)lds; LAS float* red = (LAS float*)(lds + 16384);
        for (int i = tid; i < NB * D; i += NTHR) ca[i] = silu_f(((const GAS float*)args.in[1])[i]);
        __syncthreads();
        for (int unit = wg; unit < (DEPTH * 6 * D + 2 * D) / 64; unit += G) mod_unit(unit, args.in[2], args.in[3], args.in[14], args.in[15], MODP, ca, red, wave, lane);
        __syncthreads();
        { LAS unsigned* scr = (LAS unsigned*)(lds + 32768 + wave * 8448); const int gw = wg * NWAVES + wave, ngw = G * NWAVES;
#pragma unroll
          for (int g = 0; g < 7; ++g) { const ConvGroup Gq = conv_group(g); conv_range(args, ws, g, 0, Gq.count * (Gq.K / 64) * (Gq.N / 64), scr, (gw + 37 * g) % ngw, ngw, lane); }
          conv_range(args, ws, 7, 0, M1A7, scr, gw, ngw, lane); conv_range(args, ws, 8, 0, M1A8, scr, (gw + 1024) % ngw, ngw, lane); }
    PH_END
    if (VWG_MODE && lo == 0 && hi > 1) { const unsigned bad_ = __hip_atomic_load((unsigned*)(args.ws + WS_CTL) + CW_VWG + 64 * 8, __ATOMIC_RELAXED, __HIP_MEMORY_SCOPE_AGENT);
        if (!bad_) vwg = __builtin_amdgcn_readfirstlane((int)((volatile LAS unsigned*)(lds + LDSCTL_OFF))[4]); }
    PH_BEGIN(REP_ROW, 1)
        RowArgs A{}; A.oscale = 1.0f; A.mode = 0; A.x_in = args.in[0]; A.sh = MODP; A.sc = MODP + D; A.mstride = 6 * D; if (FP8_CONV) A.h8_out = WSP(unsigned char, WS_HBF); else A.h_out = WSP(bf16_t, WS_HBF);
        row_phase<4>(A, lds, wg, tid, wave, lane);
    PH_END
    layer_phases<0>(args, lds, bar, lo, hi, G, vwg, tp);
    layer_phases<1>(args, lds, bar, lo, hi, G, vwg, tp);
    layer_phases<2>(args, lds, bar, lo, hi, G, vwg, tp);
    layer_phases<3>(args, lds, bar, lo, hi, G, vwg, tp);
}
#undef PH_BEGIN
#undef PH_END
constexpr int N_PHASES = 2 + 7 + 8 + 7 + 8 + (SPARSE_ATTN ? 6 : 0);
__host__ inline int phases_through_sublayer(int s) { const int per[4] = {7, 8, 7 + (SPARSE_ATTN ? 3 + (DIAG_SORT_LISTS ? 1 : 0) : 0), 8 + (SPARSE_ATTN ? 3 + (DIAG_SORT_LISTS ? 1 : 0) : 0)}; const int l = s / 2; int p = 2; for (int i = 0; i < l; ++i) p += per[i]; p += (s & 1) ? per[l] : 4; return p; }
}
extern "C" void kernel_launch(void* const* d_in, const int* in_sizes, int n_in, void* d_out, int out_size, void* d_ws, size_t ws_size, hipStream_t stream) {
    using namespace mk;
    static int grid = 0;
    if (grid == 0) {
        if (n_in != 25 || in_sizes[0] != T * D || out_size != T * D || ws_size < WS_END3) { fprintf(stderr, "kernel_launch: unexpected problem shape / workspace (n_in %d, ws %zu < %zu); nothing launched\n", n_in, ws_size, (size_t)WS_END3); grid = -1; return; }
        int dev = 0, cus = 0, per_cu = 0;
        if (hipGetDevice(&dev) != hipSuccess || hipDeviceGetAttribute(&cus, hipDeviceAttributeMultiprocessorCount, dev) != hipSuccess) { grid = -1; return; }
        if (hipFuncSetAttribute((const void*)mega_fwd, hipFuncAttributeMaxDynamicSharedMemorySize, LDS_BYTES) != hipSuccess) { fprintf(stderr, "kernel_launch: hipFuncSetAttribute failed\n"); grid = -1; return; }
        if (hipOccupancyMaxActiveBlocksPerMultiprocessor(&per_cu, (const void*)mega_fwd, NTHR, LDS_BYTES) != hipSuccess || per_cu < 1) { fprintf(stderr, "kernel_launch: occupancy query says %d blocks per CU\n", per_cu); (void)hipGetLastError(); grid = -1; return; }
        if (cus != GRID) { fprintf(stderr, "kernel_launch: built for a 256-CU device (one workgroup per CU), found %d CUs; nothing launched\n", cus); grid = -1; return; }
        grid = GRID;
    }
    if (grid < 0) return;
    (void)hipMemsetAsync((char*)d_ws + WS_CTL, 0, CTL_ZERO_BYTES, stream);
    Args a{};
    for (int i = 0; i < 25; ++i) a.in[i] = (const float*)d_in[i];
    a.out = (float*)d_out; a.ws = (unsigned char*)d_ws;
    const int P = phases_through_sublayer(HYB_SUB);
#if MK_PER_PHASE
    for (int p = 0; p < P; ++p) { a.ph_lo = p; a.ph_hi = p + 1; hipLaunchKernelGGL(mega_fwd, dim3(grid), dim3(NTHR), LDS_BYTES, stream, a); }
#else
    a.ph_lo = 0; a.ph_hi = P;
    hipLaunchKernelGGL(mega_fwd, dim3(grid), dim3(NTHR), LDS_BYTES, stream, a);
#endif
#if HYB_SUB < 7
    nv::forward(d_in, (float*)d_out, (char*)d_ws + NAIVE_BASE, stream, HYB_SUB + 1, (const float*)((char*)d_ws + WS_X0 + (size_t)HYB_SUB * 64 * MiB), (const float*)((char*)d_ws + WS_X0 + (size_t)3 * 64 * MiB));
#endif
}
```
